# Optimizing an MI355X kernel written in HIP

```python
import jax, jax.numpy as jnp
from jax import lax
import numpy as np

D_MODEL = 2048
BATCH = 4
SEQ = 2048
DEPTH = 1
DEC_BATCH = 128
DEC_SEQ = 4
PAST_LEN = 16384
PAGE_SIZE = 128

MIX_WIDTH = D_MODEL
M_WIDTH = MIX_WIDTH // 2
G_WIDTH = MIX_WIDTH - M_WIDTH
M_HEADS = 4
M_HEAD_DIM = M_WIDTH // M_HEADS
G_HEADS = 8
G_HEAD_DIM = G_WIDTH // G_HEADS
CONV_W = 4
CHUNK = 64
D_FF = -(-8 * D_MODEL // (3 * 256)) * 256
DEEPNORM_ALPHA = (2.0 * DEPTH) ** 0.25
DEEPNORM_BETA = (8.0 * DEPTH) ** -0.25
LN_EPS = 1e-5
RMS_EPS = 1e-6
IN_SIZES = (M_WIDTH, M_WIDTH, M_WIDTH, M_WIDTH, 3 * G_WIDTH, G_WIDTH, M_HEADS, M_HEADS, G_HEADS, G_HEADS)
IN_COLS = sum(IN_SIZES)

kernel_name = 'hybrid_mlstm_gdn_step'


def layer_norm(x, g, b):
    xf = x.astype(jnp.float32)
    mu = jnp.mean(xf, -1, keepdims=True)
    var = jnp.mean(jnp.square(xf - mu), -1, keepdims=True)
    return ((xf - mu) * lax.rsqrt(var + LN_EPS) * g.astype(jnp.float32) + b.astype(jnp.float32)).astype(x.dtype)


def head_rms_norm(x, g):
    H, d = x.shape[-2:]
    return x * lax.rsqrt(jnp.mean(jnp.square(x), -1, keepdims=True) + RMS_EPS) * g.astype(jnp.float32).reshape(H, d)


def l2norm(x):
    x = x.astype(jnp.float32)
    return x * lax.rsqrt(jnp.sum(jnp.square(x), -1, keepdims=True) + RMS_EPS)


def chunk_len(T):
    return CHUNK if T % CHUNK == 0 else T


def to_chunks(a, L):
    B, T = a.shape[:2]
    return jnp.moveaxis(a.reshape(B, T // L, L, *a.shape[2:]), 1, 0)


def from_chunks(a):
    NC, B, L = a.shape[:3]
    return jnp.moveaxis(a, 0, 1).reshape(B, NC * L, *a.shape[3:])


def mlstm_scan(q, k, v, i_pre, f_pre, C0, n0, m0):
    B, T, H, dk = q.shape
    L = chunk_len(T)
    f32 = jnp.float32
    q = q.astype(f32)
    k = k.astype(f32) * (dk ** -0.5)
    v = v.astype(f32)
    ig = i_pre.astype(f32)
    lf = jax.nn.log_sigmoid(f_pre.astype(f32))
    causal = jnp.tril(jnp.ones((L, L), bool))

    def step(carry, xs):
        C, n, m = carry
        q_, k_, v_, ig_, lf_ = xs
        bt = jnp.moveaxis(jnp.cumsum(lf_, axis=1), 1, -1)
        it = jnp.moveaxis(ig_, 1, -1)
        logD = jnp.where(causal, bt[..., :, None] - bt[..., None, :] + it[..., None, :], -jnp.inf)
        inter = bt + m[..., None]
        m_t = jnp.maximum(inter, jnp.max(logD, -1))
        inter_w = jnp.exp(inter - m_t)
        s = jnp.einsum('blhd,bshd->bhls', q_, k_) * jnp.exp(logD - m_t[..., None])
        num = inter_w[..., None] * jnp.einsum('blhd,bhde->bhle', q_, C) + jnp.einsum('bhls,bshe->bhle', s, v_)
        den = inter_w * jnp.einsum('blhd,bhd->bhl', q_, n) + jnp.sum(s, -1)
        h = num / jnp.maximum(jnp.abs(den), jnp.exp(-m_t))[..., None]
        bL = bt[..., -1]
        wlog = bL[..., None] - bt + it
        m_new = jnp.maximum(bL + m, jnp.max(wlog, -1))
        w = jnp.moveaxis(jnp.exp(wlog - m_new[..., None]), -1, 1)
        decay = jnp.exp(bL + m - m_new)
        C_new = decay[..., None, None] * C + jnp.einsum('bshd,bshe->bhde', k_ * w[..., None], v_)
        n_new = decay[..., None] * n + jnp.einsum('bsh,bshd->bhd', w, k_)
        return (C_new, n_new, m_new), jnp.moveaxis(h, 2, 1)

    xs = tuple(to_chunks(a, L) for a in (q, k, v, ig, lf))
    (C1, n1, m1), hs = lax.scan(step, (C0.astype(f32), n0.astype(f32), m0.astype(f32)), xs)
    return from_chunks(hs), C1, n1, m1


def gdn_scan(q, k, v, log_a, beta, S0):
    B, T, H, dk = q.shape
    L = chunk_len(T)
    f32 = jnp.float32
    q = q.astype(f32) * (dk ** -0.5)
    k = k.astype(f32)
    v = v.astype(f32)
    causal = jnp.tril(jnp.ones((L, L), bool))
    strict = jnp.tril(jnp.ones((L, L), f32), -1)
    eye = jnp.eye(L, dtype=f32)

    def step(S, xs):
        q_, k_, v_, la_, be_ = xs
        b = jnp.moveaxis(jnp.cumsum(la_, axis=1), 1, -1)
        bet = jnp.moveaxis(be_, 1, -1)
        decay = jnp.exp(jnp.where(causal, b[..., :, None] - b[..., None, :], -jnp.inf))
        kh = jnp.moveaxis(k_, 1, 2)
        A = bet[..., :, None] * jnp.einsum('bhld,bhsd->bhls', kh, kh) * decay * strict
        rhs = jnp.concatenate([bet[..., None] * jnp.moveaxis(v_, 1, 2),
                               (bet * jnp.exp(b))[..., None] * kh], -1)
        sol = lax.linalg.triangular_solve(eye + A, rhs, left_side=True, lower=True, unit_diagonal=True)
        U0, W = sol[..., :v_.shape[-1]], sol[..., v_.shape[-1]:]
        U = U0 - jnp.einsum('bhld,bhde->bhle', W, S)
        qk = jnp.einsum('blhd,bhsd->bhls', q_, kh) * decay
        o = jnp.exp(b)[..., None] * jnp.einsum('blhd,bhde->bhle', q_, S) + jnp.einsum('bhls,bhse->bhle', qk, U)
        bL = b[..., -1]
        wk = jnp.exp(bL[..., None] - b)[..., None] * kh
        S_new = jnp.exp(bL)[..., None, None] * S + jnp.einsum('bhld,bhle->bhde', wk, U)
        return S_new, jnp.moveaxis(o, 2, 1)

    xs = tuple(to_chunks(a, L) for a in (q, k, v, log_a.astype(f32), beta.astype(f32)))
    S1, os_ = lax.scan(step, S0.astype(f32), xs)
    return from_chunks(os_), S1


def causal_conv(x, buf, w):
    xp = jnp.concatenate([buf.astype(x.dtype), x], 1)
    T = x.shape[1]
    y = sum(w[j] * xp[:, j:j + T] for j in range(CONV_W))
    return jax.nn.silu(y), xp[:, -(CONV_W - 1):]


def hybrid_layer(x, c, C0, n0, m0, S0, conv0, w_ada, b_ada, w_in, m_i_bias, m_f_bias, m_norm_g,
                 conv_w, g_dt_bias, g_A_log, g_norm_g, w_out, ln1_g, ln1_b, w_gu, w_down, ln2_g, ln2_b):
    B, T, _ = x.shape
    dt = x.dtype
    f32 = jnp.float32
    ada = jax.nn.silu(c) @ w_ada + b_ada
    sh1, sc1, gt1, sh2, sc2, gt2 = [a[:, None, :] for a in jnp.split(ada, 6, axis=-1)]
    h = x * (1 + sc1) + sh1
    proj = h @ w_in
    mq, mk, mv, mo, g_qkv, gz, mi, mf, gb, g_a = jnp.split(proj, np.cumsum(IN_SIZES)[:-1].tolist(), axis=-1)
    hm, C1, n1, m1 = mlstm_scan(mq.reshape(B, T, M_HEADS, M_HEAD_DIM), mk.reshape(B, T, M_HEADS, M_HEAD_DIM),
                                mv.reshape(B, T, M_HEADS, M_HEAD_DIM), mi + m_i_bias, mf + m_f_bias, C0, n0, m0)
    hm = head_rms_norm(hm, m_norm_g) * jax.nn.sigmoid(mo.astype(f32)).reshape(B, T, M_HEADS, M_HEAD_DIM)
    g_conv, conv1 = causal_conv(g_qkv, conv0, conv_w)
    gq, gk, gv = jnp.split(g_conv, 3, axis=-1)
    log_a = -jnp.exp(g_A_log.astype(f32)) * jax.nn.softplus((g_a + g_dt_bias).astype(f32))
    beta = jax.nn.sigmoid(gb.astype(f32))
    hg, S1 = gdn_scan(l2norm(gq.reshape(B, T, G_HEADS, G_HEAD_DIM)), l2norm(gk.reshape(B, T, G_HEADS, G_HEAD_DIM)),
                      gv.reshape(B, T, G_HEADS, G_HEAD_DIM), log_a, beta, S0)
    hg = head_rms_norm(hg, g_norm_g) * jax.nn.silu(gz.astype(f32)).reshape(B, T, G_HEADS, G_HEAD_DIM)
    mix = jnp.concatenate([hm.reshape(B, T, M_WIDTH), hg.reshape(B, T, G_WIDTH)], -1).astype(dt) @ w_out
    x = layer_norm(DEEPNORM_ALPHA * x + (1 + gt1) * mix, ln1_g, ln1_b)
    h2 = x * (1 + sc2) + sh2
    gate, up = jnp.split(h2 @ w_gu, 2, axis=-1)
    ffn = (jax.nn.silu(gate) * up) @ w_down
    x = layer_norm(DEEPNORM_ALPHA * x + (1 + gt2) * ffn, ln2_g, ln2_b)
    return x, C1.astype(dt), n1.astype(dt), m1.astype(dt), S1.astype(dt), conv1.astype(dt)


def setup_inputs(seed: int = 0) -> dict:
    key = jax.random.key(seed)
    ks = jax.random.split(key, 32)
    f32 = jnp.float32
    nrm = lambda k, shape, s: s * jax.random.normal(k, shape, f32)
    return {
        'x_prompt': nrm(ks[0], (BATCH, SEQ, D_MODEL), 1.0),
        'x_sample': nrm(ks[1], (DEC_BATCH, DEC_SEQ, D_MODEL), 1.0),
        'state_mlstm_C': nrm(ks[2], (DEC_BATCH, M_HEADS, M_HEAD_DIM, M_HEAD_DIM), 0.1),
        'state_mlstm_n': nrm(ks[3], (DEC_BATCH, M_HEADS, M_HEAD_DIM), 0.1),
        'state_mlstm_m': nrm(ks[4], (DEC_BATCH, M_HEADS), 1.0),
        'state_gdn_S': nrm(ks[5], (DEC_BATCH, G_HEADS, G_HEAD_DIM, G_HEAD_DIM), 0.1),
        'state_gdn_conv': nrm(ks[6], (DEC_BATCH, CONV_W - 1, 3 * G_WIDTH), 1.0),
        'c_prompt': nrm(ks[7], (BATCH, D_MODEL), 1.0),
        'c_sample': nrm(ks[8], (DEC_BATCH, D_MODEL), 1.0),
        'w_ada': nrm(ks[9], (D_MODEL, 6 * D_MODEL), 0.5 * D_MODEL ** -0.5),
        'b_ada': nrm(ks[10], (6 * D_MODEL,), 0.02),
        'w_in': nrm(ks[11], (D_MODEL, IN_COLS), D_MODEL ** -0.5),
        'm_i_bias': nrm(ks[12], (M_HEADS,), 0.1),
        'm_f_bias': 3.0 + nrm(ks[13], (M_HEADS,), 0.5),
        'm_norm_g': 1.0 + nrm(ks[14], (M_WIDTH,), 0.02),
        'conv_w': nrm(ks[15], (CONV_W, 3 * G_WIDTH), CONV_W ** -0.5),
        'g_dt_bias': nrm(ks[16], (G_HEADS,), 0.1),
        'g_A_log': jnp.log(jax.random.uniform(ks[17], (G_HEADS,), f32, 1.0, 16.0)),
        'g_norm_g': 1.0 + nrm(ks[18], (G_WIDTH,), 0.02),
        'w_out': nrm(ks[19], (MIX_WIDTH, D_MODEL), DEEPNORM_BETA * MIX_WIDTH ** -0.5),
        'ln1_g': 1.0 + nrm(ks[20], (D_MODEL,), 0.02),
        'ln1_b': nrm(ks[21], (D_MODEL,), 0.02),
        'w_gu': nrm(ks[22], (D_MODEL, 2 * D_FF), D_MODEL ** -0.5),
        'w_down': nrm(ks[23], (D_FF, D_MODEL), DEEPNORM_BETA * D_FF ** -0.5),
        'ln2_g': 1.0 + nrm(ks[24], (D_MODEL,), 0.02),
        'ln2_b': nrm(ks[25], (D_MODEL,), 0.02),
    }


def reference(x_prompt, x_sample, state_mlstm_C, state_mlstm_n, state_mlstm_m, state_gdn_S, state_gdn_conv,
              c_prompt, c_sample, w_ada, b_ada, w_in, m_i_bias, m_f_bias, m_norm_g, conv_w, g_dt_bias,
              g_A_log, g_norm_g, w_out, ln1_g, ln1_b, w_gu, w_down, ln2_g, ln2_b):
    f32 = jnp.float32
    Bp = x_prompt.shape[0]
    y_p = x_prompt
    y_s = x_sample
    for _ in range(DEPTH):
        y_p, p_C, p_n, p_m, p_S, p_conv = hybrid_layer(
            y_p, c_prompt,
            jnp.zeros((Bp, M_HEADS, M_HEAD_DIM, M_HEAD_DIM), f32), jnp.zeros((Bp, M_HEADS, M_HEAD_DIM), f32),
            jnp.zeros((Bp, M_HEADS), f32), jnp.zeros((Bp, G_HEADS, G_HEAD_DIM, G_HEAD_DIM), f32),
            jnp.zeros((Bp, CONV_W - 1, 3 * G_WIDTH), x_prompt.dtype),
            w_ada, b_ada, w_in, m_i_bias, m_f_bias, m_norm_g, conv_w, g_dt_bias, g_A_log, g_norm_g,
            w_out, ln1_g, ln1_b, w_gu, w_down, ln2_g, ln2_b)
        y_s, s_C, s_n, s_m, s_S, s_conv = hybrid_layer(
            y_s, c_sample, state_mlstm_C, state_mlstm_n, state_mlstm_m, state_gdn_S, state_gdn_conv,
            w_ada, b_ada, w_in, m_i_bias, m_f_bias, m_norm_g, conv_w, g_dt_bias, g_A_log, g_norm_g,
            w_out, ln1_g, ln1_b, w_gu, w_down, ln2_g, ln2_b)
    return (y_p, y_s, p_C, p_n, p_m, p_S, p_conv, s_C, s_n, s_m, s_S, s_conv)
```

```cpp
#include <hip/hip_runtime.h>
#include <hip/hip_cooperative_groups.h>
#include <cstdio>
namespace cg = cooperative_groups;

#ifndef FUSED
#define FUSED 1
#endif

#define DEVI __device__ __forceinline__
typedef unsigned short u16;
typedef short bf16x8 __attribute__((ext_vector_type(8)));
typedef float f32x4 __attribute__((ext_vector_type(4)));

constexpr int NTHR = 512;
constexpr int DM = 2048, NTOK = 8704, NPT = 8192, INC = 8216, DFF = 5632, ADAW = 12288;
constexpr int LDS_BYTES = 158 * 1024;
constexpr float ALPHA = 1.189207115002721f;

constexpr size_t O_YP = 0, O_PC = 17825792, O_PN = 18874368, O_PM = 18878464, O_PS = 18878480, O_PCONV = 19402768,
                 O_SC = 19439632, O_SN = 52994064, O_SM = 53125136, O_SS = 53125648, O_SCONV = 69902864;
constexpr size_t WS_WOUT = 0, WS_WGU = 8388608, WS_WDOWN = 54525952, WS_ADA = 77594624, WS_AC = 84082688,
                 WS_WIN = 85131264, WS_WADA = 119734272, WS_HBUF = WS_WIN, WS_AH = 170065920, WS_MIX = 205717504,
                 WS_PROJ = 241369088, WS_X1 = WS_PROJ, WS_ACT = WS_PROJ + 71303168, WS_END = 527417344;

struct Params {
    const float* x_prompt; const float* x_sample; const float* st_C; const float* st_n; const float* st_m; const float* st_S;
    const float* st_conv; const float* c_prompt; const float* c_sample; const float* w_ada; const float* b_ada; const float* w_in;
    const float* m_i_bias; const float* m_f_bias; const float* m_norm_g; const float* conv_w; const float* g_dt_bias;
    const float* g_A_log; const float* g_norm_g; const float* w_out; const float* ln1_g; const float* ln1_b; const float* w_gu;
    const float* w_down; const float* ln2_g; const float* ln2_b;
    float* out; unsigned char* ws;
    int ph_lo, ph_hi;
};

DEVI u16 f2bf(float f) { unsigned u = __float_as_uint(f); u += 0x7FFFu + ((u >> 16) & 1u); return (u16)(u >> 16); }
DEVI float bf2f(u16 b) { return __uint_as_float(((unsigned)b) << 16); }
DEVI unsigned pack2(float a, float b) { return (unsigned)f2bf(a) | ((unsigned)f2bf(b) << 16); }
DEVI float wsum(float v) { for (int o = 32; o; o >>= 1) v += __shfl_xor(v, o); return v; }
DEVI float sigmoidf_(float x) { return 1.f / (1.f + __expf(-x)); }
DEVI float siluf_(float x) { return x / (1.f + __expf(-x)); }
DEVI float softplusf_(float x) { return fmaxf(x, 0.f) + log1pf(__expf(-fabsf(x))); }
DEVI float logsigf_(float x) { return fminf(x, 0.f) - log1pf(__expf(-fabsf(x))); }
DEVI f32x4 mfma16(bf16x8 a, bf16x8 b, f32x4 c) { return __builtin_amdgcn_mfma_f32_16x16x32_bf16(a, b, c, 0, 0, 0); }
DEVI int tok_batch(int row) { return row < NPT ? (row >> 11) : 4 + ((row - NPT) >> 2); }
DEVI const float* x_row(const Params& p, int row) { return row < NPT ? p.x_prompt + (size_t)row * DM : p.x_sample + (size_t)(row - NPT) * DM; }

template <int MT, int NT>
DEVI void mma_lds(f32x4 (&acc)[MT][NT], const u16* A, int lda, const u16* B, int ldb, int K, int fr, int fq) {
    for (int k = 0; k < K; k += 32) {
        bf16x8 a[MT], b[NT];
#pragma unroll
        for (int m = 0; m < MT; ++m) a[m] = *(const bf16x8*)(A + (m * 16 + fr) * lda + k + fq * 8);
#pragma unroll
        for (int n = 0; n < NT; ++n) b[n] = *(const bf16x8*)(B + (n * 16 + fr) * ldb + k + fq * 8);
#pragma unroll
        for (int m = 0; m < MT; ++m)
#pragma unroll
            for (int n = 0; n < NT; ++n) acc[m][n] = mfma16(a[m], b[n], acc[m][n]);
    }
}

DEVI void transpose_tile(const float* src, int ldsrc, int nvalid, int k0, int c0, u16* dst, int ldd, u16* t) {
    const int tid = threadIdx.x;
#pragma unroll
    for (int i = 0; i < 2; ++i) {
        const int k = (tid >> 4) + 32 * i, n4 = (tid & 15) * 4;
        float4 v = make_float4(0.f, 0.f, 0.f, 0.f);
        if (c0 + n4 < nvalid) v = *(const float4*)(src + (size_t)(k0 + k) * ldsrc + c0 + n4);
        t[(n4 + 0) * 72 + k] = f2bf(v.x); t[(n4 + 1) * 72 + k] = f2bf(v.y); t[(n4 + 2) * 72 + k] = f2bf(v.z); t[(n4 + 3) * 72 + k] = f2bf(v.w);
    }
    __syncthreads();
    {
        const int n = tid >> 3, kc = tid & 7;
        *(uint4*)(dst + (size_t)n * ldd + k0 + kc * 8) = *(const uint4*)(t + n * 72 + kc * 8);
    }
    __syncthreads();
}

DEVI void phase_prep(const Params& p, char* smem) {
    u16* t = (u16*)smem;
    u16* WoutT = (u16*)(p.ws + WS_WOUT); u16* WguT = (u16*)(p.ws + WS_WGU); u16* WdownT = (u16*)(p.ws + WS_WDOWN);
    u16* WinT = (u16*)(p.ws + WS_WIN); u16* WadaT = (u16*)(p.ws + WS_WADA); u16* Ac = (u16*)(p.ws + WS_AC);
    constexpr int JA = 32 * 192, JB = 32 * 132, JC = 32 * 32, JD = 32 * 176, JE = 88 * 32;
    constexpr int TOT = JA + JB + JC + JD + JE;
    for (int job = blockIdx.x; job < TOT; job += gridDim.x) {
        int j = job;
        if (j < JA) { const int kt = j & 31, rt = j >> 5; transpose_tile(p.w_ada, ADAW, ADAW, kt * 64, rt * 64, WadaT + (size_t)rt * 64 * DM, DM, t); continue; }
        j -= JA;
        if (j < JB) { const int kt = j & 31, rt = j >> 5; transpose_tile(p.w_in, INC, INC, kt * 64, rt * 64, WinT + (size_t)rt * 64 * DM, DM, t); continue; }
        j -= JB;
        if (j < JC) { const int kt = j & 31, rt = j >> 5; transpose_tile(p.w_out, DM, DM, kt * 64, rt * 64, WoutT + (size_t)rt * 64 * DM, DM, t); continue; }
        j -= JC;
        if (j < JD) { const int kt = j & 31, rt = j >> 5; const int jj = rt >> 2, sub = rt & 3;
            const int c0 = (sub < 2) ? (128 * jj + 64 * sub) : (DFF + 128 * jj + 64 * (sub - 2));
            transpose_tile(p.w_gu, 2 * DFF, 2 * DFF, kt * 64, c0, WguT + (size_t)rt * 64 * DM, DM, t); continue; }
        j -= JD;
        { const int kt = j % 88, rt = j / 88; transpose_tile(p.w_down, DM, DM, kt * 64, rt * 64, WdownT + (size_t)rt * 64 * DFF, DFF, t); }
    }
    for (int i = blockIdx.x * NTHR + threadIdx.x; i < 256 * DM; i += gridDim.x * NTHR) {
        const int r = i >> 11, c = i & 2047;
        float v = 0.f;
        if (r < 4) v = siluf_(p.c_prompt[r * DM + c]); else if (r < 132) v = siluf_(p.c_sample[(r - 4) * DM + c]);
        Ac[i] = f2bf(v);
    }
}

template <class Epi>
DEVI void gemm_phase(const u16* __restrict__ A, const u16* __restrict__ Bt, int M, int N, int K, char* smem, const Epi& epi) {
    constexpr int LDT = 72;
    u16* As = (u16*)smem;
    u16* Bs = As + 2 * 128 * LDT;
    const int tid = threadIdx.x, lane = tid & 63, wid = tid >> 6, wr = wid >> 2, wc = wid & 3, fr = lane & 15, fq = lane >> 4;
    const int nM = M / 128, nN = N / 256, ntiles = nM * nN, nk = K / 64;
    const int lrow = tid >> 3, lc = (tid & 7) * 8;
    for (int tile = blockIdx.x; tile < ntiles; tile += gridDim.x) {
        const int pm = tile % nM, pn = tile / nM;
        const u16* Ag = A + (size_t)(pm * 128 + lrow) * K + lc;
        const u16* Bg = Bt + (size_t)(pn * 256 + lrow) * K + lc;
        f32x4 acc[4][4];
#pragma unroll
        for (int m = 0; m < 4; ++m)
#pragma unroll
            for (int n = 0; n < 4; ++n) acc[m][n] = (f32x4){0.f, 0.f, 0.f, 0.f};
        uint4 ra[2], rb[4];
#pragma unroll
        for (int i = 0; i < 2; ++i) ra[i] = *(const uint4*)(Ag + (size_t)(i * 64) * K);
#pragma unroll
        for (int i = 0; i < 4; ++i) rb[i] = *(const uint4*)(Bg + (size_t)(i * 64) * K);
#pragma unroll
        for (int i = 0; i < 2; ++i) *(uint4*)(As + (lrow + i * 64) * LDT + lc) = ra[i];
#pragma unroll
        for (int i = 0; i < 4; ++i) *(uint4*)(Bs + (lrow + i * 64) * LDT + lc) = rb[i];
        __syncthreads();
        for (int kt = 0; kt < nk; ++kt) {
            const int buf = kt & 1;
            if (kt + 1 < nk) {
#pragma unroll
                for (int i = 0; i < 2; ++i) ra[i] = *(const uint4*)(Ag + (size_t)(i * 64) * K + (kt + 1) * 64);
#pragma unroll
                for (int i = 0; i < 4; ++i) rb[i] = *(const uint4*)(Bg + (size_t)(i * 64) * K + (kt + 1) * 64);
            }
            const u16* as = As + buf * 128 * LDT + (wr * 64 + fr) * LDT + fq * 8;
            const u16* bs = Bs + buf * 256 * LDT + (wc * 32 + fr) * LDT + fq * 8;
#pragma unroll
            for (int k2 = 0; k2 < 2; ++k2) {
                bf16x8 a[4], b[4];
#pragma unroll
                for (int m = 0; m < 4; ++m) a[m] = *(const bf16x8*)(as + m * 16 * LDT + k2 * 32);
#pragma unroll
                for (int n = 0; n < 4; ++n) b[n] = *(const bf16x8*)(bs + ((n >> 1) * 128 + (n & 1) * 16) * LDT + k2 * 32);
#pragma unroll
                for (int m = 0; m < 4; ++m)
#pragma unroll
                    for (int n = 0; n < 4; ++n) acc[m][n] = mfma16(b[n], a[m], acc[m][n]);
            }
            if (kt + 1 < nk) {
                u16* as2 = As + (buf ^ 1) * 128 * LDT; u16* bs2 = Bs + (buf ^ 1) * 256 * LDT;
#pragma unroll
                for (int i = 0; i < 2; ++i) *(uint4*)(as2 + (lrow + i * 64) * LDT + lc) = ra[i];
#pragma unroll
                for (int i = 0; i < 4; ++i) *(uint4*)(bs2 + (lrow + i * 64) * LDT + lc) = rb[i];
            }
            __syncthreads();
        }
        epi(acc, pm, pn, wr, wc, fr, fq);
    }
}

struct EpiAda { float* ada; const float* b_ada;
    DEVI void operator()(const f32x4 (&acc)[4][4], int pm, int pn, int wr, int wc, int fr, int fq) const {
#pragma unroll
        for (int m = 0; m < 4; ++m) { const int row = pm * 128 + wr * 64 + m * 16 + fr; if (row >= 132) continue;
#pragma unroll
            for (int n = 0; n < 4; ++n) { const int col = pn * 256 + (n >> 1) * 128 + wc * 32 + (n & 1) * 16 + fq * 4;
                const f32x4 bv = *(const f32x4*)(b_ada + col); *(f32x4*)(ada + (size_t)row * ADAW + col) = acc[m][n] + bv; } }
    } };
struct EpiProj { float* proj;
    DEVI void operator()(const f32x4 (&acc)[4][4], int pm, int pn, int wr, int wc, int fr, int fq) const {
#pragma unroll
        for (int m = 0; m < 4; ++m) { const int row = pm * 128 + wr * 64 + m * 16 + fr;
#pragma unroll
            for (int n = 0; n < 4; ++n) { const int col = pn * 256 + (n >> 1) * 128 + wc * 32 + (n & 1) * 16 + fq * 4;
                if (col < INC) *(f32x4*)(proj + (size_t)row * INC + col) = acc[m][n]; } }
    } };
struct EpiRes { const float* xp; const float* xs; const float* res;   const float* ada; int gofs; float* out;
    DEVI void operator()(const f32x4 (&acc)[4][4], int pm, int pn, int wr, int wc, int fr, int fq) const {
#pragma unroll
        for (int m = 0; m < 4; ++m) { const int row = pm * 128 + wr * 64 + m * 16 + fr; const int b = tok_batch(row);
            const float* rp = res ? res + (size_t)row * DM : (row < NPT ? xp + (size_t)row * DM : xs + (size_t)(row - NPT) * DM);
#pragma unroll
            for (int n = 0; n < 4; ++n) { const int col = pn * 256 + (n >> 1) * 128 + wc * 32 + (n & 1) * 16 + fq * 4;
                const f32x4 g = *(const f32x4*)(ada + (size_t)b * ADAW + gofs + col); const f32x4 r = *(const f32x4*)(rp + col);
                *(f32x4*)(out + (size_t)row * DM + col) = ALPHA * r + (1.f + g) * acc[m][n]; } }
    } };
struct EpiGU { u16* act;
    DEVI void operator()(const f32x4 (&acc)[4][4], int pm, int pn, int wr, int wc, int fr, int fq) const {
#pragma unroll
        for (int m = 0; m < 4; ++m) { const int row = pm * 128 + wr * 64 + m * 16 + fr;
#pragma unroll
            for (int n = 0; n < 2; ++n) { const int col = pn * 128 + wc * 32 + n * 16 + fq * 4;
                const f32x4 g = acc[m][n], u = acc[m][n + 2];
                uint2 w; w.x = pack2(siluf_(g[0]) * u[0], siluf_(g[1]) * u[1]); w.y = pack2(siluf_(g[2]) * u[2], siluf_(g[3]) * u[3]);
                *(uint2*)(act + (size_t)row * DFF + col) = w; } }
    } };

DEVI void phase_modulate(const Params& p) {
    const float* ada = (const float*)(p.ws + WS_ADA); u16* Ah = (u16*)(p.ws + WS_AH);
    const int lane = threadIdx.x & 63, gw = blockIdx.x * 8 + (threadIdx.x >> 6), nw = gridDim.x * 8;
    for (int row = gw; row < NTOK; row += nw) {
        const float* xr = x_row(p, row); const float* ar = ada + (size_t)tok_batch(row) * ADAW;
#pragma unroll
        for (int i = 0; i < 8; ++i) { const int col = i * 256 + lane * 4;
            const f32x4 x = *(const f32x4*)(xr + col), sh = *(const f32x4*)(ar + col), sc = *(const f32x4*)(ar + DM + col);
            const f32x4 h = x * (1.f + sc) + sh; uint2 w; w.x = pack2(h[0], h[1]); w.y = pack2(h[2], h[3]);
            *(uint2*)(Ah + (size_t)row * DM + col) = w; }
    }
}
DEVI void ln_row(f32x4 (&v)[8], const float* g, const float* bta, int lane) {
    float s = 0.f;
#pragma unroll
    for (int i = 0; i < 8; ++i) s += v[i][0] + v[i][1] + v[i][2] + v[i][3];
    const float mu = wsum(s) * (1.f / DM);
    float q = 0.f;
#pragma unroll
    for (int i = 0; i < 8; ++i) { v[i] = v[i] - mu; q += v[i][0] * v[i][0] + v[i][1] * v[i][1] + v[i][2] * v[i][2] + v[i][3] * v[i][3]; }
    const float rs = rsqrtf(wsum(q) * (1.f / DM) + 1e-5f);
#pragma unroll
    for (int i = 0; i < 8; ++i) { const int col = i * 256 + lane * 4; v[i] = v[i] * rs * *(const f32x4*)(g + col) + *(const f32x4*)(bta + col); }
}
DEVI void phase_ln1(const Params& p) {
    const float* ada = (const float*)(p.ws + WS_ADA); u16* Ah = (u16*)(p.ws + WS_AH); float* x1 = (float*)(p.ws + WS_X1);
    const int lane = threadIdx.x & 63, gw = blockIdx.x * 8 + (threadIdx.x >> 6), nw = gridDim.x * 8;
    for (int row = gw; row < NTOK; row += nw) {
        float* xr = x1 + (size_t)row * DM; const float* ar = ada + (size_t)tok_batch(row) * ADAW;
        f32x4 v[8];
#pragma unroll
        for (int i = 0; i < 8; ++i) v[i] = *(const f32x4*)(xr + i * 256 + lane * 4);
        ln_row(v, p.ln1_g, p.ln1_b, lane);
#pragma unroll
        for (int i = 0; i < 8; ++i) { const int col = i * 256 + lane * 4; *(f32x4*)(xr + col) = v[i];
            const f32x4 sh = *(const f32x4*)(ar + 3 * DM + col), sc = *(const f32x4*)(ar + 4 * DM + col);
            const f32x4 h = v[i] * (1.f + sc) + sh; uint2 w; w.x = pack2(h[0], h[1]); w.y = pack2(h[2], h[3]);
            *(uint2*)(Ah + (size_t)row * DM + col) = w; }
    }
}
DEVI void phase_ln2(const Params& p) {
    const int lane = threadIdx.x & 63, gw = blockIdx.x * 8 + (threadIdx.x >> 6), nw = gridDim.x * 8;
    for (int row = gw; row < NTOK; row += nw) {
        float* xr = p.out + O_YP + (size_t)row * DM;
        f32x4 v[8];
#pragma unroll
        for (int i = 0; i < 8; ++i) v[i] = *(const f32x4*)(xr + i * 256 + lane * 4);
        ln_row(v, p.ln2_g, p.ln2_b, lane);
#pragma unroll
        for (int i = 0; i < 8; ++i) *(f32x4*)(xr + i * 256 + lane * 4) = v[i];
    }
}
DEVI void phase_post(const Params& p) {
    const float* proj = (const float*)(p.ws + WS_PROJ); const float* hbuf = (const float*)(p.ws + WS_HBUF); u16* mix = (u16*)(p.ws + WS_MIX);
    const int lane = threadIdx.x & 63, gw = blockIdx.x * 8 + (threadIdx.x >> 6), nw = gridDim.x * 8;
    for (int row = gw; row < NPT; row += nw) {
        const float* hr = hbuf + (size_t)row * DM; const float* pr = proj + (size_t)row * INC; u16* mr = mix + (size_t)row * DM;
#pragma unroll
        for (int h = 0; h < 4; ++h) { const int col = h * 256 + lane * 4;
            const f32x4 v = *(const f32x4*)(hr + col); const float ss = wsum(v[0] * v[0] + v[1] * v[1] + v[2] * v[2] + v[3] * v[3]);
            const float rs = rsqrtf(ss * (1.f / 256.f) + 1e-6f);
            const f32x4 g = *(const f32x4*)(p.m_norm_g + col), o = *(const f32x4*)(pr + 3072 + col);
            uint2 w; w.x = pack2(v[0] * rs * g[0] * sigmoidf_(o[0]), v[1] * rs * g[1] * sigmoidf_(o[1]));
            w.y = pack2(v[2] * rs * g[2] * sigmoidf_(o[2]), v[3] * rs * g[3] * sigmoidf_(o[3]));
            *(uint2*)(mr + col) = w; }
#pragma unroll
        for (int h = 0; h < 8; ++h) { const int c = h * 128 + lane * 2;
            const float v0 = hr[1024 + c], v1 = hr[1024 + c + 1]; const float ss = wsum(v0 * v0 + v1 * v1);
            const float rs = rsqrtf(ss * (1.f / 128.f) + 1e-6f);
            const float z0 = pr[7168 + c], z1 = pr[7168 + c + 1];
            *(unsigned*)(mr + 1024 + c) = pack2(v0 * rs * p.g_norm_g[c] * siluf_(z0), v1 * rs * p.g_norm_g[c + 1] * siluf_(z1)); }
    }
    const int total = (4 + 128) * 3 * 3072;
    for (int i = blockIdx.x * NTHR + threadIdx.x; i < total; i += gridDim.x * NTHR) {
        const int ch = i % 3072, rj = i / 3072, j = rj % 3, b = rj / 3;
        if (b < 4) p.out[O_PCONV + (size_t)(b * 3 + j) * 3072 + ch] = proj[(size_t)(b * 2048 + 2045 + j) * INC + 4096 + ch];
        else p.out[O_SCONV + (size_t)((b - 4) * 3 + j) * 3072 + ch] = proj[(size_t)(NPT + (b - 4) * 4 + 1 + j) * INC + 4096 + ch];
    }
}

DEVI float scan_add(float x, int lane) { for (int o = 1; o < 64; o <<= 1) { const float y = __shfl_up(x, o); if (lane >= o) x += y; } return x; }
DEVI float scan_max(float x, int lane) { for (int o = 1; o < 64; o <<= 1) { const float y = __shfl_up(x, o); if (lane >= o) x = fmaxf(x, y); } return x; }

DEVI void mlstm_prompt(const Params& p, int role, char* smem) {
    const int tid = threadIdx.x, lane0 = tid & 63, w0 = tid >> 6;
    const int b = role >> 4, h = (role >> 2) & 3, eb = role & 3;
    u16* Ks = (u16*)smem;
    u16* Kts = Ks + 64 * 264;
    u16* Cts = Kts + 256 * 72;
    u16* Vts = Cts + 80 * 264;
    u16* Vws = Vts + 80 * 72;
    u16* Ps = Vws + 80 * 72;
    for (int i = tid; i < 80 * 264 / 2; i += NTHR) ((unsigned*)Cts)[i] = 0u;
    for (int i = tid; i < 80 * 72; i += NTHR) ((unsigned*)Vts)[i] = 0u;
    const float* proj = (const float*)(p.ws + WS_PROJ); float* hbuf = (float*)(p.ws + WS_HBUF);
    const float ib = p.m_i_bias[h], fb = p.m_f_bias[h];
    f32x4 accC[5][2];
#pragma unroll
    for (int m = 0; m < 5; ++m) { accC[m][0] = (f32x4){0.f, 0.f, 0.f, 0.f}; accC[m][1] = (f32x4){0.f, 0.f, 0.f, 0.f}; }
    float mcar = 0.f;
    __syncthreads();
    for (int c = 0; c < 32; ++c) {
        int lane = lane0, w = w0; asm volatile("" : "+v"(lane), "+v"(w));
        const int fr = lane & 15, fq = lane >> 4, mt = w & 3, g = w >> 2, et0 = g * 2;
        const size_t row0 = (size_t)b * 2048 + c * 64;
        const float iv = proj[(row0 + lane) * INC + 8192 + h] + ib;
        const float fv = proj[(row0 + lane) * INC + 8196 + h] + fb;
        const float bt = scan_add(logsigf_(fv), lane);
        const float av = iv - bt;
        const float mr = fmaxf(scan_max(av, lane), mcar);
        const float bL = __shfl(bt, 63), mnew = bL + __shfl(mr, 63);
        const float wgt = __expf(bL + av - mnew), decay = __expf(bL + mcar - mnew);
        const float flo = __expf(-(bt + mr)), iw = __expf(mcar - mr);
        __builtin_amdgcn_sched_barrier(0);
        if (c > 0) {
#pragma unroll
            for (int m = 0; m < 5; ++m)
#pragma unroll
                for (int n = 0; n < 2; ++n)
#pragma unroll
                    for (int j = 0; j < 4; ++j) Cts[(m * 16 + fq * 4 + j) * 264 + w * 32 + n * 16 + fr] = f2bf(accC[m][n][j]);
        }
        __builtin_amdgcn_sched_barrier(0);
#pragma unroll 2
        for (int i = 0; i < 8; ++i) { const int s = w * 8 + i;
            const f32x4 kv = *(const f32x4*)(proj + (row0 + s) * INC + 1024 + h * 256 + lane * 4) * 0.0625f;
            const u16 k0 = f2bf(kv[0]), k1 = f2bf(kv[1]), k2 = f2bf(kv[2]), k3 = f2bf(kv[3]);
            uint2 pk; pk.x = (unsigned)k0 | ((unsigned)k1 << 16); pk.y = (unsigned)k2 | ((unsigned)k3 << 16);
            *(uint2*)(Ks + s * 264 + lane * 4) = pk;
            Kts[(lane * 4 + 0) * 72 + s] = k0; Kts[(lane * 4 + 1) * 72 + s] = k1; Kts[(lane * 4 + 2) * 72 + s] = k2; Kts[(lane * 4 + 3) * 72 + s] = k3;
            const float v = proj[(row0 + s) * INC + 2048 + h * 256 + eb * 64 + lane]; const float ws_ = __shfl(wgt, s);
            Vts[lane * 72 + s] = f2bf(v); Vws[lane * 72 + s] = f2bf(v * ws_); }
        if (w == 0) { Vts[64 * 72 + lane] = 0x3F80; Vws[64 * 72 + lane] = f2bf(wgt); }
        __builtin_amdgcn_sched_barrier(0);
        bf16x8 qf[8];
        { const float* qp = proj + (row0 + mt * 16 + fr) * INC + h * 256 + fq * 8;
#pragma unroll
            for (int kk = 0; kk < 8; ++kk) { const f32x4 x0 = *(const f32x4*)(qp + kk * 32), x1 = *(const f32x4*)(qp + kk * 32 + 4);
                bf16x8 q; q[0] = (short)f2bf(x0[0]); q[1] = (short)f2bf(x0[1]); q[2] = (short)f2bf(x0[2]); q[3] = (short)f2bf(x0[3]);
                q[4] = (short)f2bf(x1[0]); q[5] = (short)f2bf(x1[1]); q[6] = (short)f2bf(x1[2]); q[7] = (short)f2bf(x1[3]); qf[kk] = q; } }
        __syncthreads();
        __builtin_amdgcn_sched_barrier(0);
        f32x4 accS[2], accH[3];
        accS[0] = accS[1] = accH[0] = accH[1] = accH[2] = (f32x4){0.f, 0.f, 0.f, 0.f};
#pragma unroll
        for (int kk = 0; kk < 8; ++kk) {
#pragma unroll
            for (int n = 0; n < 2; ++n) accS[n] = mfma16(qf[kk], *(const bf16x8*)(Ks + ((g * 2 + n) * 16 + fr) * 264 + kk * 32 + fq * 8), accS[n]);
#pragma unroll
            for (int n = 0; n < 3; ++n) { const int et = n < 2 ? et0 + n : 4;
                accH[n] = mfma16(qf[kk], *(const bf16x8*)(Cts + (et * 16 + fr) * 264 + kk * 32 + fq * 8), accH[n]); }
            __builtin_amdgcn_sched_barrier(0);
        }
#pragma unroll
        for (int n = 0; n < 2; ++n) { const int s = (g * 2 + n) * 16 + fr; const float as_ = __shfl(av, s);
#pragma unroll
            for (int j = 0; j < 4; ++j) { const int t = mt * 16 + fq * 4 + j; const float mrt = __shfl(mr, t);
                const float pv = (s <= t) ? accS[n][j] * __expf(as_ - mrt) : 0.f; Ps[t * 72 + s] = f2bf(pv); } }
#pragma unroll
        for (int j = 0; j < 4; ++j) { const float iwt = __shfl(iw, mt * 16 + fq * 4 + j);
#pragma unroll
            for (int n = 0; n < 3; ++n) accH[n][j] *= iwt; }
        __syncthreads();
        __builtin_amdgcn_sched_barrier(0);
#pragma unroll
        for (int k = 0; k < 64; k += 32) { const bf16x8 a = *(const bf16x8*)(Ps + (mt * 16 + fr) * 72 + k + fq * 8);
#pragma unroll
            for (int n = 0; n < 3; ++n) { const int et = n < 2 ? et0 + n : 4;
                accH[n] = mfma16(a, *(const bf16x8*)(Vts + (et * 16 + fr) * 72 + k + fq * 8), accH[n]); } }
#pragma unroll
        for (int j = 0; j < 4; ++j) { const int t = mt * 16 + fq * 4 + j;
            const float den = __shfl(accH[2][j], fq * 16); const float fl = __shfl(flo, t); const float dn = fmaxf(fabsf(den), fl);
#pragma unroll
            for (int n = 0; n < 2; ++n) hbuf[(row0 + t) * DM + h * 256 + eb * 64 + (et0 + n) * 16 + fr] = accH[n][j] / dn; }
#pragma unroll
        for (int m = 0; m < 5; ++m) { accC[m][0] *= decay; accC[m][1] *= decay; }
        mma_lds<5, 2>(accC, Vws, 72, Kts + (w * 32) * 72, 72, 64, fr, fq);
        mcar = mnew;
        __syncthreads();
    }
    const int lane = lane0, w = w0, fr = lane & 15, fq = lane >> 4;
    float* pC = p.out + O_PC + (size_t)(b * 4 + h) * 65536;
#pragma unroll
    for (int m = 0; m < 4; ++m)
#pragma unroll
        for (int n = 0; n < 2; ++n) *(f32x4*)(pC + (size_t)(w * 32 + n * 16 + fr) * 256 + eb * 64 + m * 16 + fq * 4) = accC[m][n];
    if (eb == 0 && fq == 0) { p.out[O_PN + (b * 4 + h) * 256 + w * 32 + fr] = accC[4][0][0]; p.out[O_PN + (b * 4 + h) * 256 + w * 32 + 16 + fr] = accC[4][1][0]; }
    if (eb == 0 && tid == 0) p.out[O_PM + b * 4 + h] = mcar;
    __syncthreads();
}

DEVI void gdn_prompt(const Params& p, int role, char* smem) {
    const int tid = threadIdx.x, lane0 = tid & 63, w0 = tid >> 6;
    const int b = role >> 4, h = (role >> 1) & 7, eb = role & 1;
    u16* Ks = (u16*)smem;
    u16* Qs = Ks + 64 * 136;
    u16* Kws = Qs + 64 * 136;
    u16* Sts = Kws + 128 * 72;
    u16* Vs = Sts + 64 * 136;
    u16* Mb = Vs + 64 * 72;
    u16* Mtb = Mb + 2 * 64 * 72;
    u16* Ts = Mtb + 2 * 64 * 72;
    u16* Ps = Ts + 64 * 72;
    u16* Rts = Ps + 64 * 72;
    u16* Uts = Rts + 64 * 72;
    for (int i = tid; i < 64 * 136 / 2; i += NTHR) ((unsigned*)Sts)[i] = 0u;
    const float* proj = (const float*)(p.ws + WS_PROJ); float* hbuf = (float*)(p.ws + WS_HBUF);
    const float dtb = p.g_dt_bias[h], Aexp = __expf(p.g_A_log[h]);
    const int chq = h * 128 + 2 * lane0, chk = 1024 + h * 128 + 2 * lane0, chv = 2048 + h * 128 + eb * 64 + lane0;
    float cwq0[4], cwq1[4], cwk0[4], cwk1[4], cwv[4];
#pragma unroll
    for (int j = 0; j < 4; ++j) { cwq0[j] = p.conv_w[j * 3072 + chq]; cwq1[j] = p.conv_w[j * 3072 + chq + 1]; cwk0[j] = p.conv_w[j * 3072 + chk];
        cwk1[j] = p.conv_w[j * 3072 + chk + 1]; cwv[j] = p.conv_w[j * 3072 + chv]; }
    f32x4 accSt[4];
#pragma unroll
    for (int m = 0; m < 4; ++m) accSt[m] = (f32x4){0.f, 0.f, 0.f, 0.f};
    __syncthreads();
    for (int c = 0; c < 32; ++c) {
        int lane = lane0, w = w0; asm volatile("" : "+v"(lane), "+v"(w));
        const int fr = lane & 15, fq = lane >> 4, mt = w & 3, g = w >> 2;
        const long row0 = (long)b * 2048 + c * 64;
        const float ga = proj[(row0 + lane) * INC + 8208 + h] + dtb;
        const float la = -Aexp * softplusf_(ga);
        const float beta = sigmoidf_(proj[(row0 + lane) * INC + 8200 + h]);
        const float bc = scan_add(la, lane);
        const float bL = __shfl(bc, 63);
        const float eb_ = __expf(bc);
        __builtin_amdgcn_sched_barrier(0);
        if (c > 0) {
#pragma unroll
            for (int m = 0; m < 4; ++m)
#pragma unroll
                for (int j = 0; j < 4; ++j) Sts[(m * 16 + fq * 4 + j) * 136 + w * 16 + fr] = f2bf(accSt[m][j]);
        }
        __builtin_amdgcn_sched_barrier(0);
        {
            float xq0[3], xq1[3], xk0[3], xk1[3], xv[3];
#pragma unroll
            for (int j = 0; j < 3; ++j) { const long tg = (long)c * 64 + w * 8 - 3 + j;
                if (tg >= 0) { const float* pr = proj + ((long)b * 2048 + tg) * INC + 4096;
                    xq0[j] = pr[chq]; xq1[j] = pr[chq + 1]; xk0[j] = pr[chk]; xk1[j] = pr[chk + 1]; xv[j] = pr[chv]; }
                else { xq0[j] = xq1[j] = xk0[j] = xk1[j] = xv[j] = 0.f; } }
#pragma unroll 1
            for (int i = 0; i < 8; ++i) { const int s = w * 8 + i; const float* pr = proj + (row0 + s) * INC + 4096;
                const float nq0 = pr[chq], nq1 = pr[chq + 1], nk0 = pr[chk], nk1 = pr[chk + 1], nv = pr[chv];
                float yq0 = cwq0[0] * xq0[0] + cwq0[1] * xq0[1] + cwq0[2] * xq0[2] + cwq0[3] * nq0;
                float yq1 = cwq1[0] * xq1[0] + cwq1[1] * xq1[1] + cwq1[2] * xq1[2] + cwq1[3] * nq1;
                float yk0 = cwk0[0] * xk0[0] + cwk0[1] * xk0[1] + cwk0[2] * xk0[2] + cwk0[3] * nk0;
                float yk1 = cwk1[0] * xk1[0] + cwk1[1] * xk1[1] + cwk1[2] * xk1[2] + cwk1[3] * nk1;
                float yv = cwv[0] * xv[0] + cwv[1] * xv[1] + cwv[2] * xv[2] + cwv[3] * nv;
                xq0[0] = xq0[1]; xq0[1] = xq0[2]; xq0[2] = nq0; xq1[0] = xq1[1]; xq1[1] = xq1[2]; xq1[2] = nq1;
                xk0[0] = xk0[1]; xk0[1] = xk0[2]; xk0[2] = nk0; xk1[0] = xk1[1]; xk1[1] = xk1[2]; xk1[2] = nk1;
                xv[0] = xv[1]; xv[1] = xv[2]; xv[2] = nv;
                yq0 = siluf_(yq0); yq1 = siluf_(yq1); yk0 = siluf_(yk0); yk1 = siluf_(yk1); yv = siluf_(yv);
                const float rq = rsqrtf(wsum(yq0 * yq0 + yq1 * yq1) + 1e-6f) * 0.08838834764831845f;
                const float rk = rsqrtf(wsum(yk0 * yk0 + yk1 * yk1) + 1e-6f);
                yq0 *= rq; yq1 *= rq; yk0 *= rk; yk1 *= rk;
                *(unsigned*)(Qs + s * 136 + 2 * lane) = pack2(yq0, yq1);
                *(unsigned*)(Ks + s * 136 + 2 * lane) = pack2(yk0, yk1);
                const float wk = __expf(bL - __shfl(bc, s));
                Kws[(2 * lane) * 72 + s] = f2bf(yk0 * wk); Kws[(2 * lane + 1) * 72 + s] = f2bf(yk1 * wk);
                Vs[s * 72 + lane] = f2bf(yv); }
        }
        __syncthreads();
        __builtin_amdgcn_sched_barrier(0);
        f32x4 aKK[2], aQK[2], aKS[2], accO[2];
#pragma unroll
        for (int n = 0; n < 2; ++n) aKK[n] = aQK[n] = aKS[n] = accO[n] = (f32x4){0.f, 0.f, 0.f, 0.f};
#pragma unroll
        for (int k = 0; k < 128; k += 32) {
            const bf16x8 fK = *(const bf16x8*)(Ks + (mt * 16 + fr) * 136 + k + fq * 8), fQ = *(const bf16x8*)(Qs + (mt * 16 + fr) * 136 + k + fq * 8);
#pragma unroll
            for (int n = 0; n < 2; ++n) { const bf16x8 bK = *(const bf16x8*)(Ks + ((g * 2 + n) * 16 + fr) * 136 + k + fq * 8);
                const bf16x8 bS = *(const bf16x8*)(Sts + ((g * 2 + n) * 16 + fr) * 136 + k + fq * 8);
                aKK[n] = mfma16(fK, bK, aKK[n]); aQK[n] = mfma16(fQ, bK, aQK[n]); aKS[n] = mfma16(fK, bS, aKS[n]); accO[n] = mfma16(fQ, bS, accO[n]); }
            __builtin_amdgcn_sched_barrier(0);
        }
#pragma unroll
        for (int n = 0; n < 2; ++n) { const int s = (g * 2 + n) * 16 + fr; const float bs_ = __shfl(bc, s);
#pragma unroll
            for (int j = 0; j < 4; ++j) { const int l = mt * 16 + fq * 4 + j; const float bl = __shfl(bc, l), betl = __shfl(beta, l), ebl = __shfl(eb_, l);
                const float dec = __expf(fminf(bl - bs_, 0.f));
                const float nm = (s < l) ? -betl * aKK[n][j] * dec : 0.f; const u16 nmb = f2bf(nm);
                Mb[l * 72 + s] = nmb; Mtb[s * 72 + l] = nmb; Ts[l * 72 + s] = (l == s) ? (u16)0x3F80 : nmb;
                Ps[l * 72 + s] = f2bf((s <= l) ? aQK[n][j] * dec : 0.f);
                const float r = betl * (bf2f(Vs[l * 72 + s]) - ebl * aKS[n][j]);
                Rts[s * 72 + l] = f2bf(r);
                accO[n][j] *= ebl; } }
        __syncthreads();
        __builtin_amdgcn_sched_barrier(0);
        f32x4 accT[4];
        if (w >= 4) {
#pragma unroll
            for (int n = 0; n < 4; ++n)
#pragma unroll
                for (int j = 0; j < 4; ++j) accT[n][j] = bf2f(Ts[((w - 4) * 16 + fq * 4 + j) * 72 + n * 16 + fr]);
        }
        for (int k = 1; k <= 6; ++k) {
            const int cur = (k - 1) & 1;
            const u16* Mc = Mb + cur * 64 * 72; const u16* Mtc = Mtb + cur * 64 * 72;
            if (w < 4) {
                if (k <= 5) {
                    f32x4 am[1][4];
#pragma unroll
                    for (int n = 0; n < 4; ++n) am[0][n] = (f32x4){0.f, 0.f, 0.f, 0.f};
                    mma_lds<1, 4>(am, Mc + (w * 16) * 72, 72, Mtc, 72, 64, fr, fq);
                    u16* Mn = Mb + (cur ^ 1) * 64 * 72; u16* Mtn = Mtb + (cur ^ 1) * 64 * 72;
#pragma unroll
                    for (int n = 0; n < 4; ++n)
#pragma unroll
                        for (int j = 0; j < 4; ++j) { const int l = w * 16 + fq * 4 + j, s = n * 16 + fr; const u16 v = f2bf(am[0][n][j]); Mn[l * 72 + s] = v; Mtn[s * 72 + l] = v; }
                }
            } else if (k >= 2) {
                f32x4 at[1][4];
#pragma unroll
                for (int n = 0; n < 4; ++n) at[0][n] = accT[n];
                mma_lds<1, 4>(at, Ts + ((w - 4) * 16) * 72, 72, Mtc, 72, 64, fr, fq);
#pragma unroll
                for (int n = 0; n < 4; ++n) { accT[n] = at[0][n];
#pragma unroll
                    for (int j = 0; j < 4; ++j) Ts[((w - 4) * 16 + fq * 4 + j) * 72 + n * 16 + fr] = f2bf(accT[n][j]); }
            }
            __syncthreads();
        }
        __builtin_amdgcn_sched_barrier(0);
        {
            f32x4 au[1][2]; au[0][0] = au[0][1] = (f32x4){0.f, 0.f, 0.f, 0.f};
            mma_lds<1, 2>(au, Ts + (mt * 16) * 72, 72, Rts + (g * 32) * 72, 72, 64, fr, fq);
#pragma unroll
            for (int n = 0; n < 2; ++n)
#pragma unroll
                for (int j = 0; j < 4; ++j) Uts[((g * 2 + n) * 16 + fr) * 72 + mt * 16 + fq * 4 + j] = f2bf(au[0][n][j]);
        }
        __syncthreads();
        __builtin_amdgcn_sched_barrier(0);
        {
            f32x4 ao[1][2]; ao[0][0] = accO[0]; ao[0][1] = accO[1];
            mma_lds<1, 2>(ao, Ps + (mt * 16) * 72, 72, Uts + (g * 32) * 72, 72, 64, fr, fq);
#pragma unroll
            for (int n = 0; n < 2; ++n)
#pragma unroll
                for (int j = 0; j < 4; ++j) hbuf[(row0 + mt * 16 + fq * 4 + j) * DM + 1024 + h * 128 + eb * 64 + (g * 2 + n) * 16 + fr] = ao[0][n][j];
            const float dL = __expf(bL);
            f32x4 as_[4][1];
#pragma unroll
            for (int m = 0; m < 4; ++m) as_[m][0] = accSt[m] * dL;
            mma_lds<4, 1>(as_, Uts, 72, Kws + (w * 16) * 72, 72, 64, fr, fq);
#pragma unroll
            for (int m = 0; m < 4; ++m) accSt[m] = as_[m][0];
        }
        __syncthreads();
    }
    const int lane = lane0, w = w0, fr = lane & 15, fq = lane >> 4;
    float* pS = p.out + O_PS + (size_t)(b * 8 + h) * 16384;
#pragma unroll
    for (int m = 0; m < 4; ++m) *(f32x4*)(pS + (size_t)(w * 16 + fr) * 128 + eb * 64 + m * 16 + fq * 4) = accSt[m];
    __syncthreads();
}

DEVI void mlstm_sample(const Params& p, int item, char* smem) {
    const int tid = threadIdx.x, lane = tid & 63, w = tid >> 6;
    const int bs = item >> 2, h = item & 3;
    float* qs = (float*)smem; float* ks = qs + 1024; float* vs = ks + 1024; float* red = vs + 1024; float* num = red + 2048; float* sc = num + 1024; float* sc2 = sc + 32;
    const float* proj = (const float*)(p.ws + WS_PROJ); u16* mix = (u16*)(p.ws + WS_MIX);
    const size_t row0 = NPT + (size_t)bs * 4;
    for (int i = tid; i < 3072; i += NTHR) { const int which = i >> 10, t = (i >> 8) & 3, d = i & 255;
        float v = proj[(row0 + t) * INC + which * 1024 + h * 256 + d]; if (which == 1) v *= 0.0625f; qs[i] = v; }
    float m = p.st_m[bs * 4 + h]; float fw[4], iw[4], flo[4];
    const float ib = p.m_i_bias[h], fb = p.m_f_bias[h];
#pragma unroll
    for (int t = 0; t < 4; ++t) { const float iv = proj[(row0 + t) * INC + 8192 + h] + ib; const float lf = logsigf_(proj[(row0 + t) * INC + 8196 + h] + fb);
        const float mn = fmaxf(lf + m, iv); fw[t] = __expf(lf + m - mn); iw[t] = __expf(iv - mn); flo[t] = __expf(-mn); m = mn; }
    __syncthreads();
    float qn[4] = {0.f, 0.f, 0.f, 0.f};
    if (tid < 256) { float n = p.st_n[(bs * 4 + h) * 256 + tid];
#pragma unroll
        for (int t = 0; t < 4; ++t) { n = fw[t] * n + iw[t] * ks[t * 256 + tid]; qn[t] = qs[t * 256 + tid] * n; }
        p.out[O_SN + (bs * 4 + h) * 256 + tid] = n; }
#pragma unroll
    for (int t = 0; t < 4; ++t) { const float r = wsum(qn[t]); if (lane == 0) sc[w * 4 + t] = r; }
    const float* Cin = p.st_C + (size_t)(bs * 4 + h) * 65536; float* Cout = p.out + O_SC + (size_t)(bs * 4 + h) * 65536;
    for (int slab = 0; slab < 4; ++slab) {
        float Cr[32];
#pragma unroll
        for (int i = 0; i < 32; ++i) Cr[i] = Cin[(w * 32 + i) * 256 + slab * 64 + lane];
        float pn[4];
#pragma unroll
        for (int t = 0; t < 4; ++t) { const float vt = vs[t * 256 + slab * 64 + lane] * iw[t]; float a = 0.f;
#pragma unroll
            for (int i = 0; i < 32; ++i) { Cr[i] = fw[t] * Cr[i] + ks[t * 256 + w * 32 + i] * vt; a += qs[t * 256 + w * 32 + i] * Cr[i]; }
            pn[t] = a; }
#pragma unroll
        for (int i = 0; i < 32; ++i) Cout[(w * 32 + i) * 256 + slab * 64 + lane] = Cr[i];
#pragma unroll
        for (int t = 0; t < 4; ++t) red[(t * 8 + w) * 64 + lane] = pn[t];
        __syncthreads();
        if (tid < 256) { const int t = tid >> 6; float s = 0.f;
#pragma unroll
            for (int g = 0; g < 8; ++g) s += red[(t * 8 + g) * 64 + lane];
            num[t * 256 + slab * 64 + lane] = s; }
        __syncthreads();
    }
    float hv[4];
    if (tid < 256) {
#pragma unroll
        for (int t = 0; t < 4; ++t) { float den = 0.f;
#pragma unroll
            for (int g = 0; g < 8; ++g) den += sc[g * 4 + t];
            hv[t] = num[t * 256 + tid] / fmaxf(fabsf(den), flo[t]);
            const float r = wsum(hv[t] * hv[t]); if (lane == 0) sc2[w * 4 + t] = r; }
    }
    __syncthreads();
    if (tid < 256) {
#pragma unroll
        for (int t = 0; t < 4; ++t) { const float ss = sc2[t] + sc2[4 + t] + sc2[8 + t] + sc2[12 + t]; const float rs = rsqrtf(ss * (1.f / 256.f) + 1e-6f);
            const float mo = proj[(row0 + t) * INC + 3072 + h * 256 + tid];
            mix[(row0 + t) * DM + h * 256 + tid] = f2bf(hv[t] * rs * p.m_norm_g[h * 256 + tid] * sigmoidf_(mo)); }
    }
    if (tid == 0) p.out[O_SM + bs * 4 + h] = m;
    __syncthreads();
}

DEVI void gdn_sample(const Params& p, int item, char* smem) {
    const int tid = threadIdx.x, lane = tid & 63, w = tid >> 6;
    const int bs = item >> 3, h = item & 7;
    float* qkv = (float*)smem;
    float* red = qkv + 1536;
    float* ored = red + 1024;
    float* sc = ored + 2048;
    const float* proj = (const float*)(p.ws + WS_PROJ); u16* mix = (u16*)(p.ws + WS_MIX);
    const size_t row0 = NPT + (size_t)bs * 4;
    if (tid < 384) { const int which = tid >> 7, dch = tid & 127, ch = which * 1024 + h * 128 + dch;
        float xp[7];
#pragma unroll
        for (int j = 0; j < 3; ++j) xp[j] = p.st_conv[(size_t)(bs * 3 + j) * 3072 + ch];
#pragma unroll
        for (int t = 0; t < 4; ++t) xp[3 + t] = proj[(row0 + t) * INC + 4096 + ch];
        float cw[4];
#pragma unroll
        for (int j = 0; j < 4; ++j) cw[j] = p.conv_w[j * 3072 + ch];
#pragma unroll
        for (int t = 0; t < 4; ++t) qkv[(which * 4 + t) * 128 + dch] = siluf_(cw[0] * xp[t] + cw[1] * xp[t + 1] + cw[2] * xp[t + 2] + cw[3] * xp[t + 3]); }
    float at[4], be[4];
    { const float dtb = p.g_dt_bias[h], Aexp = __expf(p.g_A_log[h]);
#pragma unroll
        for (int t = 0; t < 4; ++t) { at[t] = __expf(-Aexp * softplusf_(proj[(row0 + t) * INC + 8208 + h] + dtb)); be[t] = sigmoidf_(proj[(row0 + t) * INC + 8200 + h]); } }
    __syncthreads();
    { const int which = w >> 2, t = w & 3; float* a = qkv + (which * 4 + t) * 128; const float v0 = a[lane * 2], v1 = a[lane * 2 + 1];
        const float sc_ = rsqrtf(wsum(v0 * v0 + v1 * v1) + 1e-6f) * (which == 0 ? 0.08838834764831845f : 1.f);
        a[lane * 2] = v0 * sc_; a[lane * 2 + 1] = v1 * sc_; }
    __syncthreads();
    const float* qf = qkv; const float* kf = qkv + 512; const float* vf = qkv + 1024;
    const int e = tid & 127, dg = tid >> 7;
    const float* Sin = p.st_S + (size_t)(bs * 8 + h) * 16384; float* Sout = p.out + O_SS + (size_t)(bs * 8 + h) * 16384;
    float Sr[32];
#pragma unroll
    for (int i = 0; i < 32; ++i) Sr[i] = Sin[(dg * 32 + i) * 128 + e];
#pragma unroll
    for (int t = 0; t < 4; ++t) {
        float r = 0.f;
#pragma unroll
        for (int i = 0; i < 32; ++i) r += kf[t * 128 + dg * 32 + i] * Sr[i];
        red[((t & 1) * 4 + dg) * 128 + e] = r;
        __syncthreads();
        const float rr = red[((t & 1) * 4 + 0) * 128 + e] + red[((t & 1) * 4 + 1) * 128 + e] + red[((t & 1) * 4 + 2) * 128 + e] + red[((t & 1) * 4 + 3) * 128 + e];
        const float u = be[t] * (vf[t * 128 + e] - at[t] * rr);
        float po = 0.f;
#pragma unroll
        for (int i = 0; i < 32; ++i) { Sr[i] = at[t] * Sr[i] + kf[t * 128 + dg * 32 + i] * u; po += qf[t * 128 + dg * 32 + i] * Sr[i]; }
        ored[(t * 4 + dg) * 128 + e] = po;
    }
#pragma unroll
    for (int i = 0; i < 32; ++i) Sout[(dg * 32 + i) * 128 + e] = Sr[i];
    __syncthreads();
    float ov[4];
    if (tid < 128) {
#pragma unroll
        for (int t = 0; t < 4; ++t) { ov[t] = ored[(t * 4 + 0) * 128 + tid] + ored[(t * 4 + 1) * 128 + tid] + ored[(t * 4 + 2) * 128 + tid] + ored[(t * 4 + 3) * 128 + tid];
            const float r = wsum(ov[t] * ov[t]); if (lane == 0) sc[w * 4 + t] = r; }
    }
    __syncthreads();
    if (tid < 128) {
#pragma unroll
        for (int t = 0; t < 4; ++t) { const float rs = rsqrtf((sc[t] + sc[4 + t]) * (1.f / 128.f) + 1e-6f);
            const float gz = proj[(row0 + t) * INC + 7168 + h * 128 + tid];
            mix[(row0 + t) * DM + 1024 + h * 128 + tid] = f2bf(ov[t] * rs * p.g_norm_g[h * 128 + tid] * siluf_(gz)); }
    }
    __syncthreads();
}

#ifndef SCM
#define SCM 15
#endif
DEVI void phase_scan(const Params& p, char* smem) {
    const int G = gridDim.x, bid = blockIdx.x;
    if (G >= 192) {
        if (bid < 64) { if (SCM & 1) mlstm_prompt(p, bid, smem); }
        else if (bid < 128) { if (SCM & 2) gdn_prompt(p, bid - 64, smem); }
        else { for (int u = bid - 128; u < 512 + 1024; u += G - 128) { if (u < 512) { if (SCM & 4) mlstm_sample(p, u, smem); } else { if (SCM & 8) gdn_sample(p, u - 512, smem); } } }
    } else {
        for (int u = bid; u < 128 + 512 + 1024; u += G) {
            if (u < 64) { if (SCM & 1) mlstm_prompt(p, u, smem); } else if (u < 128) { if (SCM & 2) gdn_prompt(p, u - 64, smem); }
            else if (u < 640) { if (SCM & 4) mlstm_sample(p, u - 128, smem); } else { if (SCM & 8) gdn_sample(p, u - 640, smem); } }
    }
}

__global__ void __launch_bounds__(NTHR) fwd_kernel(Params p) {
    extern __shared__ __attribute__((aligned(16))) char smem[];
    cg::grid_group grid = cg::this_grid();
    const int lo = p.ph_lo, hi = p.ph_hi;
#ifndef PHMASK
#define PHMASK 0xFFFF
#endif
#define PHASE(k) if (((PHMASK >> (k)) & 1) && lo <= (k) && (k) < hi)
#define SEAM(k) if (lo <= (k) && (k) + 1 < hi) grid.sync()
    PHASE(0) phase_prep(p, smem);
    SEAM(0);
    PHASE(1) { EpiAda e{(float*)(p.ws + WS_ADA), p.b_ada}; gemm_phase((const u16*)(p.ws + WS_AC), (const u16*)(p.ws + WS_WADA), 256, ADAW, DM, smem, e); }
    SEAM(1);
    PHASE(2) phase_modulate(p);
    SEAM(2);
    PHASE(3) { EpiProj e{(float*)(p.ws + WS_PROJ)}; gemm_phase((const u16*)(p.ws + WS_AH), (const u16*)(p.ws + WS_WIN), NTOK, 8448, DM, smem, e); }
    SEAM(3);
    PHASE(4) phase_scan(p, smem);
    SEAM(4);
    PHASE(5) phase_post(p);
    SEAM(5);
    PHASE(6) { EpiRes e{p.x_prompt, p.x_sample, nullptr, (const float*)(p.ws + WS_ADA), 2 * DM, (float*)(p.ws + WS_X1)};
        gemm_phase((const u16*)(p.ws + WS_MIX), (const u16*)(p.ws + WS_WOUT), NTOK, DM, DM, smem, e); }
    SEAM(6);
    PHASE(7) phase_ln1(p);
    SEAM(7);
    PHASE(8) { EpiGU e{(u16*)(p.ws + WS_ACT)}; gemm_phase((const u16*)(p.ws + WS_AH), (const u16*)(p.ws + WS_WGU), NTOK, 2 * DFF, DM, smem, e); }
    SEAM(8);
    PHASE(9) { EpiRes e{p.x_prompt, p.x_sample, (const float*)(p.ws + WS_X1), (const float*)(p.ws + WS_ADA), 5 * DM, p.out + O_YP};
        gemm_phase((const u16*)(p.ws + WS_ACT), (const u16*)(p.ws + WS_WDOWN), NTOK, DM, DFF, smem, e); }
    SEAM(9);
    PHASE(10) phase_ln2(p);
}

extern "C" void kernel_launch(void* const* d_in, const int* in_sizes, int n_in, void* d_out, int out_size, void* d_ws, size_t ws_size,
                              hipStream_t stream) {
    static int grid = 0;
    if (grid == 0) {
        if (n_in != 26 || ws_size < WS_END) { fprintf(stderr, "kernel_launch: unexpected n_in %d / ws_size %zu\n", n_in, ws_size); grid = -1; return; }
        int dev = 0, cus = 0, per_cu = 0;
        hipGetDevice(&dev);
        hipDeviceGetAttribute(&cus, hipDeviceAttributeMultiprocessorCount, dev);
        hipFuncSetAttribute((const void*)fwd_kernel, hipFuncAttributeMaxDynamicSharedMemorySize, LDS_BYTES);
        hipOccupancyMaxActiveBlocksPerMultiprocessor(&per_cu, (const void*)fwd_kernel, NTHR, LDS_BYTES);
        if (per_cu < 1) { fprintf(stderr, "kernel_launch: occupancy query says %d blocks/CU\n", per_cu); grid = -1; return; }
        grid = cus * per_cu;
    }
    if (grid < 0) return;
    Params p{};
    const float** f = (const float**)&p;
    for (int i = 0; i < 26; ++i) f[i] = (const float*)d_in[i];
    p.out = (float*)d_out; p.ws = (unsigned char*)d_ws;
#if FUSED
    p.ph_lo = 0; p.ph_hi = 11;
    void* args[] = {&p};
    hipError_t e = hipLaunchCooperativeKernel((const void*)fwd_kernel, dim3(grid), dim3(NTHR), args, LDS_BYTES, stream);
    if (e != hipSuccess) fprintf(stderr, "cooperative launch failed: %s (grid %d)\n", hipGetErrorString(e), grid);
#else
    for (int ph = 0; ph < 11; ++ph) { p.ph_lo = ph; p.ph_hi = ph + 1; hipLaunchKernelGGL(fwd_kernel, dim3(grid), dim3(NTHR), LDS_BYTES, stream, p); }
#endif
}
```

```cpp
#include <hip/hip_runtime.h>
#include <hip/hip_cooperative_groups.h>
#include <cstdio>
namespace cg = cooperative_groups;

#ifndef FUSED
#define FUSED 1
#endif

#define DEVI __device__ __forceinline__
typedef unsigned short u16;
typedef short bf16x8 __attribute__((ext_vector_type(8)));
typedef float f32x4 __attribute__((ext_vector_type(4)));

constexpr int NTHR = 512;
constexpr int DM = 2048, NTOK = 8704, NPT = 8192, INC = 8216, PLD = 8192, DFF = 5632, ADAW = 12288;
constexpr int LDS_BYTES = 158 * 1024;
constexpr float ALPHA = 1.189207115002721f;

constexpr size_t O_YP = 0, O_PC = 17825792, O_PN = 18874368, O_PM = 18878464, O_PS = 18878480, O_PCONV = 19402768,
                 O_SC = 19439632, O_SN = 52994064, O_SM = 53125136, O_SS = 53125648, O_SCONV = 69902864;
constexpr size_t WS_WOUT = 0, WS_WGU = 8388608, WS_WDOWN = 54525952, WS_ADA = 77594624, WS_AC = 84082688,
                 WS_WIN = 85131264, WS_WADA = 119734272, WS_HBUF = WS_WIN, WS_AH = 170065920, WS_MIX = 205717504,
                 WS_PROJ = 241369088, WS_X1 = 85131264  , WS_ACT = WS_PROJ + 71303168, WS_GATES = 527417344, WS_GQ = 152240128, WS_GW = 169017344, WS_GP = 185794560, WS_GSC = 194183168,
                 WS_GU0 = 528252928, WS_GKW = 545030144, WS_MKT = 561807360, WS_MVT = 578584576,
                 WS_PART = 528252928  , WS_MP = 194510848, WS_MSC = 198705152, WS_MQ = 118685696, WS_BAR = 595361792, WS_END = 595378176;

struct Params {
    const float* x_prompt; const float* x_sample; const float* st_C; const float* st_n; const float* st_m; const float* st_S;
    const float* st_conv; const float* c_prompt; const float* c_sample; const float* w_ada; const float* b_ada; const float* w_in;
    const float* m_i_bias; const float* m_f_bias; const float* m_norm_g; const float* conv_w; const float* g_dt_bias;
    const float* g_A_log; const float* g_norm_g; const float* w_out; const float* ln1_g; const float* ln1_b; const float* w_gu;
    const float* w_down; const float* ln2_g; const float* ln2_b;
    float* out; unsigned char* ws;
    int ph_lo, ph_hi;
};

typedef float f32x2_t __attribute__((ext_vector_type(2)));
typedef __bf16 bf16x2_t __attribute__((ext_vector_type(2)));
DEVI unsigned pack2(float a, float b) { const f32x2_t v = {a, b}; const bf16x2_t r = __builtin_convertvector(v, bf16x2_t); return __builtin_bit_cast(unsigned, r); }
DEVI u16 f2bf(float f) { const __bf16 r = (__bf16)f; return __builtin_bit_cast(u16, r); }
DEVI float bf2f(u16 b) { return __uint_as_float(((unsigned)b) << 16); }
DEVI float wsum(float v) { for (int o = 32; o; o >>= 1) v += __shfl_xor(v, o); return v; }
DEVI float sigmoidf_(float x) { return 1.f / (1.f + __expf(-x)); }
DEVI float siluf_(float x) { return x / (1.f + __expf(-x)); }
DEVI float softplusf_(float x) { return fmaxf(x, 0.f) + log1pf(__expf(-fabsf(x))); }
DEVI float logsigf_(float x) { return fminf(x, 0.f) - log1pf(__expf(-fabsf(x))); }
DEVI f32x4 mfma16(bf16x8 a, bf16x8 b, f32x4 c) { return __builtin_amdgcn_mfma_f32_16x16x32_bf16(a, b, c, 0, 0, 0); }
DEVI int tok_batch(int row) { return row < NPT ? (row >> 11) : 4 + ((row - NPT) >> 2); }
DEVI const float* x_row(const Params& p, int row) { return row < NPT ? p.x_prompt + (size_t)row * DM : p.x_sample + (size_t)(row - NPT) * DM; }

template <int MT, int NT>
DEVI void mma_lds(f32x4 (&acc)[MT][NT], const u16* A, int lda, const u16* B, int ldb, int K, int fr, int fq) {
    for (int k = 0; k < K; k += 32) {
        bf16x8 a[MT], b[NT];
#pragma unroll
        for (int m = 0; m < MT; ++m) a[m] = *(const bf16x8*)(A + (m * 16 + fr) * lda + k + fq * 8);
#pragma unroll
        for (int n = 0; n < NT; ++n) b[n] = *(const bf16x8*)(B + (n * 16 + fr) * ldb + k + fq * 8);
#pragma unroll
        for (int m = 0; m < MT; ++m)
#pragma unroll
            for (int n = 0; n < NT; ++n) acc[m][n] = mfma16(a[m], b[n], acc[m][n]);
    }
}

namespace pg8 {
#define PG8_LAS __attribute__((address_space(3)))
typedef unsigned short bf16_t;
typedef short bf16x8 __attribute__((ext_vector_type(8)));
typedef float f32x4 __attribute__((ext_vector_type(4)));
typedef unsigned u32x4 __attribute__((ext_vector_type(4)));
constexpr int BM = 256, BK = 64, HALF = 128, HTB = HALF * BK * 2  , STAGE_BYTES = 8 * HTB, NXCD = 8, WGM = 8;

__host__ __device__ __forceinline__ int lds_byte(int r, int c) { const int st = (r >> 4) * 2 + (c >> 5), rr = r & 15, cc = c & 31, ob = rr * 64 + cc * 2; return st * 1024 + (ob ^ (((ob >> 9) & 1) << 5)); }
__host__ __device__ __forceinline__ void stage_rc(int b, int& R, int& C) { const int st = b / 1024, sb = b % 1024, swz = sb ^ (((sb >> 9) & 1) << 5); R = (st >> 1) * 16 + swz / 64; C = (st & 1) * 32 + (swz % 64) / 2; }
__host__ __device__ __forceinline__ int perm32(int rho) { const int n = rho >> 4, i = rho & 15; return 8 * (i >> 2) + 4 * n + (i & 3); }

struct Unit { int pm, pn, k0, nt; };
struct Gemm { const bf16_t* A; const bf16_t* Bt; int M, N, K; };

struct StaticOrder {
    int nM, nN, nwg, G, c, Kt;
    __host__ __device__ void init(int M, int N, int G_, int c_, int K_ = 0) { nM = M / BM; nN = N / BM; nwg = nM * nN; G = G_; c = c_; Kt = K_ / BK; }
    __host__ __device__ bool next(int i, Unit& u) const {
        const long L = (long)i * G + c; if (L >= nwg) return false;
        int wgid = (int)L; { const int q = nwg / NXCD, r = nwg % NXCD, xcd = wgid % NXCD, off = wgid / NXCD; wgid = (xcd < r ? xcd * (q + 1) : r * (q + 1) + (xcd - r) * q) + off; }
        const int nig = WGM * nN, gid = wgid / nig, fm = gid * WGM, gsz = (nM - fm) < WGM ? (nM - fm) : WGM;
        u.pm = fm + ((wgid % nig) % gsz); u.pn = (wgid % nig) / gsz; u.k0 = 0; u.nt = Kt; return true;
    }
    __device__ __forceinline__ void a_ready(const Unit&) const {}
    __device__ __forceinline__ void done(const Unit&) const {}
};
__device__ __forceinline__ unsigned cvt_pk_bf16(float lo, float hi) { unsigned r; asm volatile("v_cvt_pk_bf16_f32 %0, %1, %2" : "=v"(r) : "v"(lo), "v"(hi)); return r; }
template <class Epi, class Sched, bool STAMP = false>
__device__ __forceinline__ void gemm_phase(PG8_LAS unsigned char* lds, const Gemm g, const Sched& S, const Epi& E, unsigned long long* stamps) {
    const int tid = threadIdx.x, wid = __builtin_amdgcn_readfirstlane(tid >> 6), lane = tid & 63, wr = wid >> 2, wc = wid & 3, fr = lane & 15, fq = lane >> 4;
    const int K = g.K;
    int ts_lo = 0, ts_hi = 0, nts = 0; const unsigned long long rt_entry = STAMP ? (unsigned long long)wall_clock64() : 0ull;
#define PG8_STAMP() do { if (STAMP && wid == 0 && nts < 64) { const unsigned long long _c = (unsigned long long)clock64(); \
        ts_lo = (lane == nts) ? (int)(unsigned)_c : ts_lo; ts_hi = (lane == nts) ? (int)(unsigned)(_c >> 32) : ts_hi; ++nts; } } while (0)
    PG8_STAMP();
    unsigned voffA[2], voffB[2];
#pragma unroll
    for (int i = 0; i < 2; ++i) { int R, C; stage_rc(tid * 16 + i * 8192, R, C); const int Rb = Epi::PERM ? ((R & ~31) + perm32(R & 31)) : R;
        voffA[i] = (unsigned)(R * K + C) * 2u; voffB[i] = (unsigned)(Rb * K + C) * 2u; }
    const size_t kstep = (size_t)(BK * 2);
    const size_t hstep = (size_t)HALF * K * 2;
    const size_t tstep = 2 * hstep;
    const unsigned ldsw = (unsigned)wid * 1024u;
    const int aoff = lds_byte(wr * 64 + fr, fq * 8), boff = lds_byte(wc * 32 + fr, fq * 8);
#define PG8_SA(b, h) (((b) * 2 + (h)) * HTB)
#define PG8_SB(b, h) ((4 + (b) * 2 + (h)) * HTB)
#define PG8_STAGE(bufoff, gbase, voff) do { _Pragma("unroll") for (int _i = 0; _i < 2; ++_i) \
        __builtin_amdgcn_global_load_lds((const unsigned*)((const char*)(gbase) + (voff)[_i]), (PG8_LAS unsigned*)(lds + (bufoff) + ldsw + _i * 8192), 16, 0, 0); } while (0)
#define PG8_LDA(dst, b, h) do { _Pragma("unroll") for (int m = 0; m < 4; ++m) _Pragma("unroll") for (int k = 0; k < 2; ++k) dst[m][k] = *(const PG8_LAS bf16x8*)(lds + PG8_SA(b, h) + aoff + m * 2048 + k * 1024); } while (0)
#define PG8_LDB(dst, b, h) do { _Pragma("unroll") for (int n = 0; n < 2; ++n) _Pragma("unroll") for (int k = 0; k < 2; ++k) dst[n][k] = *(const PG8_LAS bf16x8*)(lds + PG8_SB(b, h) + boff + n * 2048 + k * 1024); } while (0)
#define PG8_MMA(ai, bj, At, Bt) do { __builtin_amdgcn_s_setprio(1); _Pragma("unroll") for (int m = 0; m < 4; ++m) _Pragma("unroll") for (int n = 0; n < 2; ++n) _Pragma("unroll") for (int k = 0; k < 2; ++k) \
        acc[ai][bj][m][n] = __builtin_amdgcn_mfma_f32_16x16x32_bf16(Bt[n][k], At[m][k], acc[ai][bj][m][n], 0, 0, 0); __builtin_amdgcn_s_setprio(0); } while (0)
#define PG8_WAIT_V(n) asm volatile("s_waitcnt vmcnt(" #n ")" ::: "memory")
#define PG8_WAIT_L(n) asm volatile("s_waitcnt lgkmcnt(" #n ")" ::: "memory")
#define PG8_BAR __builtin_amdgcn_s_barrier()
#define PG8_SCHED __builtin_amdgcn_sched_barrier(0)
    Unit cur, nxt; int ui = 0;
    if (!S.next(0, cur)) return;
    f32x4 acc[2][2][4][2];
#pragma unroll
    for (int a = 0; a < 2; ++a)
#pragma unroll
        for (int b = 0; b < 2; ++b)
#pragma unroll
            for (int m = 0; m < 4; ++m)
#pragma unroll
                for (int n = 0; n < 2; ++n) acc[a][b][m][n] = (f32x4){0.f, 0.f, 0.f, 0.f};
    bf16x8 At[4][2], B0[2][2], B1[2][2];
    const char* cA = (const char*)g.A + (size_t)cur.pm * tstep + (size_t)cur.k0 * 2; const char* cB = (const char*)g.Bt + (size_t)cur.pn * tstep + (size_t)cur.k0 * 2;
    S.a_ready(cur);
    PG8_STAGE(PG8_SB(0, 0), cB, voffB); PG8_STAGE(PG8_SA(0, 0), cA, voffA); PG8_STAGE(PG8_SB(0, 1), cB + hstep, voffB); PG8_STAGE(PG8_SA(0, 1), cA + hstep, voffA);
    if (wr == 1) PG8_BAR;
    PG8_WAIT_V(4); PG8_BAR;
    PG8_STAGE(PG8_SB(1, 0), cB + kstep, voffB); PG8_STAGE(PG8_SA(1, 0), cA + kstep, voffA); PG8_STAGE(PG8_SB(1, 1), cB + hstep + kstep, voffB);
    PG8_WAIT_V(6); PG8_BAR;
    PG8_STAMP();
    for (;;) {
        const bool has_next = S.next(ui + 1, nxt);
        const char* nA = has_next ? (const char*)g.A + (size_t)nxt.pm * tstep + (size_t)nxt.k0 * 2 : cA; const char* nB = has_next ? (const char*)g.Bt + (size_t)nxt.pn * tstep + (size_t)nxt.k0 * 2 : cB;
        const int nt = cur.nt;
        for (int t = 0; t < nt; t += 2) {
            const bool last = (t == nt - 2);
            const char* a1 = cA + (size_t)(t + 1) * kstep;
            const char* a2 = last ? nA : cA + (size_t)(t + 2) * kstep; const char* b2 = last ? nB : cB + (size_t)(t + 2) * kstep;
            const char* a3 = a2 + kstep; const char* b3 = b2 + kstep;
            if (last && has_next) S.a_ready(nxt);
            PG8_LDB(B0, 0, 0); PG8_SCHED; PG8_LDA(At, 0, 0); PG8_STAGE(PG8_SA(1, 1), a1 + hstep, voffA);
            PG8_WAIT_L(8); PG8_BAR; PG8_WAIT_L(0); PG8_MMA(0, 0, At, B0); PG8_BAR; PG8_SCHED;
            PG8_LDB(B1, 0, 1); PG8_STAGE(PG8_SB(0, 0), b2, voffB);
            PG8_BAR; PG8_WAIT_L(0); PG8_MMA(0, 1, At, B1); PG8_BAR;
            PG8_LDA(At, 0, 1); PG8_STAGE(PG8_SA(0, 0), a2, voffA);
            PG8_BAR; PG8_WAIT_L(0); PG8_MMA(1, 0, At, B0); PG8_BAR; PG8_SCHED;
            PG8_STAGE(PG8_SB(0, 1), b2 + hstep, voffB);
            PG8_WAIT_V(6); PG8_BAR; PG8_MMA(1, 1, At, B1); PG8_BAR;
            PG8_LDB(B0, 1, 0); PG8_SCHED; PG8_LDA(At, 1, 0); PG8_STAGE(PG8_SA(0, 1), a2 + hstep, voffA);
            PG8_WAIT_L(8); PG8_BAR; PG8_WAIT_L(0); PG8_MMA(0, 0, At, B0); PG8_BAR; PG8_SCHED;
            PG8_LDB(B1, 1, 1); PG8_STAGE(PG8_SB(1, 0), b3, voffB);
            PG8_BAR; PG8_WAIT_L(0); PG8_MMA(0, 1, At, B1); PG8_BAR;
            PG8_LDA(At, 1, 1); PG8_STAGE(PG8_SA(1, 0), a3, voffA);
            PG8_BAR; PG8_WAIT_L(0); PG8_MMA(1, 0, At, B0); PG8_BAR; PG8_SCHED;
            PG8_STAGE(PG8_SB(1, 1), b3 + hstep, voffB);
            PG8_WAIT_V(6); PG8_BAR; PG8_MMA(1, 1, At, B1); PG8_BAR;
        }
        PG8_STAMP();
        if constexpr (!Epi::AFTER_DRAIN) { E(acc, cur, wr, wc, fr, fq); S.done(cur); }
        PG8_STAMP();
        if (!has_next) break;
#pragma unroll
        for (int a = 0; a < 2; ++a)
#pragma unroll
            for (int b = 0; b < 2; ++b)
#pragma unroll
                for (int m = 0; m < 4; ++m)
#pragma unroll
                    for (int n = 0; n < 2; ++n) acc[a][b][m][n] = (f32x4){0.f, 0.f, 0.f, 0.f};
        cur = nxt; cA = nA; cB = nB; ++ui;
    }
    PG8_WAIT_V(0);
    if (wr == 0) PG8_BAR;
    PG8_BAR;
    if constexpr (Epi::AFTER_DRAIN) { E.fused(acc, cur, wr, wc, fr, fq, lds, wid, lane); S.done(cur); }
    PG8_STAMP();
    if (STAMP && wid == 0) { stamps[lane] = lane < nts ? (((unsigned long long)(unsigned)ts_hi << 32) | (unsigned)ts_lo) : 0ull;
        if (lane == 62) stamps[62] = rt_entry; if (lane == 63) stamps[63] = (unsigned long long)wall_clock64(); }
#undef PG8_STAMP
#undef PG8_SA
#undef PG8_SB
#undef PG8_STAGE
#undef PG8_LDA
#undef PG8_LDB
#undef PG8_MMA
#undef PG8_WAIT_V
#undef PG8_WAIT_L
#undef PG8_BAR
#undef PG8_SCHED
}
}

DEVI void transpose_tile4(const float* src, int ldsrc, int nvalid, int k0, int c00, int c01, int c02, int c03, u16* dst, int ldd, u16* t) {
    int tid = threadIdx.x; asm volatile("" : "+v"(tid));
    const int kr = tid >> 4, n4 = (tid & 15) * 4;
    float4 v[4][2];
#pragma unroll
    for (int q = 0; q < 4; ++q) { const int c0 = q == 0 ? c00 : q == 1 ? c01 : q == 2 ? c02 : c03;
#pragma unroll
        for (int i = 0; i < 2; ++i) { v[q][i] = make_float4(0.f, 0.f, 0.f, 0.f);
            if (c0 + n4 < nvalid) v[q][i] = *(const float4*)(src + (size_t)(k0 + kr + 32 * i) * ldsrc + c0 + n4); } }
#pragma unroll
    for (int q = 0; q < 4; ++q)
#pragma unroll
        for (int i = 0; i < 2; ++i) { const int k = kr + 32 * i; u16* tq = t + q * 64 * 72;
            tq[(n4 + 0) * 72 + k] = f2bf(v[q][i].x); tq[(n4 + 1) * 72 + k] = f2bf(v[q][i].y); tq[(n4 + 2) * 72 + k] = f2bf(v[q][i].z); tq[(n4 + 3) * 72 + k] = f2bf(v[q][i].w); }
    __syncthreads();
#pragma unroll
    for (int q = 0; q < 4; ++q) { const int n = tid >> 3, kc = tid & 7;
        *(uint4*)(dst + (size_t)(q * 64 + n) * ldd + k0 + kc * 8) = *(const uint4*)(t + q * 64 * 72 + n * 72 + kc * 8); }
    __syncthreads();
}

DEVI void ada_job(const Params& p, int job, char* smem) {
    int tid = threadIdx.x; asm volatile("" : "+v"(tid));
    const int lane = tid & 63, w = tid >> 6, fr = lane & 15, fq = lane >> 4;
    u16* T = (u16*)smem;
    const int n0 = job * 64;
    float* ada = (float*)(p.ws + WS_ADA);
    f32x4 acc0[4], acc1[4];
#pragma unroll
    for (int n = 0; n < 4; ++n) acc0[n] = acc1[n] = (f32x4){0.f, 0.f, 0.f, 0.f};
    const int kr = tid >> 4, n4 = (tid & 15) * 4;
    const int r0 = 16 * w + fr;
    const float* c0 = (r0 < 4 ? p.c_prompt + (size_t)r0 * DM : p.c_sample + (size_t)(r0 - 4) * DM) + fq * 8;
    const bool v1 = (fr < 4);
    const float* c1 = p.c_sample + (size_t)(124 + (v1 ? fr : 0)) * DM + fq * 8;
    const float* wsrc = p.w_ada + (size_t)kr * ADAW + n0 + n4;
    float4 wv[4][2];
#pragma unroll
    for (int q = 0; q < 4; ++q)
#pragma unroll
        for (int i = 0; i < 2; ++i) wv[q][i] = *(const float4*)(wsrc + (size_t)(q * 64 + 32 * i) * ADAW);
    for (int gk = 0; gk < 8; ++gk) {
#pragma unroll
        for (int q = 0; q < 4; ++q)
#pragma unroll
            for (int i = 0; i < 2; ++i) { const int k = kr + 32 * i; u16* tq = T + q * 64 * 72;
                tq[(n4 + 0) * 72 + k] = f2bf(wv[q][i].x); tq[(n4 + 1) * 72 + k] = f2bf(wv[q][i].y); tq[(n4 + 2) * 72 + k] = f2bf(wv[q][i].z); tq[(n4 + 3) * 72 + k] = f2bf(wv[q][i].w); }
        __syncthreads();
        if (gk + 1 < 8) {
#pragma unroll
            for (int q = 0; q < 4; ++q)
#pragma unroll
                for (int i = 0; i < 2; ++i) wv[q][i] = *(const float4*)(wsrc + (size_t)((gk + 1) * 256 + q * 64 + 32 * i) * ADAW);
        }
#pragma unroll
        for (int q = 0; q < 4; ++q) { const int kt = gk * 4 + q; const u16* Tc = T + q * 64 * 72;
            bf16x8 a0[2], a1[2];
#pragma unroll
            for (int k2 = 0; k2 < 2; ++k2) { const f32x4 x0 = *(const f32x4*)(c0 + kt * 64 + k2 * 32), x1 = *(const f32x4*)(c0 + kt * 64 + k2 * 32 + 4);
                bf16x8 qq; qq[0] = (short)f2bf(siluf_(x0[0])); qq[1] = (short)f2bf(siluf_(x0[1])); qq[2] = (short)f2bf(siluf_(x0[2])); qq[3] = (short)f2bf(siluf_(x0[3]));
                qq[4] = (short)f2bf(siluf_(x1[0])); qq[5] = (short)f2bf(siluf_(x1[1])); qq[6] = (short)f2bf(siluf_(x1[2])); qq[7] = (short)f2bf(siluf_(x1[3])); a0[k2] = qq; }
            if (w == 0) {
#pragma unroll
                for (int k2 = 0; k2 < 2; ++k2) { const f32x4 x0 = *(const f32x4*)(c1 + kt * 64 + k2 * 32), x1 = *(const f32x4*)(c1 + kt * 64 + k2 * 32 + 4);
                    bf16x8 qq; qq[0] = (short)f2bf(siluf_(x0[0])); qq[1] = (short)f2bf(siluf_(x0[1])); qq[2] = (short)f2bf(siluf_(x0[2])); qq[3] = (short)f2bf(siluf_(x0[3]));
                    qq[4] = (short)f2bf(siluf_(x1[0])); qq[5] = (short)f2bf(siluf_(x1[1])); qq[6] = (short)f2bf(siluf_(x1[2])); qq[7] = (short)f2bf(siluf_(x1[3]));
#pragma unroll
                    for (int e = 0; e < 8; ++e) qq[e] = v1 ? qq[e] : (short)0;
                    a1[k2] = qq; }
            }
#pragma unroll
            for (int k2 = 0; k2 < 2; ++k2)
#pragma unroll
                for (int n = 0; n < 4; ++n) { const bf16x8 bb = *(const bf16x8*)(Tc + (n * 16 + fr) * 72 + k2 * 32 + fq * 8);
                    acc0[n] = mfma16(a0[k2], bb, acc0[n]); if (w == 0) acc1[n] = mfma16(a1[k2], bb, acc1[n]); }
        }
        __syncthreads();
    }
#pragma unroll
    for (int n = 0; n < 4; ++n) { const int col = n0 + n * 16 + fr; const float bias = p.b_ada[col];
#pragma unroll
        for (int j = 0; j < 4; ++j) { ada[(size_t)(16 * w + fq * 4 + j) * ADAW + col] = acc0[n][j] + bias;
            if (w == 0 && fq == 0) ada[(size_t)(128 + j) * ADAW + col] = acc1[n][j] + bias; } }
    __syncthreads();
}

DEVI void phase_prep(const Params& p, char* smem) {
    u16* t = (u16*)smem;
    u16* WinT = (u16*)(p.ws + WS_WIN);
    constexpr int JA = 192, JB = 32 * 33;
    constexpr int TOT = JA + JB;
    for (int job = blockIdx.x; job < TOT; job += gridDim.x) {
        int j = job;
        if (j < JA) { ada_job(p, j, smem); continue; }
        j -= JA;
        { const int kt = j & 31, rg = j >> 5, c = rg * 256; transpose_tile4(p.w_in, INC, INC, kt * 64, c, c + 64, c + 128, c + 192, WinT + (size_t)rg * 256 * DM, DM, t); }
    }
}
constexpr int N_LATE_TR = 32 * 8 + 32 * 44 + 88 * 8;
DEVI void late_transpose(const Params& p, int j, char* smem) {
    u16* t = (u16*)smem; u16* WoutT = (u16*)(p.ws + WS_WOUT); u16* WguT = (u16*)(p.ws + WS_WGU); u16* WdownT = (u16*)(p.ws + WS_WDOWN);
    if (j < 32 * 8) { const int kt = j & 31, rg = j >> 5, c = rg * 256; transpose_tile4(p.w_out, DM, DM, kt * 64, c, c + 64, c + 128, c + 192, WoutT + (size_t)rg * 256 * DM, DM, t); return; }
    j -= 32 * 8;
    if (j < 32 * 44) { const int kt = j & 31, jj = j >> 5;
        transpose_tile4(p.w_gu, 2 * DFF, 2 * DFF, kt * 64, 128 * jj, 128 * jj + 64, DFF + 128 * jj, DFF + 128 * jj + 64, WguT + (size_t)jj * 256 * DM, DM, t); return; }
    j -= 32 * 44;
    { const int kt = j % 88, rg = j / 88, c = rg * 256; transpose_tile4(p.w_down, DM, DM, kt * 64, c, c + 64, c + 128, c + 192, WdownT + (size_t)rg * 256 * DFF, DFF, t); }
}
DEVI void pop_late(const Params& p, char* smem, int maxjobs, int list = 0) {
    unsigned* q2 = (unsigned*)(p.ws + WS_BAR) + 96 + 4 * list;
    const unsigned base = list ? 32 * 8 + 32 * 44 : 0, cnt = list ? 88 * 8 : 32 * 8 + 32 * 44;
    volatile unsigned* lq = (volatile unsigned*)(smem + LDS_BYTES - 32);
    for (int n = 0; n < maxjobs; ++n) {
        __syncthreads();
        if (threadIdx.x == 0) *lq = __hip_atomic_fetch_add(q2, 1u, __ATOMIC_RELAXED, __HIP_MEMORY_SCOPE_AGENT);
        __syncthreads();
        const unsigned u = *lq;
        if (u >= cnt) break;
        late_transpose(p, (int)(base + u), smem);
    }
    __syncthreads();
}

struct PEpiProj { static constexpr bool PERM = false, AFTER_DRAIN = false; float* C; float* gates;
    DEVI void operator()(const pg8::f32x4 (&acc)[2][2][4][2], const pg8::Unit& u, int wr, int wc, int fr, int fq) const {
        const int row0 = u.pm * 256 + wr * 64 + fr, col0 = u.pn * 256 + wc * 32 + 4 * fq;
        if (u.pn == 32) {
            if (wc == 0) {
#pragma unroll
                for (int ai = 0; ai < 2; ++ai)
#pragma unroll
                    for (int m = 0; m < 4; ++m) { float* gp = gates + (size_t)(row0 + ai * 128 + m * 16) * 24 + 4 * fq;
                        *(f32x4*)gp = acc[ai][0][m][0]; if (fq < 2) *(f32x4*)(gp + 16) = acc[ai][0][m][1]; }
            }
            return;
        }
#pragma unroll
        for (int ai = 0; ai < 2; ++ai)
#pragma unroll
            for (int m = 0; m < 4; ++m) { float* rowp = C + (size_t)(row0 + ai * 128 + m * 16) * PLD + col0;
#pragma unroll
                for (int bj = 0; bj < 2; ++bj)
#pragma unroll
                    for (int n = 0; n < 2; ++n) *(f32x4*)(rowp + bj * 128 + n * 16) = acc[ai][bj][m][n]; }
    } };
struct PEpiRes { static constexpr bool PERM = false, AFTER_DRAIN = false;
    const float* xp; const float* xs; const float* res; const float* ada; int gofs; float* out; float* part; int klen;
    DEVI void operator()(const pg8::f32x4 (&acc)[2][2][4][2], const pg8::Unit& u, int wr, int wc, int fr, int fq) const {
        const int row0 = u.pm * 256 + wr * 64 + fr, col0 = u.pn * 256 + wc * 32 + 4 * fq;
        const bool sliced = (u.pm >= 32);
#pragma unroll
        for (int ai = 0; ai < 2; ++ai)
#pragma unroll
            for (int m = 0; m < 4; ++m) { const int row = row0 + ai * 128 + m * 16; const int b = tok_batch(row);
                const float* rp = res ? res + (size_t)row * DM : (row < NPT ? xp + (size_t)row * DM : xs + (size_t)(row - NPT) * DM);
                const float* gp = ada + (size_t)b * ADAW + gofs; float* op = out + (size_t)row * DM;
#pragma unroll
                for (int bj = 0; bj < 2; ++bj)
#pragma unroll
                    for (int n = 0; n < 2; ++n) { const int col = col0 + bj * 128 + n * 16;
                        const f32x4 g = *(const f32x4*)(gp + col);
                        if (sliced) {
                            *(f32x4*)(part + ((size_t)(u.k0 / klen) * 512 + (row - NPT)) * DM + col) = acc[ai][bj][m][n];
                        } else { const f32x4 r = *(const f32x4*)(rp + col);
                            *(f32x4*)(op + col) = ALPHA * r + (1.f + g) * acc[ai][bj][m][n]; } } }
    } };
struct PEpiGU { static constexpr bool PERM = true, AFTER_DRAIN = false; u16* act;
    DEVI void operator()(const pg8::f32x4 (&acc)[2][2][4][2], const pg8::Unit& u, int wr, int wc, int fr, int fq) const {
        const int row0 = u.pm * 256 + wr * 64 + fr, col0 = u.pn * 128 + wc * 32 + 8 * fq;
#pragma unroll
        for (int ai = 0; ai < 2; ++ai)
#pragma unroll
            for (int m = 0; m < 4; ++m) { const int row = row0 + ai * 128 + m * 16;
                const f32x4 g0 = acc[ai][0][m][0], g1 = acc[ai][0][m][1], u0 = acc[ai][1][m][0], u1 = acc[ai][1][m][1];
                uint4 w; w.x = pack2(siluf_(g0[0]) * u0[0], siluf_(g0[1]) * u0[1]); w.y = pack2(siluf_(g0[2]) * u0[2], siluf_(g0[3]) * u0[3]);
                w.z = pack2(siluf_(g1[0]) * u1[0], siluf_(g1[1]) * u1[1]); w.w = pack2(siluf_(g1[2]) * u1[2], siluf_(g1[3]) * u1[3]);
                *(uint4*)(act + (size_t)row * DFF + col0) = w; }
    } };
struct SplitOrder : pg8::StaticOrder {
    int KS, Kfull;
    __device__ void init2(int N, int K, int G_, int c_, int KS_) { init(NPT, N, G_, c_, K); KS = KS_; Kfull = K; }
    __device__ bool next(int i, pg8::Unit& u) const {
        if (i == 0) return pg8::StaticOrder::next(0, u);
        if (i > 1 || c >= 16 * KS) return false;
        const int slice = c % KS, tile = c / KS;
        u.pm = 32 + (tile >> 3); u.pn = tile & 7; u.k0 = slice * (Kfull / KS); u.nt = Kfull / KS / 64; return true;
    }
};
template <class Epi>
DEVI void pg8_run_split(const u16* A, const u16* Bt, int N, int K, int KS, char* smem, const Epi& e) {
    pg8::Gemm g{(const pg8::bf16_t*)A, (const pg8::bf16_t*)Bt, NTOK, N, K}; SplitOrder S; S.init2(N, K, (int)gridDim.x, (int)blockIdx.x, KS);
    pg8::gemm_phase<Epi, SplitOrder, false>((PG8_LAS unsigned char*)smem, g, S, e, nullptr);
}
template <class Epi>
DEVI void pg8_run(const u16* A, const u16* Bt, int M, int N, int K, char* smem, const Epi& e) {
    pg8::Gemm g{(const pg8::bf16_t*)A, (const pg8::bf16_t*)Bt, M, N, K}; pg8::StaticOrder S; S.init(M, N, (int)gridDim.x, (int)blockIdx.x, K);
    pg8::gemm_phase<Epi, pg8::StaticOrder, false>((PG8_LAS unsigned char*)smem, g, S, e, nullptr);
}

DEVI void modulate_row(const Params& p, int row, int lane) {
    const float* ada = (const float*)(p.ws + WS_ADA); u16* Ah = (u16*)(p.ws + WS_AH);
    const float* xr = x_row(p, row); const float* ar = ada + (size_t)tok_batch(row) * ADAW;
#pragma unroll
    for (int i = 0; i < 8; ++i) { const int col = i * 256 + lane * 4;
        const f32x4 x = *(const f32x4*)(xr + col), sh = *(const f32x4*)(ar + col), sc = *(const f32x4*)(ar + DM + col);
        const f32x4 h = x * (1.f + sc) + sh; uint2 w; w.x = pack2(h[0], h[1]); w.y = pack2(h[2], h[3]);
        *(uint2*)(Ah + (size_t)row * DM + col) = w; }
}
DEVI void phase_modulate(const Params& p) {
    const int lane = threadIdx.x & 63, gw = blockIdx.x * 8 + (threadIdx.x >> 6), nw = gridDim.x * 8;
    for (int sr = gw; sr < 4 * (NTOK - NPT); sr += nw) if ((sr & 3) == 0) modulate_row(p, NPT + (sr >> 2), lane);
    for (int row = gw; row < NPT; row += nw) modulate_row(p, row, lane);
}
DEVI void ln_row(f32x4 (&v)[8], const float* g, const float* bta, int lane) {
    float s = 0.f;
#pragma unroll
    for (int i = 0; i < 8; ++i) s += v[i][0] + v[i][1] + v[i][2] + v[i][3];
    const float mu = wsum(s) * (1.f / DM);
    float q = 0.f;
#pragma unroll
    for (int i = 0; i < 8; ++i) { v[i] = v[i] - mu; q += v[i][0] * v[i][0] + v[i][1] * v[i][1] + v[i][2] * v[i][2] + v[i][3] * v[i][3]; }
    const float rs = rsqrtf(wsum(q) * (1.f / DM) + 1e-5f);
#pragma unroll
    for (int i = 0; i < 8; ++i) { const int col = i * 256 + lane * 4; v[i] = v[i] * rs * *(const f32x4*)(g + col) + *(const f32x4*)(bta + col); }
}
DEVI void ln1_row(const Params& p, int row, int lane) {
    const float* ada = (const float*)(p.ws + WS_ADA); u16* Ah = (u16*)(p.ws + WS_AH); float* x1 = (float*)(p.ws + WS_X1);
    float* xr = x1 + (size_t)row * DM; const float* ar = ada + (size_t)tok_batch(row) * ADAW;
    f32x4 v[8];
    if (row < NPT) {
#pragma unroll
        for (int i = 0; i < 8; ++i) v[i] = *(const f32x4*)(xr + i * 256 + lane * 4);
    } else { const float* part = (const float*)(p.ws + WS_PART) + (size_t)(row - NPT) * DM; const float* xs = p.x_sample + (size_t)(row - NPT) * DM;
#pragma unroll
        for (int i = 0; i < 8; ++i) { const int col = i * 256 + lane * 4; f32x4 a = {0.f, 0.f, 0.f, 0.f};
#pragma unroll
            for (int k = 0; k < 8; ++k) a += *(const f32x4*)(part + (size_t)k * 512 * DM + col);
            v[i] = ALPHA * *(const f32x4*)(xs + col) + (1.f + *(const f32x4*)(ar + 2 * DM + col)) * a; } }
    ln_row(v, p.ln1_g, p.ln1_b, lane);
#pragma unroll
    for (int i = 0; i < 8; ++i) { const int col = i * 256 + lane * 4; *(f32x4*)(xr + col) = v[i];
        const f32x4 sh = *(const f32x4*)(ar + 3 * DM + col), sc = *(const f32x4*)(ar + 4 * DM + col);
        const f32x4 h = v[i] * (1.f + sc) + sh; uint2 w; w.x = pack2(h[0], h[1]); w.y = pack2(h[2], h[3]);
        *(uint2*)(Ah + (size_t)row * DM + col) = w; }
}
DEVI void phase_ln1(const Params& p) {
    const int lane = threadIdx.x & 63, gw = blockIdx.x * 8 + (threadIdx.x >> 6), nw = gridDim.x * 8;
    for (int sr = gw; sr < 4 * (NTOK - NPT); sr += nw) if ((sr & 3) == 0) ln1_row(p, NPT + (sr >> 2), lane);
    for (int row = gw; row < NPT; row += nw) ln1_row(p, row, lane);
}
DEVI void ln2_row(const Params& p, int row, int lane) {
    float* xr = p.out + O_YP + (size_t)row * DM;
    f32x4 v[8];
    if (row < NPT) {
#pragma unroll
        for (int i = 0; i < 8; ++i) v[i] = *(const f32x4*)(xr + i * 256 + lane * 4);
    } else { const float* part = (const float*)(p.ws + WS_PART) + (size_t)(row - NPT) * DM; const float* x1r = (const float*)(p.ws + WS_X1) + (size_t)row * DM;
        const float* ar = (const float*)(p.ws + WS_ADA) + (size_t)tok_batch(row) * ADAW;
#pragma unroll
        for (int i = 0; i < 8; ++i) { const int col = i * 256 + lane * 4; f32x4 a = {0.f, 0.f, 0.f, 0.f};
#pragma unroll
            for (int k = 0; k < 11; ++k) a += *(const f32x4*)(part + (size_t)k * 512 * DM + col);
            v[i] = ALPHA * *(const f32x4*)(x1r + col) + (1.f + *(const f32x4*)(ar + 5 * DM + col)) * a; } }
    ln_row(v, p.ln2_g, p.ln2_b, lane);
#pragma unroll
    for (int i = 0; i < 8; ++i) *(f32x4*)(xr + i * 256 + lane * 4) = v[i];
}
DEVI void phase_ln2(const Params& p) {
    const int lane = threadIdx.x & 63, gw = blockIdx.x * 8 + (threadIdx.x >> 6), nw = gridDim.x * 8;
    for (int sr = gw; sr < 4 * (NTOK - NPT); sr += nw) if ((sr & 3) == 0) ln2_row(p, NPT + (sr >> 2), lane);
    for (int row = gw; row < NPT; row += nw) ln2_row(p, row, lane);
}
DEVI void phase_post(const Params& p) {
    const float* proj = (const float*)(p.ws + WS_PROJ); const float* gates = (const float*)(p.ws + WS_GATES); const u16* hbuf = (const u16*)(p.ws + WS_HBUF); u16* mix = (u16*)(p.ws + WS_MIX);
    const int lane = threadIdx.x & 63, gw = blockIdx.x * 8 + (threadIdx.x >> 6), nw = gridDim.x * 8;
    for (int row = gw; row < NPT; row += nw) {
        const u16* hr = hbuf + (size_t)row * DM; const float* pr = proj + (size_t)row * PLD; u16* mr = mix + (size_t)row * DM;
#pragma unroll
        for (int h = 0; h < 4; ++h) { const int col = h * 256 + lane * 4;
            const uint2 hv2 = *(const uint2*)(hr + col); const f32x4 v = {__uint_as_float(hv2.x << 16), __uint_as_float(hv2.x & 0xFFFF0000u), __uint_as_float(hv2.y << 16), __uint_as_float(hv2.y & 0xFFFF0000u)}; const float ss = wsum(v[0] * v[0] + v[1] * v[1] + v[2] * v[2] + v[3] * v[3]);
            const float rs = rsqrtf(ss * (1.f / 256.f) + 1e-6f);
            const f32x4 g = *(const f32x4*)(p.m_norm_g + col), o = *(const f32x4*)(pr + 3072 + col);
            uint2 w; w.x = pack2(v[0] * rs * g[0] * sigmoidf_(o[0]), v[1] * rs * g[1] * sigmoidf_(o[1]));
            w.y = pack2(v[2] * rs * g[2] * sigmoidf_(o[2]), v[3] * rs * g[3] * sigmoidf_(o[3]));
            *(uint2*)(mr + col) = w; }
#pragma unroll
        for (int h = 0; h < 8; ++h) { const int c = h * 128 + lane * 2;
            const unsigned hv1 = *(const unsigned*)(hr + 1024 + c); const float v0 = __uint_as_float(hv1 << 16), v1 = __uint_as_float(hv1 & 0xFFFF0000u); const float ss = wsum(v0 * v0 + v1 * v1);
            const float rs = rsqrtf(ss * (1.f / 128.f) + 1e-6f);
            const float z0 = pr[7168 + c], z1 = pr[7168 + c + 1];
            *(unsigned*)(mr + 1024 + c) = pack2(v0 * rs * p.g_norm_g[c] * siluf_(z0), v1 * rs * p.g_norm_g[c + 1] * siluf_(z1)); }
    }
    const int total = (4 + 128) * 3 * 3072;
    for (int i = blockIdx.x * NTHR + threadIdx.x; i < total; i += gridDim.x * NTHR) {
        const int ch = i % 3072, rj = i / 3072, j = rj % 3, b = rj / 3;
        if (b < 4) p.out[O_PCONV + (size_t)(b * 3 + j) * 3072 + ch] = proj[(size_t)(b * 2048 + 2045 + j) * PLD + 4096 + ch];
        else p.out[O_SCONV + (size_t)((b - 4) * 3 + j) * 3072 + ch] = proj[(size_t)(NPT + (b - 4) * 4 + 1 + j) * PLD + 4096 + ch];
    }
}

DEVI float scan_add(float x, int lane) { for (int o = 1; o < 64; o <<= 1) { const float y = __shfl_up(x, o); if (lane >= o) x += y; } return x; }
DEVI float scan_max(float x, int lane) { for (int o = 1; o < 64; o <<= 1) { const float y = __shfl_up(x, o); if (lane >= o) x = fmaxf(x, y); } return x; }

DEVI void mlstm_pre(const Params& p, int unit, char* smem) {
    int tid = threadIdx.x; asm volatile("" : "+v"(tid));
    const int lane = tid & 63, w = tid >> 6, fr = lane & 15, fq = lane >> 4;
    const int b = unit >> 7, h = (unit >> 5) & 3, c = unit & 31;
    u16* Qs = (u16*)smem;
    u16* Ks = Qs + 64 * 264;
    const float* proj = (const float*)(p.ws + WS_PROJ); const float* gates = (const float*)(p.ws + WS_GATES);
    u16* MP = (u16*)(p.ws + WS_MP) + (size_t)unit * 4096; u16* MKT = (u16*)(p.ws + WS_MKT) + (size_t)unit * 16384; u16* MQ = (u16*)(p.ws + WS_MQ) + (size_t)unit * 16384;
    u16* MVT = (u16*)(p.ws + WS_MVT) + (size_t)unit * 16384; float* MSC = (float*)(p.ws + WS_MSC) + (size_t)unit * 128;
    const size_t row0 = (size_t)b * 2048 + c * 64;
    const float iv = gates[(row0 + lane) * 24 + h] + p.m_i_bias[h];
    const float fv = gates[(row0 + lane) * 24 + 4 + h] + p.m_f_bias[h];
    const float bt = scan_add(logsigf_(fv), lane);
    const float av = iv - bt;
    const float ml = scan_max(av, lane);
    const float wt = __expf(av - __shfl(ml, 63));
    if (w == 0) { MSC[lane] = bt; MSC[64 + lane] = ml; }
    {
        unsigned kt[4][4], vt[4][4];
#pragma unroll
        for (int i = 0; i < 8; ++i) { const int s = w * 8 + i; const float* pr = proj + (row0 + s) * PLD + h * 256 + lane * 4;
            const f32x4 qv = *(const f32x4*)(pr), kv = *(const f32x4*)(pr + 1024) * 0.0625f, vv = *(const f32x4*)(pr + 2048);
            uint2 pq; pq.x = pack2(qv[0], qv[1]); pq.y = pack2(qv[2], qv[3]); *(uint2*)(Qs + s * 264 + lane * 4) = pq; *(uint2*)(MQ + s * 256 + lane * 4) = pq;
            uint2 pk; pk.x = pack2(kv[0], kv[1]); pk.y = pack2(kv[2], kv[3]); *(uint2*)(Ks + s * 264 + lane * 4) = pk;
            const float ws_ = __shfl(wt, s);
#pragma unroll
            for (int dd = 0; dd < 4; ++dd) { const unsigned kb = f2bf(kv[dd] * ws_), vb = f2bf(vv[dd]);
                if (i & 1) { kt[dd][i >> 1] |= kb << 16; vt[dd][i >> 1] |= vb << 16; } else { kt[dd][i >> 1] = kb; vt[dd][i >> 1] = vb; } } }
#pragma unroll
        for (int dd = 0; dd < 4; ++dd) {
            *(uint4*)(MKT + (lane * 4 + dd) * 64 + w * 8) = make_uint4(kt[dd][0], kt[dd][1], kt[dd][2], kt[dd][3]);
            *(uint4*)(MVT + (lane * 4 + dd) * 64 + w * 8) = make_uint4(vt[dd][0], vt[dd][1], vt[dd][2], vt[dd][3]); }
    }
    __syncthreads();
    {
        const int mt = w & 3, g = w >> 2;
        f32x4 acc[2]; acc[0] = acc[1] = (f32x4){0.f, 0.f, 0.f, 0.f};
#pragma unroll
        for (int kk = 0; kk < 8; ++kk) { const bf16x8 aQ = *(const bf16x8*)(Qs + (mt * 16 + fr) * 264 + kk * 32 + fq * 8);
#pragma unroll
            for (int n = 0; n < 2; ++n) acc[n] = mfma16(*(const bf16x8*)(Ks + ((g * 2 + n) * 16 + fr) * 264 + kk * 32 + fq * 8), aQ, acc[n]); }
        const int t = mt * 16 + fr; const float mlt = __shfl(ml, t);
#pragma unroll
        for (int n = 0; n < 2; ++n) { float pv[4];
#pragma unroll
            for (int j = 0; j < 4; ++j) { const int s = (g * 2 + n) * 16 + fq * 4 + j; const float as_ = __shfl(av, s);
                pv[j] = (s <= t) ? acc[n][j] * __expf(as_ - mlt) : 0.f; }
            uint2 pp; pp.x = pack2(pv[0], pv[1]); pp.y = pack2(pv[2], pv[3]);
            *(uint2*)(MP + t * 64 + (g * 2 + n) * 16 + fq * 4) = pp; }
    }
    __syncthreads();
}

struct MlLd { bf16x8 fP[2]; bf16x8 fV[4][2]; bf16x8 fK[2][2]; bf16x8 fQ[8]; float bt, ml; };
DEVI void ml_loadQ(MlLd& L, const Params& p, int unit, int mt, int fr, int fq) {
    const u16* MQ = (const u16*)(p.ws + WS_MQ) + (size_t)unit * 16384;
#pragma unroll
    for (int kk = 0; kk < 8; ++kk) L.fQ[kk] = *(const bf16x8*)(MQ + (mt * 16 + fr) * 256 + kk * 32 + fq * 8);
}
DEVI void ml_loadP(MlLd& L, const Params& p, int unit, int mt, int fr, int fq) {
    const u16* MP = (const u16*)(p.ws + WS_MP) + (size_t)unit * 4096;
#pragma unroll
    for (int k2 = 0; k2 < 2; ++k2) L.fP[k2] = *(const bf16x8*)(MP + (mt * 16 + fr) * 64 + k2 * 32 + fq * 8);
}
DEVI void ml_loadVK(MlLd& L, const Params& p, int unit, int eb, int w, int fr, int fq) {
    const u16* MKT = (const u16*)(p.ws + WS_MKT) + (size_t)unit * 16384; const u16* MVT = (const u16*)(p.ws + WS_MVT) + (size_t)unit * 16384;
#pragma unroll
    for (int k2 = 0; k2 < 2; ++k2) {
#pragma unroll
        for (int m = 0; m < 4; ++m) L.fV[m][k2] = *(const bf16x8*)(MVT + (eb * 64 + m * 16 + fr) * 64 + k2 * 32 + fq * 8);
#pragma unroll
        for (int n = 0; n < 2; ++n) L.fK[n][k2] = *(const bf16x8*)(MKT + (w * 32 + n * 16 + fr) * 64 + k2 * 32 + fq * 8); }
}
DEVI void ml_loadS(MlLd& L, const Params& p, int unit, int lane) {
    const float* MSC = (const float*)(p.ws + WS_MSC) + (size_t)unit * 128; L.bt = MSC[lane]; L.ml = MSC[64 + lane];
}
DEVI void mlstm_load(MlLd& L, const Params& p, int unit, int eb, int lane, int w, int mt, int fr, int fq) {
    ml_loadQ(L, p, unit, mt, fr, fq); ml_loadP(L, p, unit, mt, fr, fq); ml_loadVK(L, p, unit, eb, w, fr, fq); ml_loadS(L, p, unit, lane);
}
DEVI void mlstm_seq(const Params& p, int role, char* smem) {
    const int tid = threadIdx.x, lane0 = tid & 63, w0 = tid >> 6;
    const int b = role >> 4, h = (role >> 2) & 3, eb = role & 3;
    u16* Cts = (u16*)smem;
    for (int i = tid; i < 2 * 80 * 264 / 2; i += NTHR) ((unsigned*)Cts)[i] = 0u;
    u16* hbuf = (u16*)(p.ws + WS_HBUF);
    f32x4 accC[5][2];
#pragma unroll
    for (int m = 0; m < 5; ++m) { accC[m][0] = (f32x4){0.f, 0.f, 0.f, 0.f}; accC[m][1] = (f32x4){0.f, 0.f, 0.f, 0.f}; }
    float mcar = 0.f;
    const int ubase = (b * 4 + h) * 32;
    MlLd L;
    mlstm_load(L, p, ubase, eb, lane0, w0, w0 & 3, lane0 & 15, lane0 >> 4);
    __syncthreads();
    for (int c = 0; c < 32; ++c) {
        int lane = lane0, w = w0; asm volatile("" : "+v"(lane), "+v"(w));
        const int fr = lane & 15, fq = lane >> 4, mt = w & 3, g = w >> 2;
        const size_t row0 = (size_t)b * 2048 + c * 64;
        const u16* Cc = Cts + (c & 1) * 80 * 264; u16* Cn = Cts + ((c & 1) ^ 1) * 80 * 264;
        const float bt = L.bt, ml = L.ml;
        const float mr = fmaxf(ml, mcar);
        const float bL = __shfl(bt, 63), mrL = __shfl(mr, 63), mlL = __shfl(ml, 63);
        const float mnew = bL + mrL, decay = __expf(bL + mcar - mnew), rho = __expf(mlL - mrL);
        const float iw = __expf(mcar - mr), rt = __expf(ml - mr), flo = __expf(-(bt + mr));
        bf16x8 one8;
#pragma unroll
        for (int i = 0; i < 8; ++i) one8[i] = (fr == 0) ? (short)0x3F80 : (short)0;
        const bool more = (c + 1 < 32); const int nu = ubase + c + 1;
        if (more) ml_loadS(L, p, nu, lane);
        f32x4 accH1[3]; accH1[0] = accH1[1] = accH1[2] = (f32x4){0.f, 0.f, 0.f, 0.f};
#pragma unroll
        for (int kk = 0; kk < 8; ++kk) { const bf16x8 q = L.fQ[kk];
#pragma unroll
            for (int n = 0; n < 3; ++n) { const int et = n < 2 ? g * 2 + n : 4;
                accH1[n] = mfma16(q, *(const bf16x8*)(Cc + (et * 16 + fr) * 264 + kk * 32 + fq * 8), accH1[n]); } }
        __builtin_amdgcn_sched_barrier(0);
        if (more) ml_loadQ(L, p, nu, mt, fr, fq);
        __builtin_amdgcn_sched_barrier(0);
        f32x4 accH2[3]; accH2[0] = accH2[1] = accH2[2] = (f32x4){0.f, 0.f, 0.f, 0.f};
#pragma unroll
        for (int k2 = 0; k2 < 2; ++k2) {
#pragma unroll
            for (int n = 0; n < 2; ++n) { bf16x8 bv;
#pragma unroll
                for (int i = 0; i < 8; ++i) bv[i] = g ? L.fV[2 + n][k2][i] : L.fV[n][k2][i];
                accH2[n] = mfma16(L.fP[k2], bv, accH2[n]); }
            accH2[2] = mfma16(L.fP[k2], one8, accH2[2]); }
        __builtin_amdgcn_sched_barrier(0);
        if (more) ml_loadP(L, p, nu, mt, fr, fq);
        __builtin_amdgcn_sched_barrier(0);
#pragma unroll
        for (int j = 0; j < 4; ++j) { const int t = mt * 16 + fq * 4 + j;
            const float iwt = __shfl(iw, t), rtt = __shfl(rt, t), fl = __shfl(flo, t);
            const float h0 = iwt * accH1[0][j] + rtt * accH2[0][j], h1 = iwt * accH1[1][j] + rtt * accH2[1][j], hd = iwt * accH1[2][j] + rtt * accH2[2][j];
            const float den = __shfl(hd, fq * 16); const float dn = fmaxf(fabsf(den), fl);
            hbuf[(row0 + t) * DM + h * 256 + eb * 64 + (g * 2) * 16 + fr] = f2bf(h0 / dn);
            hbuf[(row0 + t) * DM + h * 256 + eb * 64 + (g * 2 + 1) * 16 + fr] = f2bf(h1 / dn); }
        __builtin_amdgcn_sched_barrier(0);
        {
            f32x4 tmp[5][2];
#pragma unroll
            for (int m = 0; m < 5; ++m) { tmp[m][0] = (f32x4){0.f, 0.f, 0.f, 0.f}; tmp[m][1] = (f32x4){0.f, 0.f, 0.f, 0.f}; }
#pragma unroll
            for (int k2 = 0; k2 < 2; ++k2)
#pragma unroll
                for (int m = 0; m < 5; ++m)
#pragma unroll
                    for (int n = 0; n < 2; ++n) tmp[m][n] = mfma16(m < 4 ? L.fV[m < 4 ? m : 0][k2] : one8, L.fK[n][k2], tmp[m][n]);
            __builtin_amdgcn_sched_barrier(0);
            if (more) ml_loadVK(L, p, nu, eb, w, fr, fq);
            __builtin_amdgcn_sched_barrier(0);
#pragma unroll
            for (int m = 0; m < 5; ++m)
#pragma unroll
                for (int n = 0; n < 2; ++n) { accC[m][n] = decay * accC[m][n] + rho * tmp[m][n];
#pragma unroll
                    for (int j = 0; j < 4; ++j) Cn[(m * 16 + fq * 4 + j) * 264 + w * 32 + n * 16 + fr] = f2bf(accC[m][n][j]); }
        }
        __builtin_amdgcn_sched_barrier(0);
        mcar = mnew;
        __syncthreads();
    }
    const int lane = lane0, w = w0, fr = lane & 15, fq = lane >> 4;
    float* pC = p.out + O_PC + (size_t)(b * 4 + h) * 65536;
#pragma unroll
    for (int m = 0; m < 4; ++m)
#pragma unroll
        for (int n = 0; n < 2; ++n) *(f32x4*)(pC + (size_t)(w * 32 + n * 16 + fr) * 256 + eb * 64 + m * 16 + fq * 4) = accC[m][n];
    if (eb == 0 && fq == 0) { p.out[O_PN + (b * 4 + h) * 256 + w * 32 + fr] = accC[4][0][0]; p.out[O_PN + (b * 4 + h) * 256 + w * 32 + 16 + fr] = accC[4][1][0]; }
    if (eb == 0 && tid == 0) p.out[O_PM + b * 4 + h] = mcar;
    __syncthreads();
}

DEVI void gdn_pre(const Params& p, int unit, char* smem) {
    int tid = threadIdx.x; asm volatile("" : "+v"(tid));
    const int lane = tid & 63, w = tid >> 6, fr = lane & 15, fq = lane >> 4;
    const int b = unit >> 8, h = (unit >> 5) & 7, c = unit & 31;
    u16* Ks = (u16*)smem;
    u16* Qs = Ks + 64 * 136;
    u16* KbT = Qs + 64 * 136;
    u16* VbT = KbT + 128 * 72;
    u16* KwT = VbT + 128 * 72;
    u16* Mb = KwT + 128 * 72;
    u16* Mtb = Mb + 2 * 64 * 72;
    u16* Ts = Mtb + 2 * 64 * 72;
    u16* Ps = Ts + 64 * 72;
    const float* proj = (const float*)(p.ws + WS_PROJ); const float* gates = (const float*)(p.ws + WS_GATES);
    u16* GQ = (u16*)(p.ws + WS_GQ) + (size_t)unit * 8192; u16* GW = (u16*)(p.ws + WS_GW) + (size_t)unit * 8192;
    u16* GP = (u16*)(p.ws + WS_GP) + (size_t)unit * 4096; u16* GU0 = (u16*)(p.ws + WS_GU0) + (size_t)unit * 8192;
    u16* GKW = (u16*)(p.ws + WS_GKW) + (size_t)unit * 8192; float* GSC = (float*)(p.ws + WS_GSC) + (size_t)unit * 80;
    const float dtb = p.g_dt_bias[h], Aexp = __expf(p.g_A_log[h]);
    const int mt = w & 3, g = w >> 2;
    const int chq = h * 128 + 2 * lane, chk = 1024 + chq, chv = 2048 + chq;
    const long row0 = (long)b * 2048 + c * 64;
    const float ga = gates[(row0 + lane) * 24 + 16 + h] + dtb;
    const float la = -Aexp * softplusf_(ga);
    const float beta = sigmoidf_(gates[(row0 + lane) * 24 + 8 + h]);
    const float bc = scan_add(la, lane);
    const float bL = __shfl(bc, 63);
    const float eb_ = __expf(bc);
    if (w == 0) { GSC[lane] = eb_; if (lane == 0) GSC[64] = __expf(bL); }
    {
        float2 cq[4], ck[4], cv[4];
#pragma unroll
        for (int j = 0; j < 4; ++j) { cq[j] = *(const float2*)(p.conv_w + j * 3072 + chq); ck[j] = *(const float2*)(p.conv_w + j * 3072 + chk); cv[j] = *(const float2*)(p.conv_w + j * 3072 + chv); }
        float2 rq[11], rk[11], rv[11];
#pragma unroll
        for (int j = 0; j < 11; ++j) { const long tg = (long)c * 64 + w * 8 - 3 + j;
            if (tg >= 0) { const float* pr = proj + ((long)b * 2048 + tg) * PLD + 4096;
                rq[j] = *(const float2*)(pr + chq); rk[j] = *(const float2*)(pr + chk); rv[j] = *(const float2*)(pr + chv); }
            else { rq[j] = make_float2(0.f, 0.f); rk[j] = make_float2(0.f, 0.f); rv[j] = make_float2(0.f, 0.f); } }
        unsigned kb0[4], kb1[4], kw0[4], kw1[4], vb0[4], vb1[4];
#pragma unroll
        for (int i = 0; i < 8; ++i) { const int s = w * 8 + i;
            float yq0 = cq[0].x * rq[i].x + cq[1].x * rq[i + 1].x + cq[2].x * rq[i + 2].x + cq[3].x * rq[i + 3].x;
            float yq1 = cq[0].y * rq[i].y + cq[1].y * rq[i + 1].y + cq[2].y * rq[i + 2].y + cq[3].y * rq[i + 3].y;
            float yk0 = ck[0].x * rk[i].x + ck[1].x * rk[i + 1].x + ck[2].x * rk[i + 2].x + ck[3].x * rk[i + 3].x;
            float yk1 = ck[0].y * rk[i].y + ck[1].y * rk[i + 1].y + ck[2].y * rk[i + 2].y + ck[3].y * rk[i + 3].y;
            float yv0 = cv[0].x * rv[i].x + cv[1].x * rv[i + 1].x + cv[2].x * rv[i + 2].x + cv[3].x * rv[i + 3].x;
            float yv1 = cv[0].y * rv[i].y + cv[1].y * rv[i + 1].y + cv[2].y * rv[i + 2].y + cv[3].y * rv[i + 3].y;
            yq0 = siluf_(yq0); yq1 = siluf_(yq1); yk0 = siluf_(yk0); yk1 = siluf_(yk1); yv0 = siluf_(yv0); yv1 = siluf_(yv1);
            const float rqn = rsqrtf(wsum(yq0 * yq0 + yq1 * yq1) + 1e-6f) * 0.08838834764831845f;
            const float rkn = rsqrtf(wsum(yk0 * yk0 + yk1 * yk1) + 1e-6f);
            yq0 *= rqn; yq1 *= rqn; yk0 *= rkn; yk1 *= rkn;
            *(unsigned*)(Qs + s * 136 + 2 * lane) = pack2(yq0, yq1);
            *(unsigned*)(Ks + s * 136 + 2 * lane) = pack2(yk0, yk1);
            const float bs_ = __shfl(bc, s), bets = __shfl(beta, s);
            const float f1 = bets * __expf(bs_), f2 = __expf(bL - bs_);
            const unsigned a0 = f2bf(yk0 * f1), a1 = f2bf(yk1 * f1), w0_ = f2bf(yk0 * f2), w1_ = f2bf(yk1 * f2), v0_ = f2bf(yv0 * bets), v1_ = f2bf(yv1 * bets);
            if (i & 1) { kb0[i >> 1] |= a0 << 16; kb1[i >> 1] |= a1 << 16; kw0[i >> 1] |= w0_ << 16; kw1[i >> 1] |= w1_ << 16; vb0[i >> 1] |= v0_ << 16; vb1[i >> 1] |= v1_ << 16; }
            else { kb0[i >> 1] = a0; kb1[i >> 1] = a1; kw0[i >> 1] = w0_; kw1[i >> 1] = w1_; vb0[i >> 1] = v0_; vb1[i >> 1] = v1_; } }
        *(uint4*)(KbT + (2 * lane) * 72 + w * 8) = make_uint4(kb0[0], kb0[1], kb0[2], kb0[3]);
        *(uint4*)(KbT + (2 * lane + 1) * 72 + w * 8) = make_uint4(kb1[0], kb1[1], kb1[2], kb1[3]);
        *(uint4*)(KwT + (2 * lane) * 72 + w * 8) = make_uint4(kw0[0], kw0[1], kw0[2], kw0[3]);
        *(uint4*)(KwT + (2 * lane + 1) * 72 + w * 8) = make_uint4(kw1[0], kw1[1], kw1[2], kw1[3]);
        *(uint4*)(VbT + (2 * lane) * 72 + w * 8) = make_uint4(vb0[0], vb0[1], vb0[2], vb0[3]);
        *(uint4*)(VbT + (2 * lane + 1) * 72 + w * 8) = make_uint4(vb1[0], vb1[1], vb1[2], vb1[3]);
    }
    __syncthreads();
    {
        f32x4 aKK[2], aQK[2];
#pragma unroll
        for (int n = 0; n < 2; ++n) aKK[n] = aQK[n] = (f32x4){0.f, 0.f, 0.f, 0.f};
#pragma unroll
        for (int k = 0; k < 128; k += 32) {
            const bf16x8 fK = *(const bf16x8*)(Ks + (mt * 16 + fr) * 136 + k + fq * 8), fQ = *(const bf16x8*)(Qs + (mt * 16 + fr) * 136 + k + fq * 8);
#pragma unroll
            for (int n = 0; n < 2; ++n) { const bf16x8 bK = *(const bf16x8*)(Ks + ((g * 2 + n) * 16 + fr) * 136 + k + fq * 8);
                aKK[n] = mfma16(fK, bK, aKK[n]); aQK[n] = mfma16(fQ, bK, aQK[n]); }
        }
#pragma unroll
        for (int n = 0; n < 2; ++n) { const int s = (g * 2 + n) * 16 + fr; const float bs_ = __shfl(bc, s);
#pragma unroll
            for (int j = 0; j < 4; ++j) { const int l = mt * 16 + fq * 4 + j; const float bl = __shfl(bc, l), betl = __shfl(beta, l);
                const float dec = __expf(fminf(bl - bs_, 0.f));
                const float nm = (s < l) ? -betl * aKK[n][j] * dec : 0.f; const u16 nmb = f2bf(nm);
                Mb[l * 72 + s] = nmb; Mtb[s * 72 + l] = nmb; Ts[l * 72 + s] = (l == s) ? (u16)0x3F80 : nmb;
                Ps[l * 72 + s] = f2bf((s <= l) ? aQK[n][j] * dec : 0.f); } }
    }
    __syncthreads();
    {
        f32x4 accT[4];
        if (w >= 4) {
#pragma unroll
            for (int n = 0; n < 4; ++n)
#pragma unroll
                for (int j = 0; j < 4; ++j) accT[n][j] = bf2f(Ts[((w - 4) * 16 + fq * 4 + j) * 72 + n * 16 + fr]);
        }
        for (int k = 1; k <= 6; ++k) {
            const int cur = (k - 1) & 1;
            const u16* Mc = Mb + cur * 64 * 72; const u16* Mtc = Mtb + cur * 64 * 72;
            if (w < 4) {
                if (k <= 5) {
                    f32x4 am[1][4];
#pragma unroll
                    for (int n = 0; n < 4; ++n) am[0][n] = (f32x4){0.f, 0.f, 0.f, 0.f};
                    mma_lds<1, 4>(am, Mc + (w * 16) * 72, 72, Mtc, 72, 64, fr, fq);
                    u16* Mn = Mb + (cur ^ 1) * 64 * 72; u16* Mtn = Mtb + (cur ^ 1) * 64 * 72;
#pragma unroll
                    for (int n = 0; n < 4; ++n)
#pragma unroll
                        for (int j = 0; j < 4; ++j) { const int l = w * 16 + fq * 4 + j, s = n * 16 + fr; const u16 v = f2bf(am[0][n][j]); Mn[l * 72 + s] = v; Mtn[s * 72 + l] = v; }
                }
            } else if (k >= 2) {
                f32x4 at[1][4];
#pragma unroll
                for (int n = 0; n < 4; ++n) at[0][n] = accT[n];
                mma_lds<1, 4>(at, Ts + ((w - 4) * 16) * 72, 72, Mtc, 72, 64, fr, fq);
#pragma unroll
                for (int n = 0; n < 4; ++n) { accT[n] = at[0][n];
#pragma unroll
                    for (int j = 0; j < 4; ++j) Ts[((w - 4) * 16 + fq * 4 + j) * 72 + n * 16 + fr] = f2bf(accT[n][j]); }
            }
            __syncthreads();
        }
    }
    {
        f32x4 aW[4], aU[4];
#pragma unroll
        for (int n = 0; n < 4; ++n) aW[n] = aU[n] = (f32x4){0.f, 0.f, 0.f, 0.f};
#pragma unroll
        for (int k2 = 0; k2 < 2; ++k2) { const bf16x8 aT = *(const bf16x8*)(Ts + (mt * 16 + fr) * 72 + k2 * 32 + fq * 8);
#pragma unroll
            for (int n = 0; n < 4; ++n) { const bf16x8 bK = *(const bf16x8*)(KbT + ((g * 4 + n) * 16 + fr) * 72 + k2 * 32 + fq * 8);
                const bf16x8 bV = *(const bf16x8*)(VbT + ((g * 4 + n) * 16 + fr) * 72 + k2 * 32 + fq * 8);
                aW[n] = mfma16(bK, aT, aW[n]);
                aU[n] = mfma16(aT, bV, aU[n]); } }
#pragma unroll
        for (int n = 0; n < 4; ++n) {
            uint2 pw; pw.x = pack2(aW[n][0], aW[n][1]); pw.y = pack2(aW[n][2], aW[n][3]);
            *(uint2*)(GW + (mt * 16 + fr) * 128 + (g * 4 + n) * 16 + fq * 4) = pw;
            uint2 pu; pu.x = pack2(aU[n][0], aU[n][1]); pu.y = pack2(aU[n][2], aU[n][3]);
            *(uint2*)(GU0 + ((g * 4 + n) * 16 + fr) * 64 + mt * 16 + fq * 4) = pu; }
#pragma unroll
        for (int i = 0; i < 2; ++i) { const int id = tid + i * NTHR;
            *(uint4*)(GQ + (id >> 4) * 128 + (id & 15) * 8) = *(const uint4*)(Qs + (id >> 4) * 136 + (id & 15) * 8);
            *(uint4*)(GKW + (id >> 3) * 64 + (id & 7) * 8) = *(const uint4*)(KwT + (id >> 3) * 72 + (id & 7) * 8); }
        *(uint4*)(GP + (tid >> 3) * 64 + (tid & 7) * 8) = *(const uint4*)(Ps + (tid >> 3) * 72 + (tid & 7) * 8);
    }
    __syncthreads();
}

struct GdnLd { bf16x8 fW[4], fQ[4], fP[2], fKw[2]; uint2 u0[2]; float ebl[4]; float ebL; };
DEVI void gdn_load(GdnLd& L, const Params& p, int unit, int eb, int w, int mt, int g, int fr, int fq) {
    const u16* GQ = (const u16*)(p.ws + WS_GQ) + (size_t)unit * 8192; const u16* GW = (const u16*)(p.ws + WS_GW) + (size_t)unit * 8192;
    const u16* GP = (const u16*)(p.ws + WS_GP) + (size_t)unit * 4096; const u16* GU0 = (const u16*)(p.ws + WS_GU0) + (size_t)unit * 8192;
    const u16* GKW = (const u16*)(p.ws + WS_GKW) + (size_t)unit * 8192; const float* GSC = (const float*)(p.ws + WS_GSC) + (size_t)unit * 80;
#pragma unroll
    for (int kk = 0; kk < 4; ++kk) { L.fW[kk] = *(const bf16x8*)(GW + (mt * 16 + fr) * 128 + kk * 32 + fq * 8); L.fQ[kk] = *(const bf16x8*)(GQ + (mt * 16 + fr) * 128 + kk * 32 + fq * 8); }
#pragma unroll
    for (int k2 = 0; k2 < 2; ++k2) { L.fP[k2] = *(const bf16x8*)(GP + (mt * 16 + fr) * 64 + k2 * 32 + fq * 8); L.fKw[k2] = *(const bf16x8*)(GKW + (w * 16 + fr) * 64 + k2 * 32 + fq * 8); }
#pragma unroll
    for (int n = 0; n < 2; ++n) L.u0[n] = *(const uint2*)(GU0 + (eb * 64 + (g * 2 + n) * 16 + fr) * 64 + mt * 16 + fq * 4);
    const f32x4 e4 = *(const f32x4*)(GSC + mt * 16 + fq * 4);
    L.ebl[0] = e4[0]; L.ebl[1] = e4[1]; L.ebl[2] = e4[2]; L.ebl[3] = e4[3]; L.ebL = GSC[64];
}
DEVI void gdn_seq(const Params& p, int role, char* smem) {
    const int tid = threadIdx.x, lane0 = tid & 63, w0 = tid >> 6;
    const int b = role >> 4, h = (role >> 1) & 7, eb = role & 1;
    u16* Sts = (u16*)smem;
    u16* Uts = Sts + 64 * 136;
    for (int i = tid; i < 64 * 136 / 2; i += NTHR) ((unsigned*)Sts)[i] = 0u;
    u16* hbuf = (u16*)(p.ws + WS_HBUF);
    f32x4 accSt[4];
#pragma unroll
    for (int m = 0; m < 4; ++m) accSt[m] = (f32x4){0.f, 0.f, 0.f, 0.f};
    const int ubase = (b * 8 + h) * 32;
    GdnLd L;
    gdn_load(L, p, ubase, eb, w0, w0 & 3, w0 >> 2, lane0 & 15, lane0 >> 4);
    __syncthreads();
    for (int c = 0; c < 32; ++c) {
        int lane = lane0, w = w0; asm volatile("" : "+v"(lane), "+v"(w));
        const int fr = lane & 15, fq = lane >> 4, mt = w & 3, g = w >> 2;
        const long row0 = (long)b * 2048 + c * 64;
        f32x4 aWS[2], accO[2];
        aWS[0] = aWS[1] = accO[0] = accO[1] = (f32x4){0.f, 0.f, 0.f, 0.f};
#pragma unroll
        for (int kk = 0; kk < 4; ++kk)
#pragma unroll
            for (int n = 0; n < 2; ++n) { const bf16x8 bS = *(const bf16x8*)(Sts + ((g * 2 + n) * 16 + fr) * 136 + kk * 32 + fq * 8);
                aWS[n] = mfma16(L.fW[kk], bS, aWS[n]); accO[n] = mfma16(L.fQ[kk], bS, accO[n]); }
#pragma unroll
        for (int n = 0; n < 2; ++n) {
            const float u0 = __uint_as_float(L.u0[n].x << 16), u1 = __uint_as_float(L.u0[n].x & 0xFFFF0000u);
            const float u2 = __uint_as_float(L.u0[n].y << 16), u3 = __uint_as_float(L.u0[n].y & 0xFFFF0000u);
            uint2 pu; pu.x = pack2(u0 - aWS[n][0], u1 - aWS[n][1]); pu.y = pack2(u2 - aWS[n][2], u3 - aWS[n][3]);
            *(uint2*)(Uts + ((g * 2 + n) * 16 + fr) * 72 + mt * 16 + fq * 4) = pu;
#pragma unroll
            for (int j = 0; j < 4; ++j) accO[n][j] *= L.ebl[j]; }
        const bf16x8 fP0 = L.fP[0], fP1 = L.fP[1], fK0 = L.fKw[0], fK1 = L.fKw[1]; const float ebL = L.ebL;
        __syncthreads();
        if (c + 1 < 32) gdn_load(L, p, ubase + c + 1, eb, w, mt, g, fr, fq);
#pragma unroll
        for (int n = 0; n < 2; ++n) {
            accO[n] = mfma16(fP0, *(const bf16x8*)(Uts + ((g * 2 + n) * 16 + fr) * 72 + fq * 8), accO[n]);
            accO[n] = mfma16(fP1, *(const bf16x8*)(Uts + ((g * 2 + n) * 16 + fr) * 72 + 32 + fq * 8), accO[n]); }
#pragma unroll
        for (int n = 0; n < 2; ++n)
#pragma unroll
            for (int j = 0; j < 4; ++j) hbuf[(row0 + mt * 16 + fq * 4 + j) * DM + 1024 + h * 128 + eb * 64 + (g * 2 + n) * 16 + fr] = f2bf(accO[n][j]);
#pragma unroll
        for (int m = 0; m < 4; ++m) { accSt[m] *= ebL;
            accSt[m] = mfma16(fK0, *(const bf16x8*)(Uts + (m * 16 + fr) * 72 + fq * 8), accSt[m]);
            accSt[m] = mfma16(fK1, *(const bf16x8*)(Uts + (m * 16 + fr) * 72 + 32 + fq * 8), accSt[m]);
            uint2 ps; ps.x = pack2(accSt[m][0], accSt[m][1]); ps.y = pack2(accSt[m][2], accSt[m][3]);
            *(uint2*)(Sts + (m * 16 + fr) * 136 + w * 16 + fq * 4) = ps; }
        __syncthreads();
    }
    const int lane = lane0, w = w0, fr = lane & 15, fq = lane >> 4;
    float* pS = p.out + O_PS + (size_t)(b * 8 + h) * 16384;
#pragma unroll
    for (int m = 0; m < 4; ++m)
#pragma unroll
        for (int j = 0; j < 4; ++j) pS[(size_t)(w * 16 + fq * 4 + j) * 128 + eb * 64 + m * 16 + fr] = accSt[m][j];
    __syncthreads();
}

DEVI void mlstm_sample(const Params& p, int item, char* smem) {
    int tid = threadIdx.x; asm volatile("" : "+v"(tid));
    const int lane = tid & 63, w = tid >> 6;
    const int bs = item >> 2, h = item & 3;
    float* qs = (float*)smem; float* ks = qs + 1024; float* vs = ks + 1024; float* red = vs + 1024; float* num = red + 8192; float* sc = num + 1024; float* sc2 = sc + 32;
    const float* proj = (const float*)(p.ws + WS_PROJ); const float* gates = (const float*)(p.ws + WS_GATES); u16* mix = (u16*)(p.ws + WS_MIX);
    const size_t row0 = NPT + (size_t)bs * 4;
    for (int i = tid; i < 3072; i += NTHR) { const int which = i >> 10, t = (i >> 8) & 3, d = i & 255;
        float v = proj[(row0 + t) * PLD + which * 1024 + h * 256 + d]; if (which == 1) v *= 0.0625f; qs[i] = v; }
    float m = p.st_m[bs * 4 + h]; float fw[4], iw[4], flo[4];
    const float ib = p.m_i_bias[h], fb = p.m_f_bias[h];
#pragma unroll
    for (int t = 0; t < 4; ++t) { const float iv = gates[(row0 + t) * 24 + h] + ib; const float lf = logsigf_(gates[(row0 + t) * 24 + 4 + h] + fb);
        const float mn = fmaxf(lf + m, iv); fw[t] = __expf(lf + m - mn); iw[t] = __expf(iv - mn); flo[t] = __expf(-mn); m = mn; }
    __syncthreads();
    float qn[4] = {0.f, 0.f, 0.f, 0.f};
    if (tid < 256) { float n = p.st_n[(bs * 4 + h) * 256 + tid];
#pragma unroll
        for (int t = 0; t < 4; ++t) { n = fw[t] * n + iw[t] * ks[t * 256 + tid]; qn[t] = qs[t * 256 + tid] * n; }
        p.out[O_SN + (bs * 4 + h) * 256 + tid] = n; }
#pragma unroll
    for (int t = 0; t < 4; ++t) { const float r = wsum(qn[t]); if (lane == 0) sc[w * 4 + t] = r; }
    const float* Cin = p.st_C + (size_t)(bs * 4 + h) * 65536; float* Cout = p.out + O_SC + (size_t)(bs * 4 + h) * 65536;
    float Cr[32], Cx[32];
#pragma unroll
    for (int i = 0; i < 32; ++i) Cr[i] = Cin[(w * 32 + i) * 256 + lane];
#pragma unroll
    for (int slab = 0; slab < 4; ++slab) {
        if (slab < 3) {
#pragma unroll
            for (int i = 0; i < 32; ++i) Cx[i] = Cin[(w * 32 + i) * 256 + (slab + 1) * 64 + lane];
        }
        float pn[4];
#pragma unroll
        for (int t = 0; t < 4; ++t) { const float vt = vs[t * 256 + slab * 64 + lane] * iw[t]; float a = 0.f;
#pragma unroll
            for (int i = 0; i < 32; ++i) { Cr[i] = fw[t] * Cr[i] + ks[t * 256 + w * 32 + i] * vt; a += qs[t * 256 + w * 32 + i] * Cr[i]; }
            pn[t] = a; }
#pragma unroll
        for (int i = 0; i < 32; ++i) Cout[(w * 32 + i) * 256 + slab * 64 + lane] = Cr[i];
#pragma unroll
        for (int t = 0; t < 4; ++t) red[((slab * 4 + t) * 8 + w) * 64 + lane] = pn[t];
#pragma unroll
        for (int i = 0; i < 32; ++i) Cr[i] = Cx[i];
    }
    __syncthreads();
    for (int o = tid; o < 1024; o += NTHR) { const int t = o >> 8, e = o & 255, slab = e >> 6, l = e & 63; float sacc = 0.f;
#pragma unroll
        for (int g = 0; g < 8; ++g) sacc += red[((slab * 4 + t) * 8 + g) * 64 + l];
        num[t * 256 + e] = sacc; }
    __syncthreads();
    float hv[4];
    if (tid < 256) {
#pragma unroll
        for (int t = 0; t < 4; ++t) { float den = 0.f;
#pragma unroll
            for (int g = 0; g < 8; ++g) den += sc[g * 4 + t];
            hv[t] = num[t * 256 + tid] / fmaxf(fabsf(den), flo[t]);
            const float r = wsum(hv[t] * hv[t]); if (lane == 0) sc2[w * 4 + t] = r; }
    }
    __syncthreads();
    if (tid < 256) {
#pragma unroll
        for (int t = 0; t < 4; ++t) { const float ss = sc2[t] + sc2[4 + t] + sc2[8 + t] + sc2[12 + t]; const float rs = rsqrtf(ss * (1.f / 256.f) + 1e-6f);
            const float mo = proj[(row0 + t) * PLD + 3072 + h * 256 + tid];
            mix[(row0 + t) * DM + h * 256 + tid] = f2bf(hv[t] * rs * p.m_norm_g[h * 256 + tid] * sigmoidf_(mo)); }
    }
    if (tid == 0) p.out[O_SM + bs * 4 + h] = m;
    __syncthreads();
}

DEVI void gdn_sample(const Params& p, int item, char* smem) {
    int tid = threadIdx.x; asm volatile("" : "+v"(tid));
    const int lane = tid & 63, w = tid >> 6;
    const int bs = item >> 3, h = item & 7;
    float* qkv = (float*)smem;
    float* red = qkv + 1536;
    float* ored = red + 1024;
    float* sc = ored + 2048;
    const float* proj = (const float*)(p.ws + WS_PROJ); const float* gates = (const float*)(p.ws + WS_GATES); u16* mix = (u16*)(p.ws + WS_MIX);
    const size_t row0 = NPT + (size_t)bs * 4;
    if (tid < 384) { const int which = tid >> 7, dch = tid & 127, ch = which * 1024 + h * 128 + dch;
        float xp[7];
#pragma unroll
        for (int j = 0; j < 3; ++j) xp[j] = p.st_conv[(size_t)(bs * 3 + j) * 3072 + ch];
#pragma unroll
        for (int t = 0; t < 4; ++t) xp[3 + t] = proj[(row0 + t) * PLD + 4096 + ch];
        float cw[4];
#pragma unroll
        for (int j = 0; j < 4; ++j) cw[j] = p.conv_w[j * 3072 + ch];
#pragma unroll
        for (int t = 0; t < 4; ++t) qkv[(which * 4 + t) * 128 + dch] = siluf_(cw[0] * xp[t] + cw[1] * xp[t + 1] + cw[2] * xp[t + 2] + cw[3] * xp[t + 3]); }
    float at[4], be[4];
    { const float dtb = p.g_dt_bias[h], Aexp = __expf(p.g_A_log[h]);
#pragma unroll
        for (int t = 0; t < 4; ++t) { at[t] = __expf(-Aexp * softplusf_(gates[(row0 + t) * 24 + 16 + h] + dtb)); be[t] = sigmoidf_(gates[(row0 + t) * 24 + 8 + h]); } }
    __syncthreads();
    { const int which = w >> 2, t = w & 3; float* a = qkv + (which * 4 + t) * 128; const float v0 = a[lane * 2], v1 = a[lane * 2 + 1];
        const float sc_ = rsqrtf(wsum(v0 * v0 + v1 * v1) + 1e-6f) * (which == 0 ? 0.08838834764831845f : 1.f);
        a[lane * 2] = v0 * sc_; a[lane * 2 + 1] = v1 * sc_; }
    __syncthreads();
    const float* qf = qkv; const float* kf = qkv + 512; const float* vf = qkv + 1024;
    const int e = tid & 127, dg = tid >> 7;
    const float* Sin = p.st_S + (size_t)(bs * 8 + h) * 16384; float* Sout = p.out + O_SS + (size_t)(bs * 8 + h) * 16384;
    float Sr[32];
#pragma unroll
    for (int i = 0; i < 32; ++i) Sr[i] = Sin[(dg * 32 + i) * 128 + e];
#pragma unroll
    for (int t = 0; t < 4; ++t) {
        float r = 0.f;
#pragma unroll
        for (int i = 0; i < 32; ++i) r += kf[t * 128 + dg * 32 + i] * Sr[i];
        red[((t & 1) * 4 + dg) * 128 + e] = r;
        __syncthreads();
        const float rr = red[((t & 1) * 4 + 0) * 128 + e] + red[((t & 1) * 4 + 1) * 128 + e] + red[((t & 1) * 4 + 2) * 128 + e] + red[((t & 1) * 4 + 3) * 128 + e];
        const float u = be[t] * (vf[t * 128 + e] - at[t] * rr);
        float po = 0.f;
#pragma unroll
        for (int i = 0; i < 32; ++i) { Sr[i] = at[t] * Sr[i] + kf[t * 128 + dg * 32 + i] * u; po += qf[t * 128 + dg * 32 + i] * Sr[i]; }
        ored[(t * 4 + dg) * 128 + e] = po;
    }
#pragma unroll
    for (int i = 0; i < 32; ++i) Sout[(dg * 32 + i) * 128 + e] = Sr[i];
    __syncthreads();
    float ov[4];
    if (tid < 128) {
#pragma unroll
        for (int t = 0; t < 4; ++t) { ov[t] = ored[(t * 4 + 0) * 128 + tid] + ored[(t * 4 + 1) * 128 + tid] + ored[(t * 4 + 2) * 128 + tid] + ored[(t * 4 + 3) * 128 + tid];
            const float r = wsum(ov[t] * ov[t]); if (lane == 0) sc[w * 4 + t] = r; }
    }
    __syncthreads();
    if (tid < 128) {
#pragma unroll
        for (int t = 0; t < 4; ++t) { const float rs = rsqrtf((sc[t] + sc[4 + t]) * (1.f / 128.f) + 1e-6f);
            const float gz = proj[(row0 + t) * PLD + 7168 + h * 128 + tid];
            mix[(row0 + t) * DM + 1024 + h * 128 + tid] = f2bf(ov[t] * rs * p.g_norm_g[h * 128 + tid] * siluf_(gz)); }
    }
    __syncthreads();
}

#ifndef SCM
#define SCM 15
#endif
DEVI void phase_scan(const Params& p, char* smem) {
    const int G = gridDim.x, bid = blockIdx.x;
    if (G >= 192) {
        if (bid < 64) { if (SCM & 1) mlstm_seq(p, bid, smem); }
        else if (bid < 128) { if (SCM & 2) gdn_seq(p, bid - 64, smem); }
        unsigned* q = (unsigned*)(p.ws + WS_BAR) + 64;
        volatile unsigned* lq = (volatile unsigned*)(smem + LDS_BYTES - 32);
        for (;;) {
            __syncthreads();
            if (threadIdx.x == 0) *lq = __hip_atomic_fetch_add(q, 1u, __ATOMIC_RELAXED, __HIP_MEMORY_SCOPE_AGENT);
            __syncthreads();
            const unsigned u = *lq;
            if (u >= 1536u) break;
            if (u < 512u) mlstm_sample(p, (int)u, smem); else gdn_sample(p, (int)u - 512, smem);
        }
        pop_late(p, smem, 1 << 30);
        if (p.ph_hi - p.ph_lo == 1) pop_late(p, smem, 1 << 30, 1);
    } else {
        for (int u = bid; u < 128 + 512 + 1024; u += G) {
            if (u < 64) { if (SCM & 1) mlstm_seq(p, u, smem); } else if (u < 128) { if (SCM & 2) gdn_seq(p, u - 64, smem); }
            else if (u < 640) { if (SCM & 4) mlstm_sample(p, u - 128, smem); } else { if (SCM & 8) gdn_sample(p, u - 640, smem); } }
        pop_late(p, smem, 1 << 30);
    }
}

#define XB_TMO      128
#define XB_XCNT(j)  (256  + 64 * (j))
#define XB_XSUB(j)  (1280 + 64 * (j))
#define XB_XGEN(j)  (2304 + 64 * (j))
#define XB_TOP      3328
#define XB_TOPGEN   3392
#define XCD_BAR_WORDS 3456
#define XB_SPIN_CAP (1u << 18)
#define LAS __attribute__((address_space(3)))

__device__ __forceinline__ unsigned xb_ld(unsigned* p)              { return __hip_atomic_load(p, __ATOMIC_RELAXED, __HIP_MEMORY_SCOPE_AGENT); }
__device__ __forceinline__ unsigned xb_add(unsigned* p, unsigned v) { return __hip_atomic_fetch_add(p, v, __ATOMIC_RELAXED, __HIP_MEMORY_SCOPE_AGENT); }
__device__ __forceinline__ unsigned xb_xcc_id() { return (unsigned)__builtin_amdgcn_s_getreg((3 << 11) | 20) & 0xFu; }
#define XB_SPIN(cond, bar) do { unsigned _sp = 0; while (cond) { __builtin_amdgcn_s_sleep(1); \
    if ((++_sp & 255u) == 0u) { if (xb_ld(&(bar)[XB_TMO])) break; if (_sp > XB_SPIN_CAP) { atomicAdd(&(bar)[XB_TMO], 1u); break; } } } } while (0)

struct XcdBarrier {
    unsigned* bar; unsigned x;
    volatile LAS unsigned* st;
};

__device__ __forceinline__ XcdBarrier xcd_barrier_post(unsigned* bar, volatile LAS unsigned* st) {
    XcdBarrier b; b.bar = bar; b.x = xb_xcc_id(); b.st = st;
    if (threadIdx.x == 0) (void)xb_add(&bar[XB_XCNT(b.x)], 1u);
    return b;
}
__device__ __forceinline__ void xcd_barrier_complete(unsigned* bar, unsigned x, unsigned& nloc, unsigned& nx) {
    const unsigned G = gridDim.x * gridDim.y * gridDim.z;
    unsigned sum, cnt, mine, sp = 0u;
    for (;;) {
        sum = 0u; cnt = 0u; mine = 0u;
#pragma unroll
        for (unsigned j = 0; j < 16; ++j) { const unsigned c = xb_ld(&bar[XB_XCNT(j)]); sum += c; cnt += (c > 0u) ? 1u : 0u; mine = (j == x) ? c : mine; }
        if (sum == G) break;
        __builtin_amdgcn_s_sleep(1);
        if ((++sp & 255u) == 0u) { if (xb_ld(&bar[XB_TMO])) break; if (sp > XB_SPIN_CAP) { atomicAdd(&bar[XB_TMO], 1u); break; } }
    }
    nloc = mine > 0u ? mine : 1u; nx = cnt > 0u ? cnt : 1u;
}

__device__ __forceinline__ void xcd_barrier(const XcdBarrier& b) {
    asm volatile("s_waitcnt vmcnt(0)" ::: "memory");
    __syncthreads();
    if (threadIdx.x == 0) {
        unsigned* bar = b.bar;
        __builtin_amdgcn_s_waitcnt(0);
        unsigned nloc = b.st[0], nx = b.st[1];
        if (nloc == 0u) { xcd_barrier_complete(bar, b.x, nloc, nx); b.st[0] = nloc; b.st[1] = nx; }
        const unsigned old = xb_add(&bar[XB_XSUB(b.x)], 1u);
        const unsigned gen = old / nloc;
        if (old + 1u == (gen + 1u) * nloc) {
            __builtin_amdgcn_fence(__ATOMIC_RELEASE, "agent");
            asm volatile("s_waitcnt vmcnt(0)" ::: "memory");
            const unsigned og = xb_add(&bar[XB_TOP], 1u);
            const unsigned tg = og / nx;
            if (og + 1u == (tg + 1u) * nx) xb_add(&bar[XB_TOPGEN], 1u);
            else XB_SPIN(xb_ld(&bar[XB_TOPGEN]) == tg, bar);
            __builtin_amdgcn_fence(__ATOMIC_ACQUIRE, "agent");
            xb_add(&bar[XB_XGEN(b.x)], 1u);
            asm volatile("s_waitcnt vmcnt(0)" ::: "memory");
        } else {
            XB_SPIN(xb_ld(&bar[XB_XGEN(b.x)]) == gen, bar);
            __builtin_amdgcn_fence(__ATOMIC_ACQUIRE, "agent");
            asm volatile("s_waitcnt vmcnt(0)" ::: "memory");
        }
    }
    __syncthreads();
}

__global__ void __launch_bounds__(NTHR) fwd_kernel(Params p) {
    extern __shared__ __attribute__((aligned(16))) char smem[];
    cg::grid_group grid = cg::this_grid();
    const int lo = p.ph_lo, hi = p.ph_hi;
    if (lo == 777) grid.sync();
    volatile LAS unsigned* xst = (volatile LAS unsigned*)(smem + LDS_BYTES - 16);
    if (threadIdx.x < 2) xst[threadIdx.x] = 0u;
    __syncthreads();
    XcdBarrier xbar; xbar.bar = (unsigned*)(p.ws + WS_BAR); xbar.x = 0; xbar.st = xst;
    if (hi - lo > 1) xbar = xcd_barrier_post((unsigned*)(p.ws + WS_BAR), xst);
#ifndef PHMASK
#define PHMASK 0xFFFF
#endif
#define PHASE(k) if (((PHMASK >> (k)) & 1) && lo <= (k) && (k) < hi)
#define SEAM(k) if (lo <= (k) && (k) + 1 < hi) xcd_barrier(xbar)
    PHASE(0) phase_prep(p, smem);
    SEAM(0);
    PHASE(2) phase_modulate(p);
    SEAM(2);
    PHASE(3) { PEpiProj e{(float*)(p.ws + WS_PROJ), (float*)(p.ws + WS_GATES)}; pg8_run((const u16*)(p.ws + WS_AH), (const u16*)(p.ws + WS_WIN), NTOK, 8448, DM, smem, e);
        if (hi - lo > 1 && 4 * (int)gridDim.x + (int)blockIdx.x >= 34 * 33) pop_late(p, smem, 9); }
    SEAM(3);
    PHASE(4) { for (int u = blockIdx.x; u < 1536; u += gridDim.x) { if (u < 512) mlstm_pre(p, u, smem); else gdn_pre(p, u - 512, smem); } }
    SEAM(4);
    PHASE(5) phase_scan(p, smem);
    SEAM(5);
    PHASE(6) phase_post(p);
    SEAM(6);
    PHASE(7) { PEpiRes e{p.x_prompt, p.x_sample, nullptr, (const float*)(p.ws + WS_ADA), 2 * DM, (float*)(p.ws + WS_X1), (float*)(p.ws + WS_PART), DM / 8};
        pg8_run_split((const u16*)(p.ws + WS_MIX), (const u16*)(p.ws + WS_WOUT), DM, DM, 8, smem, e);
        if (hi - lo > 1 && blockIdx.x >= 128) pop_late(p, smem, 2, 1); }
    SEAM(7);
    PHASE(8) phase_ln1(p);
    SEAM(8);
    PHASE(9) { PEpiGU e{(u16*)(p.ws + WS_ACT)}; pg8_run((const u16*)(p.ws + WS_AH), (const u16*)(p.ws + WS_WGU), NTOK, 2 * DFF, DM, smem, e);
        if (hi - lo > 1) { if (5 * (int)gridDim.x + (int)blockIdx.x >= 34 * 44) pop_late(p, smem, 9, 1); pop_late(p, smem, 1 << 30, 1); } }
    SEAM(9);
    PHASE(10) { PEpiRes e{p.x_prompt, p.x_sample, (const float*)(p.ws + WS_X1), (const float*)(p.ws + WS_ADA), 5 * DM, p.out + O_YP, (float*)(p.ws + WS_PART), DFF / 11};
        pg8_run_split((const u16*)(p.ws + WS_ACT), (const u16*)(p.ws + WS_WDOWN), DM, DFF, 11, smem, e); }
    SEAM(10);
    PHASE(11) phase_ln2(p);
}

extern "C" void kernel_launch(void* const* d_in, const int* in_sizes, int n_in, void* d_out, int out_size, void* d_ws, size_t ws_size,
                              hipStream_t stream) {
    static int grid = 0;
    if (grid == 0) {
        if (n_in != 26 || ws_size < WS_END) { fprintf(stderr, "kernel_launch: unexpected n_in %d / ws_size %zu\n", n_in, ws_size); grid = -1; return; }
        int dev = 0, cus = 0, per_cu = 0;
        hipGetDevice(&dev);
        hipDeviceGetAttribute(&cus, hipDeviceAttributeMultiprocessorCount, dev);
        hipFuncSetAttribute((const void*)fwd_kernel, hipFuncAttributeMaxDynamicSharedMemorySize, LDS_BYTES);
        hipOccupancyMaxActiveBlocksPerMultiprocessor(&per_cu, (const void*)fwd_kernel, NTHR, LDS_BYTES);
        if (per_cu < 1) { fprintf(stderr, "kernel_launch: occupancy query says %d blocks/CU\n", per_cu); grid = -1; return; }
        grid = cus * per_cu;
    }
    if (grid < 0) return;
    Params p{};
    const float** f = (const float**)&p;
    for (int i = 0; i < 26; ++i) f[i] = (const float*)d_in[i];
    p.out = (float*)d_out; p.ws = (unsigned char*)d_ws;
    hipMemsetAsync((char*)d_ws + WS_BAR, 0, XCD_BAR_WORDS * 4, stream);
#if FUSED
    p.ph_lo = 0; p.ph_hi = 12;
    void* args[] = {&p};
    hipError_t e = hipLaunchCooperativeKernel((const void*)fwd_kernel, dim3(grid), dim3(NTHR), args, LDS_BYTES, stream);
    if (e != hipSuccess) fprintf(stderr, "cooperative launch failed: %s (grid %d)\n", hipGetErrorString(e), grid);
#else
    for (int ph = 0; ph < 12; ++ph) { p.ph_lo = ph; p.ph_hi = ph + 1; hipLaunchKernelGGL(fwd_kernel, dim3(grid), dim3(NTHR), LDS_BYTES, stream, p); }
#endif
}
```

```cpp
#include <hip/hip_runtime.h>
#include <hip/hip_cooperative_groups.h>
#include <cstdio>
namespace cg = cooperative_groups;

#ifndef FUSED
#define FUSED 1
#endif

#define DEVI __device__ __forceinline__
typedef unsigned short u16;
typedef short bf16x8 __attribute__((ext_vector_type(8)));
typedef float f32x4 __attribute__((ext_vector_type(4)));

constexpr int NTHR = 512;
constexpr int DM = 2048, NTOK = 8704, NPT = 8192, INC = 8216, PLD = 8192, DFF = 5632, ADAW = 12288;
constexpr int LDS_BYTES = 158 * 1024;
constexpr float ALPHA = 1.189207115002721f;

constexpr size_t O_YP = 0, O_PC = 17825792, O_PN = 18874368, O_PM = 18878464, O_PS = 18878480, O_PCONV = 19402768,
                 O_SC = 19439632, O_SN = 52994064, O_SM = 53125136, O_SS = 53125648, O_SCONV = 69902864;
constexpr size_t WS_WOUT = 0, WS_WGU = 8388608, WS_WDOWN = 54525952, WS_ADA = 77594624, WS_AC = 84082688,
                 WS_WIN = 85131264, WS_WADA = 119734272, WS_HBUF = WS_WIN, WS_AH = 170065920, WS_MIX = 205717504,
                 WS_PROJ = 241369088, WS_X1 = 85131264  , WS_ACT = WS_PROJ + 71303168, WS_GATES = 527417344, WS_GQ = 152240128, WS_GW = 169017344, WS_GP = 185794560, WS_GSC = 194183168,
                 WS_GU0 = 528252928, WS_GKW = 545030144, WS_MKT = 561807360, WS_MVT = 578584576,
                 WS_PART = 528252928  , WS_MP = 194510848, WS_MSC = 198705152, WS_MQ = 118685696, WS_BAR = 595361792, WS_END = 595378176;

struct Params {
    const float* x_prompt; const float* x_sample; const float* st_C; const float* st_n; const float* st_m; const float* st_S;
    const float* st_conv; const float* c_prompt; const float* c_sample; const float* w_ada; const float* b_ada; const float* w_in;
    const float* m_i_bias; const float* m_f_bias; const float* m_norm_g; const float* conv_w; const float* g_dt_bias;
    const float* g_A_log; const float* g_norm_g; const float* w_out; const float* ln1_g; const float* ln1_b; const float* w_gu;
    const float* w_down; const float* ln2_g; const float* ln2_b;
    float* out; unsigned char* ws;
    int ph_lo, ph_hi;
};

typedef float f32x2_t __attribute__((ext_vector_type(2)));
typedef __bf16 bf16x2_t __attribute__((ext_vector_type(2)));
DEVI unsigned pack2(float a, float b) { const f32x2_t v = {a, b}; const bf16x2_t r = __builtin_convertvector(v, bf16x2_t); return __builtin_bit_cast(unsigned, r); }
DEVI u16 f2bf(float f) { const __bf16 r = (__bf16)f; return __builtin_bit_cast(u16, r); }
DEVI float bf2f(u16 b) { return __uint_as_float(((unsigned)b) << 16); }
DEVI float wsum(float v) { for (int o = 32; o; o >>= 1) v += __shfl_xor(v, o); return v; }
DEVI float sigmoidf_(float x) { return 1.f / (1.f + __expf(-x)); }
DEVI float siluf_(float x) { return x / (1.f + __expf(-x)); }
DEVI float softplusf_(float x) { return fmaxf(x, 0.f) + log1pf(__expf(-fabsf(x))); }
DEVI float logsigf_(float x) { return fminf(x, 0.f) - log1pf(__expf(-fabsf(x))); }
DEVI f32x4 mfma16(bf16x8 a, bf16x8 b, f32x4 c) { return __builtin_amdgcn_mfma_f32_16x16x32_bf16(a, b, c, 0, 0, 0); }
DEVI int tok_batch(int row) { return row < NPT ? (row >> 11) : 4 + ((row - NPT) >> 2); }
DEVI const float* x_row(const Params& p, int row) { return row < NPT ? p.x_prompt + (size_t)row * DM : p.x_sample + (size_t)(row - NPT) * DM; }

template <int MT, int NT>
DEVI void mma_lds(f32x4 (&acc)[MT][NT], const u16* A, int lda, const u16* B, int ldb, int K, int fr, int fq) {
    for (int k = 0; k < K; k += 32) {
        bf16x8 a[MT], b[NT];
#pragma unroll
        for (int m = 0; m < MT; ++m) a[m] = *(const bf16x8*)(A + (m * 16 + fr) * lda + k + fq * 8);
#pragma unroll
        for (int n = 0; n < NT; ++n) b[n] = *(const bf16x8*)(B + (n * 16 + fr) * ldb + k + fq * 8);
#pragma unroll
        for (int m = 0; m < MT; ++m)
#pragma unroll
            for (int n = 0; n < NT; ++n) acc[m][n] = mfma16(a[m], b[n], acc[m][n]);
    }
}

namespace pg8 {
#define PG8_LAS __attribute__((address_space(3)))
typedef unsigned short bf16_t;
typedef short bf16x8 __attribute__((ext_vector_type(8)));
typedef float f32x4 __attribute__((ext_vector_type(4)));
typedef unsigned u32x4 __attribute__((ext_vector_type(4)));
constexpr int BM = 256, BK = 64, HALF = 128, HTB = HALF * BK * 2  , STAGE_BYTES = 8 * HTB, NXCD = 8, WGM = 8;

__host__ __device__ __forceinline__ int lds_byte(int r, int c) { const int st = (r >> 4) * 2 + (c >> 5), rr = r & 15, cc = c & 31, ob = rr * 64 + cc * 2; return st * 1024 + (ob ^ (((ob >> 9) & 1) << 5)); }
__host__ __device__ __forceinline__ void stage_rc(int b, int& R, int& C) { const int st = b / 1024, sb = b % 1024, swz = sb ^ (((sb >> 9) & 1) << 5); R = (st >> 1) * 16 + swz / 64; C = (st & 1) * 32 + (swz % 64) / 2; }
__host__ __device__ __forceinline__ int perm32(int rho) { const int n = rho >> 4, i = rho & 15; return 8 * (i >> 2) + 4 * n + (i & 3); }

struct Unit { int pm, pn, k0, nt; };
struct Gemm { const bf16_t* A; const bf16_t* Bt; int M, N, K; };

struct StaticOrder {
    int nM, nN, nwg, G, c, Kt;
    __host__ __device__ void init(int M, int N, int G_, int c_, int K_ = 0) { nM = M / BM; nN = N / BM; nwg = nM * nN; G = G_; c = c_; Kt = K_ / BK; }
    __host__ __device__ bool next(int i, Unit& u) const {
        const long L = (long)i * G + c; if (L >= nwg) return false;
        int wgid = (int)L; { const int q = nwg / NXCD, r = nwg % NXCD, xcd = wgid % NXCD, off = wgid / NXCD; wgid = (xcd < r ? xcd * (q + 1) : r * (q + 1) + (xcd - r) * q) + off; }
        const int nig = WGM * nN, gid = wgid / nig, fm = gid * WGM, gsz = (nM - fm) < WGM ? (nM - fm) : WGM;
        u.pm = fm + ((wgid % nig) % gsz); u.pn = (wgid % nig) / gsz; u.k0 = 0; u.nt = Kt; return true;
    }
    __device__ __forceinline__ void a_ready(const Unit&) const {}
    __device__ __forceinline__ void done(const Unit&) const {}
};
__device__ __forceinline__ unsigned cvt_pk_bf16(float lo, float hi) { unsigned r; asm volatile("v_cvt_pk_bf16_f32 %0, %1, %2" : "=v"(r) : "v"(lo), "v"(hi)); return r; }
template <class Epi, class Sched, bool STAMP = false>
__device__ __forceinline__ void gemm_phase(PG8_LAS unsigned char* lds, const Gemm g, const Sched& S, const Epi& E, unsigned long long* stamps) {
    const int tid = threadIdx.x, wid = __builtin_amdgcn_readfirstlane(tid >> 6), lane = tid & 63, wr = wid >> 2, wc = wid & 3, fr = lane & 15, fq = lane >> 4;
    const int K = g.K;
    int ts_lo = 0, ts_hi = 0, nts = 0; const unsigned long long rt_entry = STAMP ? (unsigned long long)wall_clock64() : 0ull;
#define PG8_STAMP() do { if (STAMP && wid == 0 && nts < 64) { const unsigned long long _c = (unsigned long long)clock64(); \
        ts_lo = (lane == nts) ? (int)(unsigned)_c : ts_lo; ts_hi = (lane == nts) ? (int)(unsigned)(_c >> 32) : ts_hi; ++nts; } } while (0)
    PG8_STAMP();
    unsigned voffA[2], voffB[2];
#pragma unroll
    for (int i = 0; i < 2; ++i) { int R, C; stage_rc(tid * 16 + i * 8192, R, C); const int Rb = Epi::PERM ? ((R & ~31) + perm32(R & 31)) : R;
        voffA[i] = (unsigned)(R * K + C) * 2u; voffB[i] = (unsigned)(Rb * K + C) * 2u; }
    const size_t kstep = (size_t)(BK * 2);
    const size_t hstep = (size_t)HALF * K * 2;
    const size_t tstep = 2 * hstep;
    const unsigned ldsw = (unsigned)wid * 1024u;
    const int aoff = lds_byte(wr * 64 + fr, fq * 8), boff = lds_byte(wc * 32 + fr, fq * 8);
#define PG8_SA(b, h) (((b) * 2 + (h)) * HTB)
#define PG8_SB(b, h) ((4 + (b) * 2 + (h)) * HTB)
#define PG8_STAGE(bufoff, gbase, voff) do { _Pragma("unroll") for (int _i = 0; _i < 2; ++_i) \
        __builtin_amdgcn_global_load_lds((const unsigned*)((const char*)(gbase) + (voff)[_i]), (PG8_LAS unsigned*)(lds + (bufoff) + ldsw + _i * 8192), 16, 0, 0); } while (0)
#define PG8_LDA(dst, b, h) do { _Pragma("unroll") for (int m = 0; m < 4; ++m) _Pragma("unroll") for (int k = 0; k < 2; ++k) dst[m][k] = *(const PG8_LAS bf16x8*)(lds + PG8_SA(b, h) + aoff + m * 2048 + k * 1024); } while (0)
#define PG8_LDB(dst, b, h) do { _Pragma("unroll") for (int n = 0; n < 2; ++n) _Pragma("unroll") for (int k = 0; k < 2; ++k) dst[n][k] = *(const PG8_LAS bf16x8*)(lds + PG8_SB(b, h) + boff + n * 2048 + k * 1024); } while (0)
#define PG8_MMA(ai, bj, At, Bt) do { __builtin_amdgcn_s_setprio(1); _Pragma("unroll") for (int m = 0; m < 4; ++m) _Pragma("unroll") for (int n = 0; n < 2; ++n) _Pragma("unroll") for (int k = 0; k < 2; ++k) \
        acc[ai][bj][m][n] = __builtin_amdgcn_mfma_f32_16x16x32_bf16(Bt[n][k], At[m][k], acc[ai][bj][m][n], 0, 0, 0); __builtin_amdgcn_s_setprio(0); } while (0)
#define PG8_WAIT_V(n) asm volatile("s_waitcnt vmcnt(" #n ")" ::: "memory")
#define PG8_WAIT_L(n) asm volatile("s_waitcnt lgkmcnt(" #n ")" ::: "memory")
#define PG8_BAR __builtin_amdgcn_s_barrier()
#define PG8_SCHED __builtin_amdgcn_sched_barrier(0)
    Unit cur, nxt; int ui = 0;
    if (!S.next(0, cur)) return;
    f32x4 acc[2][2][4][2];
#pragma unroll
    for (int a = 0; a < 2; ++a)
#pragma unroll
        for (int b = 0; b < 2; ++b)
#pragma unroll
            for (int m = 0; m < 4; ++m)
#pragma unroll
                for (int n = 0; n < 2; ++n) acc[a][b][m][n] = (f32x4){0.f, 0.f, 0.f, 0.f};
    bf16x8 At[4][2], B0[2][2], B1[2][2];
    const char* cA = (const char*)g.A + (size_t)cur.pm * tstep + (size_t)cur.k0 * 2; const char* cB = (const char*)g.Bt + (size_t)cur.pn * tstep + (size_t)cur.k0 * 2;
    S.a_ready(cur);
    PG8_STAGE(PG8_SB(0, 0), cB, voffB); PG8_STAGE(PG8_SA(0, 0), cA, voffA); PG8_STAGE(PG8_SB(0, 1), cB + hstep, voffB); PG8_STAGE(PG8_SA(0, 1), cA + hstep, voffA);
    if (wr == 1) PG8_BAR;
    PG8_WAIT_V(4); PG8_BAR;
    PG8_STAGE(PG8_SB(1, 0), cB + kstep, voffB); PG8_STAGE(PG8_SA(1, 0), cA + kstep, voffA); PG8_STAGE(PG8_SB(1, 1), cB + hstep + kstep, voffB);
    PG8_WAIT_V(6); PG8_BAR;
    PG8_STAMP();
    for (;;) {
        const bool has_next = S.next(ui + 1, nxt);
        const char* nA = has_next ? (const char*)g.A + (size_t)nxt.pm * tstep + (size_t)nxt.k0 * 2 : cA; const char* nB = has_next ? (const char*)g.Bt + (size_t)nxt.pn * tstep + (size_t)nxt.k0 * 2 : cB;
        const int nt = cur.nt;
        for (int t = 0; t < nt; t += 2) {
            const bool last = (t == nt - 2);
            const char* a1 = cA + (size_t)(t + 1) * kstep;
            const char* a2 = last ? nA : cA + (size_t)(t + 2) * kstep; const char* b2 = last ? nB : cB + (size_t)(t + 2) * kstep;
            const char* a3 = a2 + kstep; const char* b3 = b2 + kstep;
            if (last && has_next) S.a_ready(nxt);
            PG8_LDB(B0, 0, 0); PG8_SCHED; PG8_LDA(At, 0, 0); PG8_STAGE(PG8_SA(1, 1), a1 + hstep, voffA);
            PG8_WAIT_L(8); PG8_BAR; PG8_WAIT_L(0); PG8_MMA(0, 0, At, B0); PG8_BAR; PG8_SCHED;
            PG8_LDB(B1, 0, 1); PG8_STAGE(PG8_SB(0, 0), b2, voffB);
            PG8_BAR; PG8_WAIT_L(0); PG8_MMA(0, 1, At, B1); PG8_BAR;
            PG8_LDA(At, 0, 1); PG8_STAGE(PG8_SA(0, 0), a2, voffA);
            PG8_BAR; PG8_WAIT_L(0); PG8_MMA(1, 0, At, B0); PG8_BAR; PG8_SCHED;
            PG8_STAGE(PG8_SB(0, 1), b2 + hstep, voffB);
            PG8_WAIT_V(6); PG8_BAR; PG8_MMA(1, 1, At, B1); PG8_BAR;
            PG8_LDB(B0, 1, 0); PG8_SCHED; PG8_LDA(At, 1, 0); PG8_STAGE(PG8_SA(0, 1), a2 + hstep, voffA);
            PG8_WAIT_L(8); PG8_BAR; PG8_WAIT_L(0); PG8_MMA(0, 0, At, B0); PG8_BAR; PG8_SCHED;
            PG8_LDB(B1, 1, 1); PG8_STAGE(PG8_SB(1, 0), b3, voffB);
            PG8_BAR; PG8_WAIT_L(0); PG8_MMA(0, 1, At, B1); PG8_BAR;
            PG8_LDA(At, 1, 1); PG8_STAGE(PG8_SA(1, 0), a3, voffA);
            PG8_BAR; PG8_WAIT_L(0); PG8_MMA(1, 0, At, B0); PG8_BAR; PG8_SCHED;
            PG8_STAGE(PG8_SB(1, 1), b3 + hstep, voffB);
            PG8_WAIT_V(6); PG8_BAR; PG8_MMA(1, 1, At, B1); PG8_BAR;
        }
        PG8_STAMP();
        if constexpr (!Epi::AFTER_DRAIN) { E(acc, cur, wr, wc, fr, fq); S.done(cur); }
        PG8_STAMP();
        if (!has_next) break;
#pragma unroll
        for (int a = 0; a < 2; ++a)
#pragma unroll
            for (int b = 0; b < 2; ++b)
#pragma unroll
                for (int m = 0; m < 4; ++m)
#pragma unroll
                    for (int n = 0; n < 2; ++n) acc[a][b][m][n] = (f32x4){0.f, 0.f, 0.f, 0.f};
        cur = nxt; cA = nA; cB = nB; ++ui;
    }
    PG8_WAIT_V(0);
    if (wr == 0) PG8_BAR;
    PG8_BAR;
    if constexpr (Epi::AFTER_DRAIN) { E.fused(acc, cur, wr, wc, fr, fq, lds, wid, lane); S.done(cur); }
    PG8_STAMP();
    if (STAMP && wid == 0) { stamps[lane] = lane < nts ? (((unsigned long long)(unsigned)ts_hi << 32) | (unsigned)ts_lo) : 0ull;
        if (lane == 62) stamps[62] = rt_entry; if (lane == 63) stamps[63] = (unsigned long long)wall_clock64(); }
#undef PG8_STAMP
#undef PG8_SA
#undef PG8_SB
#undef PG8_STAGE
#undef PG8_LDA
#undef PG8_LDB
#undef PG8_MMA
#undef PG8_WAIT_V
#undef PG8_WAIT_L
#undef PG8_BAR
#undef PG8_SCHED
}
}

DEVI void transpose_tile4(const float* src, int ldsrc, int nvalid, int k0, int c00, int c01, int c02, int c03, u16* dst, int ldd, u16* t) {
    int tid = threadIdx.x; asm volatile("" : "+v"(tid));
    const int kr = tid >> 4, n4 = (tid & 15) * 4;
    float4 v[4][2];
#pragma unroll
    for (int q = 0; q < 4; ++q) { const int c0 = q == 0 ? c00 : q == 1 ? c01 : q == 2 ? c02 : c03;
#pragma unroll
        for (int i = 0; i < 2; ++i) { v[q][i] = make_float4(0.f, 0.f, 0.f, 0.f);
            if (c0 + n4 < nvalid) v[q][i] = *(const float4*)(src + (size_t)(k0 + kr + 32 * i) * ldsrc + c0 + n4); } }
#pragma unroll
    for (int q = 0; q < 4; ++q)
#pragma unroll
        for (int i = 0; i < 2; ++i) { const int k = kr + 32 * i; u16* tq = t + q * 64 * 72;
            tq[(n4 + 0) * 72 + k] = f2bf(v[q][i].x); tq[(n4 + 1) * 72 + k] = f2bf(v[q][i].y); tq[(n4 + 2) * 72 + k] = f2bf(v[q][i].z); tq[(n4 + 3) * 72 + k] = f2bf(v[q][i].w); }
    __syncthreads();
#pragma unroll
    for (int q = 0; q < 4; ++q) { const int n = tid >> 3, kc = tid & 7;
        *(uint4*)(dst + (size_t)(q * 64 + n) * ldd + k0 + kc * 8) = *(const uint4*)(t + q * 64 * 72 + n * 72 + kc * 8); }
    __syncthreads();
}

DEVI void ada_job(const Params& p, int job, char* smem) {
    int tid = threadIdx.x; asm volatile("" : "+v"(tid));
    const int lane = tid & 63, w = tid >> 6, fr = lane & 15, fq = lane >> 4;
    u16* T = (u16*)smem;
    const int n0 = job * 64;
    float* ada = (float*)(p.ws + WS_ADA);
    f32x4 acc0[4], acc1[4];
#pragma unroll
    for (int n = 0; n < 4; ++n) acc0[n] = acc1[n] = (f32x4){0.f, 0.f, 0.f, 0.f};
    const int kr = tid >> 4, n4 = (tid & 15) * 4;
    const int r0 = 16 * w + fr;
    const float* c0 = (r0 < 4 ? p.c_prompt + (size_t)r0 * DM : p.c_sample + (size_t)(r0 - 4) * DM) + fq * 8;
    const bool v1 = (fr < 4);
    const float* c1 = p.c_sample + (size_t)(124 + (v1 ? fr : 0)) * DM + fq * 8;
    const float* wsrc = p.w_ada + (size_t)kr * ADAW + n0 + n4;
    float4 wv[4][2];
#pragma unroll
    for (int q = 0; q < 4; ++q)
#pragma unroll
        for (int i = 0; i < 2; ++i) wv[q][i] = *(const float4*)(wsrc + (size_t)(q * 64 + 32 * i) * ADAW);
    for (int gk = 0; gk < 8; ++gk) {
#pragma unroll
        for (int q = 0; q < 4; ++q)
#pragma unroll
            for (int i = 0; i < 2; ++i) { const int k = kr + 32 * i; u16* tq = T + q * 64 * 72;
                tq[(n4 + 0) * 72 + k] = f2bf(wv[q][i].x); tq[(n4 + 1) * 72 + k] = f2bf(wv[q][i].y); tq[(n4 + 2) * 72 + k] = f2bf(wv[q][i].z); tq[(n4 + 3) * 72 + k] = f2bf(wv[q][i].w); }
        __syncthreads();
        if (gk + 1 < 8) {
#pragma unroll
            for (int q = 0; q < 4; ++q)
#pragma unroll
                for (int i = 0; i < 2; ++i) wv[q][i] = *(const float4*)(wsrc + (size_t)((gk + 1) * 256 + q * 64 + 32 * i) * ADAW);
        }
#pragma unroll
        for (int q = 0; q < 4; ++q) { const int kt = gk * 4 + q; const u16* Tc = T + q * 64 * 72;
            bf16x8 a0[2], a1[2];
#pragma unroll
            for (int k2 = 0; k2 < 2; ++k2) { const f32x4 x0 = *(const f32x4*)(c0 + kt * 64 + k2 * 32), x1 = *(const f32x4*)(c0 + kt * 64 + k2 * 32 + 4);
                bf16x8 qq; qq[0] = (short)f2bf(siluf_(x0[0])); qq[1] = (short)f2bf(siluf_(x0[1])); qq[2] = (short)f2bf(siluf_(x0[2])); qq[3] = (short)f2bf(siluf_(x0[3]));
                qq[4] = (short)f2bf(siluf_(x1[0])); qq[5] = (short)f2bf(siluf_(x1[1])); qq[6] = (short)f2bf(siluf_(x1[2])); qq[7] = (short)f2bf(siluf_(x1[3])); a0[k2] = qq; }
            if (w == 0) {
#pragma unroll
                for (int k2 = 0; k2 < 2; ++k2) { const f32x4 x0 = *(const f32x4*)(c1 + kt * 64 + k2 * 32), x1 = *(const f32x4*)(c1 + kt * 64 + k2 * 32 + 4);
                    bf16x8 qq; qq[0] = (short)f2bf(siluf_(x0[0])); qq[1] = (short)f2bf(siluf_(x0[1])); qq[2] = (short)f2bf(siluf_(x0[2])); qq[3] = (short)f2bf(siluf_(x0[3]));
                    qq[4] = (short)f2bf(siluf_(x1[0])); qq[5] = (short)f2bf(siluf_(x1[1])); qq[6] = (short)f2bf(siluf_(x1[2])); qq[7] = (short)f2bf(siluf_(x1[3]));
#pragma unroll
                    for (int e = 0; e < 8; ++e) qq[e] = v1 ? qq[e] : (short)0;
                    a1[k2] = qq; }
            }
#pragma unroll
            for (int k2 = 0; k2 < 2; ++k2)
#pragma unroll
                for (int n = 0; n < 4; ++n) { const bf16x8 bb = *(const bf16x8*)(Tc + (n * 16 + fr) * 72 + k2 * 32 + fq * 8);
                    acc0[n] = mfma16(a0[k2], bb, acc0[n]); if (w == 0) acc1[n] = mfma16(a1[k2], bb, acc1[n]); }
        }
        __syncthreads();
    }
#pragma unroll
    for (int n = 0; n < 4; ++n) { const int col = n0 + n * 16 + fr; const float bias = p.b_ada[col];
#pragma unroll
        for (int j = 0; j < 4; ++j) { ada[(size_t)(16 * w + fq * 4 + j) * ADAW + col] = acc0[n][j] + bias;
            if (w == 0 && fq == 0) ada[(size_t)(128 + j) * ADAW + col] = acc1[n][j] + bias; } }
    __syncthreads();
}

DEVI void phase_prep(const Params& p, char* smem) {
    u16* t = (u16*)smem;
    u16* WinT = (u16*)(p.ws + WS_WIN);
    constexpr int JA = 192, JB = 32 * 33;
    constexpr int TOT = JA + JB;
    for (int job = blockIdx.x; job < TOT; job += gridDim.x) {
        int j = job;
        if (j < JA) { ada_job(p, j, smem); continue; }
        j -= JA;
        { const int kt = j & 31, rg = j >> 5, c = rg * 256; transpose_tile4(p.w_in, INC, INC, kt * 64, c, c + 64, c + 128, c + 192, WinT + (size_t)rg * 256 * DM, DM, t); }
    }
}
constexpr int N_LATE_TR = 32 * 8 + 32 * 44 + 88 * 8;
DEVI void late_transpose(const Params& p, int j, char* smem) {
    u16* t = (u16*)smem; u16* WoutT = (u16*)(p.ws + WS_WOUT); u16* WguT = (u16*)(p.ws + WS_WGU); u16* WdownT = (u16*)(p.ws + WS_WDOWN);
    if (j < 32 * 8) { const int kt = j & 31, rg = j >> 5, c = rg * 256; transpose_tile4(p.w_out, DM, DM, kt * 64, c, c + 64, c + 128, c + 192, WoutT + (size_t)rg * 256 * DM, DM, t); return; }
    j -= 32 * 8;
    if (j < 32 * 44) { const int kt = j & 31, jj = j >> 5;
        transpose_tile4(p.w_gu, 2 * DFF, 2 * DFF, kt * 64, 128 * jj, 128 * jj + 64, DFF + 128 * jj, DFF + 128 * jj + 64, WguT + (size_t)jj * 256 * DM, DM, t); return; }
    j -= 32 * 44;
    { const int kt = j % 88, rg = j / 88, c = rg * 256; transpose_tile4(p.w_down, DM, DM, kt * 64, c, c + 64, c + 128, c + 192, WdownT + (size_t)rg * 256 * DFF, DFF, t); }
}
DEVI void pop_late(const Params& p, char* smem, int maxjobs, int list = 0) {
    unsigned* q2 = (unsigned*)(p.ws + WS_BAR) + 96 + 4 * list;
    const unsigned base = list ? 32 * 8 + 32 * 44 : 0, cnt = list ? 88 * 8 : 32 * 8 + 32 * 44;
    volatile unsigned* lq = (volatile unsigned*)(smem + LDS_BYTES - 32);
    for (int n = 0; n < maxjobs; ++n) {
        __syncthreads();
        if (threadIdx.x == 0) *lq = __hip_atomic_fetch_add(q2, 1u, __ATOMIC_RELAXED, __HIP_MEMORY_SCOPE_AGENT);
        __syncthreads();
        const unsigned u = *lq;
        if (u >= cnt) break;
        late_transpose(p, (int)(base + u), smem);
    }
    __syncthreads();
}

struct PEpiProj { static constexpr bool PERM = false, AFTER_DRAIN = false; float* C; float* gates;
    DEVI void operator()(const pg8::f32x4 (&acc)[2][2][4][2], const pg8::Unit& u, int wr, int wc, int fr, int fq) const {
        const int row0 = u.pm * 256 + wr * 64 + fr, col0 = u.pn * 256 + wc * 32 + 4 * fq;
        if (u.pn == 32) {
            if (wc == 0) {
#pragma unroll
                for (int ai = 0; ai < 2; ++ai)
#pragma unroll
                    for (int m = 0; m < 4; ++m) { float* gp = gates + (size_t)(row0 + ai * 128 + m * 16) * 24 + 4 * fq;
                        *(f32x4*)gp = acc[ai][0][m][0]; if (fq < 2) *(f32x4*)(gp + 16) = acc[ai][0][m][1]; }
            }
            return;
        }
#pragma unroll
        for (int ai = 0; ai < 2; ++ai)
#pragma unroll
            for (int m = 0; m < 4; ++m) { float* rowp = C + (size_t)(row0 + ai * 128 + m * 16) * PLD + col0;
#pragma unroll
                for (int bj = 0; bj < 2; ++bj)
#pragma unroll
                    for (int n = 0; n < 2; ++n) *(f32x4*)(rowp + bj * 128 + n * 16) = acc[ai][bj][m][n]; }
    } };
struct PEpiRes { static constexpr bool PERM = false, AFTER_DRAIN = false;
    const float* xp; const float* xs; const float* res; const float* ada; int gofs; float* out; float* part; int klen;
    DEVI void operator()(const pg8::f32x4 (&acc)[2][2][4][2], const pg8::Unit& u, int wr, int wc, int fr, int fq) const {
        const int row0 = u.pm * 256 + wr * 64 + fr, col0 = u.pn * 256 + wc * 32 + 4 * fq;
        const bool sliced = (u.pm >= 32);
#pragma unroll
        for (int ai = 0; ai < 2; ++ai)
#pragma unroll
            for (int m = 0; m < 4; ++m) { const int row = row0 + ai * 128 + m * 16; const int b = tok_batch(row);
                const float* rp = res ? res + (size_t)row * DM : (row < NPT ? xp + (size_t)row * DM : xs + (size_t)(row - NPT) * DM);
                const float* gp = ada + (size_t)b * ADAW + gofs; float* op = out + (size_t)row * DM;
#pragma unroll
                for (int bj = 0; bj < 2; ++bj)
#pragma unroll
                    for (int n = 0; n < 2; ++n) { const int col = col0 + bj * 128 + n * 16;
                        const f32x4 g = *(const f32x4*)(gp + col);
                        if (sliced) {
                            *(f32x4*)(part + ((size_t)(u.k0 / klen) * 512 + (row - NPT)) * DM + col) = acc[ai][bj][m][n];
                        } else { const f32x4 r = *(const f32x4*)(rp + col);
                            *(f32x4*)(op + col) = ALPHA * r + (1.f + g) * acc[ai][bj][m][n]; } } }
    } };
struct PEpiGU { static constexpr bool PERM = true, AFTER_DRAIN = false; u16* act;
    DEVI void operator()(const pg8::f32x4 (&acc)[2][2][4][2], const pg8::Unit& u, int wr, int wc, int fr, int fq) const {
        const int row0 = u.pm * 256 + wr * 64 + fr, col0 = u.pn * 128 + wc * 32 + 8 * fq;
#pragma unroll
        for (int ai = 0; ai < 2; ++ai)
#pragma unroll
            for (int m = 0; m < 4; ++m) { const int row = row0 + ai * 128 + m * 16;
                const f32x4 g0 = acc[ai][0][m][0], g1 = acc[ai][0][m][1], u0 = acc[ai][1][m][0], u1 = acc[ai][1][m][1];
                uint4 w; w.x = pack2(siluf_(g0[0]) * u0[0], siluf_(g0[1]) * u0[1]); w.y = pack2(siluf_(g0[2]) * u0[2], siluf_(g0[3]) * u0[3]);
                w.z = pack2(siluf_(g1[0]) * u1[0], siluf_(g1[1]) * u1[1]); w.w = pack2(siluf_(g1[2]) * u1[2], siluf_(g1[3]) * u1[3]);
                *(uint4*)(act + (size_t)row * DFF + col0) = w; }
    } };
struct SplitOrder : pg8::StaticOrder {
    int KS, Kfull;
    __device__ void init2(int N, int K, int G_, int c_, int KS_) { init(NPT, N, G_, c_, K); KS = KS_; Kfull = K; }
    __device__ bool next(int i, pg8::Unit& u) const {
        if (i == 0) return pg8::StaticOrder::next(0, u);
        if (i > 1 || c >= 16 * KS) return false;
        const int slice = c % KS, tile = c / KS;
        u.pm = 32 + (tile >> 3); u.pn = tile & 7; u.k0 = slice * (Kfull / KS); u.nt = Kfull / KS / 64; return true;
    }
};
template <class Epi>
DEVI void pg8_run_split(const u16* A, const u16* Bt, int N, int K, int KS, char* smem, const Epi& e) {
    pg8::Gemm g{(const pg8::bf16_t*)A, (const pg8::bf16_t*)Bt, NTOK, N, K}; SplitOrder S; S.init2(N, K, (int)gridDim.x, (int)blockIdx.x, KS);
    pg8::gemm_phase<Epi, SplitOrder, false>((PG8_LAS unsigned char*)smem, g, S, e, nullptr);
}
template <class Epi>
DEVI void pg8_run(const u16* A, const u16* Bt, int M, int N, int K, char* smem, const Epi& e) {
    pg8::Gemm g{(const pg8::bf16_t*)A, (const pg8::bf16_t*)Bt, M, N, K}; pg8::StaticOrder S; S.init(M, N, (int)gridDim.x, (int)blockIdx.x, K);
    pg8::gemm_phase<Epi, pg8::StaticOrder, false>((PG8_LAS unsigned char*)smem, g, S, e, nullptr);
}

DEVI void modulate_row(const Params& p, int row, int lane) {
    const float* ada = (const float*)(p.ws + WS_ADA); u16* Ah = (u16*)(p.ws + WS_AH);
    const float* xr = x_row(p, row); const float* ar = ada + (size_t)tok_batch(row) * ADAW;
#pragma unroll
    for (int i = 0; i < 8; ++i) { const int col = i * 256 + lane * 4;
        const f32x4 x = *(const f32x4*)(xr + col), sh = *(const f32x4*)(ar + col), sc = *(const f32x4*)(ar + DM + col);
        const f32x4 h = x * (1.f + sc) + sh; uint2 w; w.x = pack2(h[0], h[1]); w.y = pack2(h[2], h[3]);
        *(uint2*)(Ah + (size_t)row * DM + col) = w; }
}
DEVI void phase_modulate(const Params& p) {
    const int lane = threadIdx.x & 63, gw = blockIdx.x * 8 + (threadIdx.x >> 6), nw = gridDim.x * 8;
    for (int sr = gw; sr < 4 * (NTOK - NPT); sr += nw) if ((sr & 3) == 0) modulate_row(p, NPT + (sr >> 2), lane);
    for (int row = gw; row < NPT; row += nw) modulate_row(p, row, lane);
}
DEVI void ln_row(f32x4 (&v)[8], const float* g, const float* bta, int lane) {
    float s = 0.f;
#pragma unroll
    for (int i = 0; i < 8; ++i) s += v[i][0] + v[i][1] + v[i][2] + v[i][3];
    const float mu = wsum(s) * (1.f / DM);
    float q = 0.f;
#pragma unroll
    for (int i = 0; i < 8; ++i) { v[i] = v[i] - mu; q += v[i][0] * v[i][0] + v[i][1] * v[i][1] + v[i][2] * v[i][2] + v[i][3] * v[i][3]; }
    const float rs = rsqrtf(wsum(q) * (1.f / DM) + 1e-5f);
#pragma unroll
    for (int i = 0; i < 8; ++i) { const int col = i * 256 + lane * 4; v[i] = v[i] * rs * *(const f32x4*)(g + col) + *(const f32x4*)(bta + col); }
}
DEVI void ln1_row(const Params& p, int row, int lane) {
    const float* ada = (const float*)(p.ws + WS_ADA); u16* Ah = (u16*)(p.ws + WS_AH); float* x1 = (float*)(p.ws + WS_X1);
    float* xr = x1 + (size_t)row * DM; const float* ar = ada + (size_t)tok_batch(row) * ADAW;
    f32x4 v[8];
    if (row < NPT) {
#pragma unroll
        for (int i = 0; i < 8; ++i) v[i] = *(const f32x4*)(xr + i * 256 + lane * 4);
    } else { const float* part = (const float*)(p.ws + WS_PART) + (size_t)(row - NPT) * DM; const float* xs = p.x_sample + (size_t)(row - NPT) * DM;
#pragma unroll
        for (int i = 0; i < 8; ++i) { const int col = i * 256 + lane * 4; f32x4 a = {0.f, 0.f, 0.f, 0.f};
#pragma unroll
            for (int k = 0; k < 8; ++k) a += *(const f32x4*)(part + (size_t)k * 512 * DM + col);
            v[i] = ALPHA * *(const f32x4*)(xs + col) + (1.f + *(const f32x4*)(ar + 2 * DM + col)) * a; } }
    ln_row(v, p.ln1_g, p.ln1_b, lane);
#pragma unroll
    for (int i = 0; i < 8; ++i) { const int col = i * 256 + lane * 4; *(f32x4*)(xr + col) = v[i];
        const f32x4 sh = *(const f32x4*)(ar + 3 * DM + col), sc = *(const f32x4*)(ar + 4 * DM + col);
        const f32x4 h = v[i] * (1.f + sc) + sh; uint2 w; w.x = pack2(h[0], h[1]); w.y = pack2(h[2], h[3]);
        *(uint2*)(Ah + (size_t)row * DM + col) = w; }
}
DEVI void phase_ln1(const Params& p) {
    const int lane = threadIdx.x & 63, gw = blockIdx.x * 8 + (threadIdx.x >> 6), nw = gridDim.x * 8;
    for (int sr = gw; sr < 4 * (NTOK - NPT); sr += nw) if ((sr & 3) == 0) ln1_row(p, NPT + (sr >> 2), lane);
    for (int row = gw; row < NPT; row += nw) ln1_row(p, row, lane);
}
DEVI void ln2_row(const Params& p, int row, int lane) {
    float* xr = p.out + O_YP + (size_t)row * DM;
    f32x4 v[8];
    if (row < NPT) {
#pragma unroll
        for (int i = 0; i < 8; ++i) v[i] = *(const f32x4*)(xr + i * 256 + lane * 4);
    } else { const float* part = (const float*)(p.ws + WS_PART) + (size_t)(row - NPT) * DM; const float* x1r = (const float*)(p.ws + WS_X1) + (size_t)row * DM;
        const float* ar = (const float*)(p.ws + WS_ADA) + (size_t)tok_batch(row) * ADAW;
#pragma unroll
        for (int i = 0; i < 8; ++i) { const int col = i * 256 + lane * 4; f32x4 a = {0.f, 0.f, 0.f, 0.f};
#pragma unroll
            for (int k = 0; k < 11; ++k) a += *(const f32x4*)(part + (size_t)k * 512 * DM + col);
            v[i] = ALPHA * *(const f32x4*)(x1r + col) + (1.f + *(const f32x4*)(ar + 5 * DM + col)) * a; } }
    ln_row(v, p.ln2_g, p.ln2_b, lane);
#pragma unroll
    for (int i = 0; i < 8; ++i) *(f32x4*)(xr + i * 256 + lane * 4) = v[i];
}
DEVI void phase_ln2(const Params& p) {
    const int lane = threadIdx.x & 63, gw = blockIdx.x * 8 + (threadIdx.x >> 6), nw = gridDim.x * 8;
    for (int sr = gw; sr < 4 * (NTOK - NPT); sr += nw) if ((sr & 3) == 0) ln2_row(p, NPT + (sr >> 2), lane);
    for (int row = gw; row < NPT; row += nw) ln2_row(p, row, lane);
}
DEVI void phase_post(const Params& p) {
    const float* proj = (const float*)(p.ws + WS_PROJ); const float* gates = (const float*)(p.ws + WS_GATES); const u16* hbuf = (const u16*)(p.ws + WS_HBUF); u16* mix = (u16*)(p.ws + WS_MIX);
    const int lane = threadIdx.x & 63, gw = blockIdx.x * 8 + (threadIdx.x >> 6), nw = gridDim.x * 8;
    for (int row = gw; row < NPT; row += nw) {
        const u16* hr = hbuf + (size_t)row * DM; const float* pr = proj + (size_t)row * PLD; u16* mr = mix + (size_t)row * DM;
#pragma unroll
        for (int h = 0; h < 4; ++h) { const int col = h * 256 + lane * 4;
            const uint2 hv2 = *(const uint2*)(hr + col); const f32x4 v = {__uint_as_float(hv2.x << 16), __uint_as_float(hv2.x & 0xFFFF0000u), __uint_as_float(hv2.y << 16), __uint_as_float(hv2.y & 0xFFFF0000u)}; const float ss = wsum(v[0] * v[0] + v[1] * v[1] + v[2] * v[2] + v[3] * v[3]);
            const float rs = rsqrtf(ss * (1.f / 256.f) + 1e-6f);
            const f32x4 g = *(const f32x4*)(p.m_norm_g + col), o = *(const f32x4*)(pr + 3072 + col);
            uint2 w; w.x = pack2(v[0] * rs * g[0] * sigmoidf_(o[0]), v[1] * rs * g[1] * sigmoidf_(o[1]));
            w.y = pack2(v[2] * rs * g[2] * sigmoidf_(o[2]), v[3] * rs * g[3] * sigmoidf_(o[3]));
            *(uint2*)(mr + col) = w; }
#pragma unroll
        for (int h = 0; h < 8; ++h) { const int c = h * 128 + lane * 2;
            const unsigned hv1 = *(const unsigned*)(hr + 1024 + c); const float v0 = __uint_as_float(hv1 << 16), v1 = __uint_as_float(hv1 & 0xFFFF0000u); const float ss = wsum(v0 * v0 + v1 * v1);
            const float rs = rsqrtf(ss * (1.f / 128.f) + 1e-6f);
            const float z0 = pr[7168 + c], z1 = pr[7168 + c + 1];
            *(unsigned*)(mr + 1024 + c) = pack2(v0 * rs * p.g_norm_g[c] * siluf_(z0), v1 * rs * p.g_norm_g[c + 1] * siluf_(z1)); }
    }
    const int total = (4 + 128) * 3 * 3072;
    for (int i = blockIdx.x * NTHR + threadIdx.x; i < total; i += gridDim.x * NTHR) {
        const int ch = i % 3072, rj = i / 3072, j = rj % 3, b = rj / 3;
        if (b < 4) p.out[O_PCONV + (size_t)(b * 3 + j) * 3072 + ch] = proj[(size_t)(b * 2048 + 2045 + j) * PLD + 4096 + ch];
        else p.out[O_SCONV + (size_t)((b - 4) * 3 + j) * 3072 + ch] = proj[(size_t)(NPT + (b - 4) * 4 + 1 + j) * PLD + 4096 + ch];
    }
}

DEVI float scan_add(float x, int lane) { for (int o = 1; o < 64; o <<= 1) { const float y = __shfl_up(x, o); if (lane >= o) x += y; } return x; }
DEVI float scan_max(float x, int lane) { for (int o = 1; o < 64; o <<= 1) { const float y = __shfl_up(x, o); if (lane >= o) x = fmaxf(x, y); } return x; }

DEVI void mlstm_pre(const Params& p, int unit, char* smem) {
    int tid = threadIdx.x; asm volatile("" : "+v"(tid));
    const int lane = tid & 63, w = tid >> 6, fr = lane & 15, fq = lane >> 4;
    const int b = unit >> 7, h = (unit >> 5) & 3, c = unit & 31;
    u16* Qs = (u16*)smem;
    u16* Ks = Qs + 64 * 264;
    const float* proj = (const float*)(p.ws + WS_PROJ); const float* gates = (const float*)(p.ws + WS_GATES);
    u16* MP = (u16*)(p.ws + WS_MP) + (size_t)unit * 4096; u16* MKT = (u16*)(p.ws + WS_MKT) + (size_t)unit * 16384; u16* MQ = (u16*)(p.ws + WS_MQ) + (size_t)unit * 16384;
    u16* MVT = (u16*)(p.ws + WS_MVT) + (size_t)unit * 16384; float* MSC = (float*)(p.ws + WS_MSC) + (size_t)unit * 128;
    const size_t row0 = (size_t)b * 2048 + c * 64;
    const float iv = gates[(row0 + lane) * 24 + h] + p.m_i_bias[h];
    const float fv = gates[(row0 + lane) * 24 + 4 + h] + p.m_f_bias[h];
    const float bt = scan_add(logsigf_(fv), lane);
    const float av = iv - bt;
    const float ml = scan_max(av, lane);
    const float wt = __expf(av - __shfl(ml, 63));
    if (w == 0) { MSC[lane] = bt; MSC[64 + lane] = ml; }
    {
        unsigned kt[4][4], vt[4][4];
#pragma unroll
        for (int i = 0; i < 8; ++i) { const int s = w * 8 + i; const float* pr = proj + (row0 + s) * PLD + h * 256 + lane * 4;
            const f32x4 qv = *(const f32x4*)(pr), kv = *(const f32x4*)(pr + 1024) * 0.0625f, vv = *(const f32x4*)(pr + 2048);
            uint2 pq; pq.x = pack2(qv[0], qv[1]); pq.y = pack2(qv[2], qv[3]); *(uint2*)(Qs + s * 264 + lane * 4) = pq; *(uint2*)(MQ + s * 256 + lane * 4) = pq;
            uint2 pk; pk.x = pack2(kv[0], kv[1]); pk.y = pack2(kv[2], kv[3]); *(uint2*)(Ks + s * 264 + lane * 4) = pk;
            const float ws_ = __shfl(wt, s);
#pragma unroll
            for (int dd = 0; dd < 4; ++dd) { const unsigned kb = f2bf(kv[dd] * ws_), vb = f2bf(vv[dd]);
                if (i & 1) { kt[dd][i >> 1] |= kb << 16; vt[dd][i >> 1] |= vb << 16; } else { kt[dd][i >> 1] = kb; vt[dd][i >> 1] = vb; } } }
#pragma unroll
        for (int dd = 0; dd < 4; ++dd) {
            *(uint4*)(MKT + (lane * 4 + dd) * 64 + w * 8) = make_uint4(kt[dd][0], kt[dd][1], kt[dd][2], kt[dd][3]);
            *(uint4*)(MVT + (lane * 4 + dd) * 64 + w * 8) = make_uint4(vt[dd][0], vt[dd][1], vt[dd][2], vt[dd][3]); }
    }
    __syncthreads();
    {
        const int mt = w & 3, g = w >> 2;
        f32x4 acc[2]; acc[0] = acc[1] = (f32x4){0.f, 0.f, 0.f, 0.f};
#pragma unroll
        for (int kk = 0; kk < 8; ++kk) { const bf16x8 aQ = *(const bf16x8*)(Qs + (mt * 16 + fr) * 264 + kk * 32 + fq * 8);
#pragma unroll
            for (int n = 0; n < 2; ++n) acc[n] = mfma16(*(const bf16x8*)(Ks + ((g * 2 + n) * 16 + fr) * 264 + kk * 32 + fq * 8), aQ, acc[n]); }
        const int t = mt * 16 + fr; const float mlt = __shfl(ml, t);
#pragma unroll
        for (int n = 0; n < 2; ++n) { float pv[4];
#pragma unroll
            for (int j = 0; j < 4; ++j) { const int s = (g * 2 + n) * 16 + fq * 4 + j; const float as_ = __shfl(av, s);
                pv[j] = (s <= t) ? acc[n][j] * __expf(as_ - mlt) : 0.f; }
            uint2 pp; pp.x = pack2(pv[0], pv[1]); pp.y = pack2(pv[2], pv[3]);
            *(uint2*)(MP + t * 64 + (g * 2 + n) * 16 + fq * 4) = pp; }
    }
    __syncthreads();
}

struct MlLd { bf16x8 fP[2]; bf16x8 fV[4][2]; bf16x8 fK[2][2]; bf16x8 fQ[8]; float bt, ml; };
DEVI void ml_loadQ(MlLd& L, const Params& p, int unit, int mt, int fr, int fq) {
    const u16* MQ = (const u16*)(p.ws + WS_MQ) + (size_t)unit * 16384;
#pragma unroll
    for (int kk = 0; kk < 8; ++kk) L.fQ[kk] = *(const bf16x8*)(MQ + (mt * 16 + fr) * 256 + kk * 32 + fq * 8);
}
DEVI void ml_loadP(MlLd& L, const Params& p, int unit, int mt, int fr, int fq) {
    const u16* MP = (const u16*)(p.ws + WS_MP) + (size_t)unit * 4096;
#pragma unroll
    for (int k2 = 0; k2 < 2; ++k2) L.fP[k2] = *(const bf16x8*)(MP + (mt * 16 + fr) * 64 + k2 * 32 + fq * 8);
}
DEVI void ml_loadVK(MlLd& L, const Params& p, int unit, int eb, int w, int fr, int fq) {
    const u16* MKT = (const u16*)(p.ws + WS_MKT) + (size_t)unit * 16384; const u16* MVT = (const u16*)(p.ws + WS_MVT) + (size_t)unit * 16384;
#pragma unroll
    for (int k2 = 0; k2 < 2; ++k2) {
#pragma unroll
        for (int m = 0; m < 4; ++m) L.fV[m][k2] = *(const bf16x8*)(MVT + (eb * 64 + m * 16 + fr) * 64 + k2 * 32 + fq * 8);
#pragma unroll
        for (int n = 0; n < 2; ++n) L.fK[n][k2] = *(const bf16x8*)(MKT + (w * 32 + n * 16 + fr) * 64 + k2 * 32 + fq * 8); }
}
DEVI void ml_loadS(MlLd& L, const Params& p, int unit, int lane) {
    const float* MSC = (const float*)(p.ws + WS_MSC) + (size_t)unit * 128; L.bt = MSC[lane]; L.ml = MSC[64 + lane];
}
DEVI void mlstm_load(MlLd& L, const Params& p, int unit, int eb, int lane, int w, int mt, int fr, int fq) {
    ml_loadQ(L, p, unit, mt, fr, fq); ml_loadP(L, p, unit, mt, fr, fq); ml_loadVK(L, p, unit, eb, w, fr, fq); ml_loadS(L, p, unit, lane);
}
DEVI void mlstm_seq(const Params& p, int role, char* smem) {
    const int tid = threadIdx.x, lane0 = tid & 63, w0 = tid >> 6;
    const int b = role >> 4, h = (role >> 2) & 3, eb = role & 3;
    u16* Cts = (u16*)smem;
    for (int i = tid; i < 2 * 80 * 264 / 2; i += NTHR) ((unsigned*)Cts)[i] = 0u;
    u16* hbuf = (u16*)(p.ws + WS_HBUF);
    f32x4 accC[5][2];
#pragma unroll
    for (int m = 0; m < 5; ++m) { accC[m][0] = (f32x4){0.f, 0.f, 0.f, 0.f}; accC[m][1] = (f32x4){0.f, 0.f, 0.f, 0.f}; }
    float mcar = 0.f;
    const int ubase = (b * 4 + h) * 32;
    MlLd L;
    mlstm_load(L, p, ubase, eb, lane0, w0, w0 & 3, lane0 & 15, lane0 >> 4);
    __syncthreads();
    for (int c = 0; c < 32; ++c) {
        int lane = lane0, w = w0; asm volatile("" : "+v"(lane), "+v"(w));
        const int fr = lane & 15, fq = lane >> 4, mt = w & 3, g = w >> 2;
        const size_t row0 = (size_t)b * 2048 + c * 64;
        const u16* Cc = Cts + (c & 1) * 80 * 264; u16* Cn = Cts + ((c & 1) ^ 1) * 80 * 264;
        const float bt = L.bt, ml = L.ml;
        const float mr = fmaxf(ml, mcar);
        const float bL = __shfl(bt, 63), mrL = __shfl(mr, 63), mlL = __shfl(ml, 63);
        const float mnew = bL + mrL, decay = __expf(bL + mcar - mnew), rho = __expf(mlL - mrL);
        const float iw = __expf(mcar - mr), rt = __expf(ml - mr), flo = __expf(-(bt + mr));
        bf16x8 one8;
#pragma unroll
        for (int i = 0; i < 8; ++i) one8[i] = (fr == 0) ? (short)0x3F80 : (short)0;
        const bool more = (c + 1 < 32); const int nu = ubase + c + 1;
        if (more) ml_loadS(L, p, nu, lane);
        f32x4 accH1[3]; accH1[0] = accH1[1] = accH1[2] = (f32x4){0.f, 0.f, 0.f, 0.f};
#pragma unroll
        for (int kk = 0; kk < 8; ++kk) { const bf16x8 q = L.fQ[kk];
#pragma unroll
            for (int n = 0; n < 3; ++n) { const int et = n < 2 ? g * 2 + n : 4;
                accH1[n] = mfma16(q, *(const bf16x8*)(Cc + (et * 16 + fr) * 264 + kk * 32 + fq * 8), accH1[n]); } }
        __builtin_amdgcn_sched_barrier(0);
        if (more) ml_loadQ(L, p, nu, mt, fr, fq);
        __builtin_amdgcn_sched_barrier(0);
        f32x4 accH2[3]; accH2[0] = accH2[1] = accH2[2] = (f32x4){0.f, 0.f, 0.f, 0.f};
#pragma unroll
        for (int k2 = 0; k2 < 2; ++k2) {
#pragma unroll
            for (int n = 0; n < 2; ++n) { bf16x8 bv;
#pragma unroll
                for (int i = 0; i < 8; ++i) bv[i] = g ? L.fV[2 + n][k2][i] : L.fV[n][k2][i];
                accH2[n] = mfma16(L.fP[k2], bv, accH2[n]); }
            accH2[2] = mfma16(L.fP[k2], one8, accH2[2]); }
        __builtin_amdgcn_sched_barrier(0);
        if (more) ml_loadP(L, p, nu, mt, fr, fq);
        __builtin_amdgcn_sched_barrier(0);
#pragma unroll
        for (int j = 0; j < 4; ++j) { const int t = mt * 16 + fq * 4 + j;
            const float iwt = __shfl(iw, t), rtt = __shfl(rt, t), fl = __shfl(flo, t);
            const float h0 = iwt * accH1[0][j] + rtt * accH2[0][j], h1 = iwt * accH1[1][j] + rtt * accH2[1][j], hd = iwt * accH1[2][j] + rtt * accH2[2][j];
            const float den = __shfl(hd, fq * 16); const float dn = fmaxf(fabsf(den), fl);
            hbuf[(row0 + t) * DM + h * 256 + eb * 64 + (g * 2) * 16 + fr] = f2bf(h0 / dn);
            hbuf[(row0 + t) * DM + h * 256 + eb * 64 + (g * 2 + 1) * 16 + fr] = f2bf(h1 / dn); }
        __builtin_amdgcn_sched_barrier(0);
        {
            f32x4 tmp[5][2];
#pragma unroll
            for (int m = 0; m < 5; ++m) { tmp[m][0] = (f32x4){0.f, 0.f, 0.f, 0.f}; tmp[m][1] = (f32x4){0.f, 0.f, 0.f, 0.f}; }
#pragma unroll
            for (int k2 = 0; k2 < 2; ++k2)
#pragma unroll
                for (int m = 0; m < 5; ++m)
#pragma unroll
                    for (int n = 0; n < 2; ++n) tmp[m][n] = mfma16(m < 4 ? L.fV[m < 4 ? m : 0][k2] : one8, L.fK[n][k2], tmp[m][n]);
            __builtin_amdgcn_sched_barrier(0);
            if (more) ml_loadVK(L, p, nu, eb, w, fr, fq);
            __builtin_amdgcn_sched_barrier(0);
#pragma unroll
            for (int m = 0; m < 5; ++m)
#pragma unroll
                for (int n = 0; n < 2; ++n) { accC[m][n] = decay * accC[m][n] + rho * tmp[m][n];
#pragma unroll
                    for (int j = 0; j < 4; ++j) Cn[(m * 16 + fq * 4 + j) * 264 + w * 32 + n * 16 + fr] = f2bf(accC[m][n][j]); }
        }
        __builtin_amdgcn_sched_barrier(0);
        mcar = mnew;
        __syncthreads();
    }
    const int lane = lane0, w = w0, fr = lane & 15, fq = lane >> 4;
    float* pC = p.out + O_PC + (size_t)(b * 4 + h) * 65536;
#pragma unroll
    for (int m = 0; m < 4; ++m)
#pragma unroll
        for (int n = 0; n < 2; ++n) *(f32x4*)(pC + (size_t)(w * 32 + n * 16 + fr) * 256 + eb * 64 + m * 16 + fq * 4) = accC[m][n];
    if (eb == 0 && fq == 0) { p.out[O_PN + (b * 4 + h) * 256 + w * 32 + fr] = accC[4][0][0]; p.out[O_PN + (b * 4 + h) * 256 + w * 32 + 16 + fr] = accC[4][1][0]; }
    if (eb == 0 && tid == 0) p.out[O_PM + b * 4 + h] = mcar;
    __syncthreads();
}

DEVI void gdn_pre(const Params& p, int unit, char* smem) {
    int tid = threadIdx.x; asm volatile("" : "+v"(tid));
    const int lane = tid & 63, w = tid >> 6, fr = lane & 15, fq = lane >> 4;
    const int b = unit >> 8, h = (unit >> 5) & 7, c = unit & 31;
    u16* Ks = (u16*)smem;
    u16* Qs = Ks + 64 * 136;
    u16* KbT = Qs + 64 * 136;
    u16* VbT = KbT + 128 * 72;
    u16* KwT = VbT + 128 * 72;
    u16* Mb = KwT + 128 * 72;
    u16* Mtb = Mb + 2 * 64 * 72;
    u16* Ts = Mtb + 2 * 64 * 72;
    u16* Ps = Ts + 64 * 72;
    const float* proj = (const float*)(p.ws + WS_PROJ); const float* gates = (const float*)(p.ws + WS_GATES);
    u16* GQ = (u16*)(p.ws + WS_GQ) + (size_t)unit * 8192; u16* GW = (u16*)(p.ws + WS_GW) + (size_t)unit * 8192;
    u16* GP = (u16*)(p.ws + WS_GP) + (size_t)unit * 4096; u16* GU0 = (u16*)(p.ws + WS_GU0) + (size_t)unit * 8192;
    u16* GKW = (u16*)(p.ws + WS_GKW) + (size_t)unit * 8192; float* GSC = (float*)(p.ws + WS_GSC) + (size_t)unit * 80;
    const float dtb = p.g_dt_bias[h], Aexp = __expf(p.g_A_log[h]);
    const int mt = w & 3, g = w >> 2;
    const int chq = h * 128 + 2 * lane, chk = 1024 + chq, chv = 2048 + chq;
    const long row0 = (long)b * 2048 + c * 64;
    const float ga = gates[(row0 + lane) * 24 + 16 + h] + dtb;
    const float la = -Aexp * softplusf_(ga);
    const float beta = sigmoidf_(gates[(row0 + lane) * 24 + 8 + h]);
    const float bc = scan_add(la, lane);
    const float bL = __shfl(bc, 63);
    const float eb_ = __expf(bc);
    if (w == 0) { GSC[lane] = eb_; if (lane == 0) GSC[64] = __expf(bL); }
    {
        float2 cq[4], ck[4], cv[4];
#pragma unroll
        for (int j = 0; j < 4; ++j) { cq[j] = *(const float2*)(p.conv_w + j * 3072 + chq); ck[j] = *(const float2*)(p.conv_w + j * 3072 + chk); cv[j] = *(const float2*)(p.conv_w + j * 3072 + chv); }
        float2 rq[11], rk[11], rv[11];
#pragma unroll
        for (int j = 0; j < 11; ++j) { const long tg = (long)c * 64 + w * 8 - 3 + j;
            if (tg >= 0) { const float* pr = proj + ((long)b * 2048 + tg) * PLD + 4096;
                rq[j] = *(const float2*)(pr + chq); rk[j] = *(const float2*)(pr + chk); rv[j] = *(const float2*)(pr + chv); }
            else { rq[j] = make_float2(0.f, 0.f); rk[j] = make_float2(0.f, 0.f); rv[j] = make_float2(0.f, 0.f); } }
        unsigned kb0[4], kb1[4], kw0[4], kw1[4], vb0[4], vb1[4];
#pragma unroll
        for (int i = 0; i < 8; ++i) { const int s = w * 8 + i;
            float yq0 = cq[0].x * rq[i].x + cq[1].x * rq[i + 1].x + cq[2].x * rq[i + 2].x + cq[3].x * rq[i + 3].x;
            float yq1 = cq[0].y * rq[i].y + cq[1].y * rq[i + 1].y + cq[2].y * rq[i + 2].y + cq[3].y * rq[i + 3].y;
            float yk0 = ck[0].x * rk[i].x + ck[1].x * rk[i + 1].x + ck[2].x * rk[i + 2].x + ck[3].x * rk[i + 3].x;
            float yk1 = ck[0].y * rk[i].y + ck[1].y * rk[i + 1].y + ck[2].y * rk[i + 2].y + ck[3].y * rk[i + 3].y;
            float yv0 = cv[0].x * rv[i].x + cv[1].x * rv[i + 1].x + cv[2].x * rv[i + 2].x + cv[3].x * rv[i + 3].x;
            float yv1 = cv[0].y * rv[i].y + cv[1].y * rv[i + 1].y + cv[2].y * rv[i + 2].y + cv[3].y * rv[i + 3].y;
            yq0 = siluf_(yq0); yq1 = siluf_(yq1); yk0 = siluf_(yk0); yk1 = siluf_(yk1); yv0 = siluf_(yv0); yv1 = siluf_(yv1);
            const float rqn = rsqrtf(wsum(yq0 * yq0 + yq1 * yq1) + 1e-6f) * 0.08838834764831845f;
            const float rkn = rsqrtf(wsum(yk0 * yk0 + yk1 * yk1) + 1e-6f);
            yq0 *= rqn; yq1 *= rqn; yk0 *= rkn; yk1 *= rkn;
            *(unsigned*)(Qs + s * 136 + 2 * lane) = pack2(yq0, yq1);
            *(unsigned*)(Ks + s * 136 + 2 * lane) = pack2(yk0, yk1);
            const float bs_ = __shfl(bc, s), bets = __shfl(beta, s);
            const float f1 = bets * __expf(bs_), f2 = __expf(bL - bs_);
            const unsigned a0 = f2bf(yk0 * f1), a1 = f2bf(yk1 * f1), w0_ = f2bf(yk0 * f2), w1_ = f2bf(yk1 * f2), v0_ = f2bf(yv0 * bets), v1_ = f2bf(yv1 * bets);
            if (i & 1) { kb0[i >> 1] |= a0 << 16; kb1[i >> 1] |= a1 << 16; kw0[i >> 1] |= w0_ << 16; kw1[i >> 1] |= w1_ << 16; vb0[i >> 1] |= v0_ << 16; vb1[i >> 1] |= v1_ << 16; }
            else { kb0[i >> 1] = a0; kb1[i >> 1] = a1; kw0[i >> 1] = w0_; kw1[i >> 1] = w1_; vb0[i >> 1] = v0_; vb1[i >> 1] = v1_; } }
        *(uint4*)(KbT + (2 * lane) * 72 + w * 8) = make_uint4(kb0[0], kb0[1], kb0[2], kb0[3]);
        *(uint4*)(KbT + (2 * lane + 1) * 72 + w * 8) = make_uint4(kb1[0], kb1[1], kb1[2], kb1[3]);
        *(uint4*)(KwT + (2 * lane) * 72 + w * 8) = make_uint4(kw0[0], kw0[1], kw0[2], kw0[3]);
        *(uint4*)(KwT + (2 * lane + 1) * 72 + w * 8) = make_uint4(kw1[0], kw1[1], kw1[2], kw1[3]);
        *(uint4*)(VbT + (2 * lane) * 72 + w * 8) = make_uint4(vb0[0], vb0[1], vb0[2], vb0[3]);
        *(uint4*)(VbT + (2 * lane + 1) * 72 + w * 8) = make_uint4(vb1[0], vb1[1], vb1[2], vb1[3]);
    }
    __syncthreads();
    {
        f32x4 aKK[2], aQK[2];
#pragma unroll
        for (int n = 0; n < 2; ++n) aKK[n] = aQK[n] = (f32x4){0.f, 0.f, 0.f, 0.f};
#pragma unroll
        for (int k = 0; k < 128; k += 32) {
            const bf16x8 fK = *(const bf16x8*)(Ks + (mt * 16 + fr) * 136 + k + fq * 8), fQ = *(const bf16x8*)(Qs + (mt * 16 + fr) * 136 + k + fq * 8);
#pragma unroll
            for (int n = 0; n < 2; ++n) { const bf16x8 bK = *(const bf16x8*)(Ks + ((g * 2 + n) * 16 + fr) * 136 + k + fq * 8);
                aKK[n] = mfma16(fK, bK, aKK[n]); aQK[n] = mfma16(fQ, bK, aQK[n]); }
        }
#pragma unroll
        for (int n = 0; n < 2; ++n) { const int s = (g * 2 + n) * 16 + fr; const float bs_ = __shfl(bc, s);
#pragma unroll
            for (int j = 0; j < 4; ++j) { const int l = mt * 16 + fq * 4 + j; const float bl = __shfl(bc, l), betl = __shfl(beta, l);
                const float dec = __expf(fminf(bl - bs_, 0.f));
                const float nm = (s < l) ? -betl * aKK[n][j] * dec : 0.f; const u16 nmb = f2bf(nm);
                Mb[l * 72 + s] = nmb; Mtb[s * 72 + l] = nmb; Ts[l * 72 + s] = (l == s) ? (u16)0x3F80 : nmb;
                Ps[l * 72 + s] = f2bf((s <= l) ? aQK[n][j] * dec : 0.f); } }
    }
    __syncthreads();
    {
        f32x4 accT[4];
        if (w >= 4) {
#pragma unroll
            for (int n = 0; n < 4; ++n)
#pragma unroll
                for (int j = 0; j < 4; ++j) accT[n][j] = bf2f(Ts[((w - 4) * 16 + fq * 4 + j) * 72 + n * 16 + fr]);
        }
        for (int k = 1; k <= 6; ++k) {
            const int cur = (k - 1) & 1;
            const u16* Mc = Mb + cur * 64 * 72; const u16* Mtc = Mtb + cur * 64 * 72;
            if (w < 4) {
                if (k <= 5) {
                    f32x4 am[1][4];
#pragma unroll
                    for (int n = 0; n < 4; ++n) am[0][n] = (f32x4){0.f, 0.f, 0.f, 0.f};
                    mma_lds<1, 4>(am, Mc + (w * 16) * 72, 72, Mtc, 72, 64, fr, fq);
                    u16* Mn = Mb + (cur ^ 1) * 64 * 72; u16* Mtn = Mtb + (cur ^ 1) * 64 * 72;
#pragma unroll
                    for (int n = 0; n < 4; ++n)
#pragma unroll
                        for (int j = 0; j < 4; ++j) { const int l = w * 16 + fq * 4 + j, s = n * 16 + fr; const u16 v = f2bf(am[0][n][j]); Mn[l * 72 + s] = v; Mtn[s * 72 + l] = v; }
                }
            } else if (k >= 2) {
                f32x4 at[1][4];
#pragma unroll
                for (int n = 0; n < 4; ++n) at[0][n] = accT[n];
                mma_lds<1, 4>(at, Ts + ((w - 4) * 16) * 72, 72, Mtc, 72, 64, fr, fq);
#pragma unroll
                for (int n = 0; n < 4; ++n) { accT[n] = at[0][n];
#pragma unroll
                    for (int j = 0; j < 4; ++j) Ts[((w - 4) * 16 + fq * 4 + j) * 72 + n * 16 + fr] = f2bf(accT[n][j]); }
            }
            __syncthreads();
        }
    }
    {
        f32x4 aW[4], aU[4];
#pragma unroll
        for (int n = 0; n < 4; ++n) aW[n] = aU[n] = (f32x4){0.f, 0.f, 0.f, 0.f};
#pragma unroll
        for (int k2 = 0; k2 < 2; ++k2) { const bf16x8 aT = *(const bf16x8*)(Ts + (mt * 16 + fr) * 72 + k2 * 32 + fq * 8);
#pragma unroll
            for (int n = 0; n < 4; ++n) { const bf16x8 bK = *(const bf16x8*)(KbT + ((g * 4 + n) * 16 + fr) * 72 + k2 * 32 + fq * 8);
                const bf16x8 bV = *(const bf16x8*)(VbT + ((g * 4 + n) * 16 + fr) * 72 + k2 * 32 + fq * 8);
                aW[n] = mfma16(bK, aT, aW[n]);
                aU[n] = mfma16(aT, bV, aU[n]); } }
#pragma unroll
        for (int n = 0; n < 4; ++n) {
            uint2 pw; pw.x = pack2(aW[n][0], aW[n][1]); pw.y = pack2(aW[n][2], aW[n][3]);
            *(uint2*)(GW + (mt * 16 + fr) * 128 + (g * 4 + n) * 16 + fq * 4) = pw;
            uint2 pu; pu.x = pack2(aU[n][0], aU[n][1]); pu.y = pack2(aU[n][2], aU[n][3]);
            *(uint2*)(GU0 + ((g * 4 + n) * 16 + fr) * 64 + mt * 16 + fq * 4) = pu; }
#pragma unroll
        for (int i = 0; i < 2; ++i) { const int id = tid + i * NTHR;
            *(uint4*)(GQ + (id >> 4) * 128 + (id & 15) * 8) = *(const uint4*)(Qs + (id >> 4) * 136 + (id & 15) * 8);
            *(uint4*)(GKW + (id >> 3) * 64 + (id & 7) * 8) = *(const uint4*)(KwT + (id >> 3) * 72 + (id & 7) * 8); }
        *(uint4*)(GP + (tid >> 3) * 64 + (tid & 7) * 8) = *(const uint4*)(Ps + (tid >> 3) * 72 + (tid & 7) * 8);
    }
    __syncthreads();
}

struct GdnLd { bf16x8 fW[4], fQ[4], fP[2], fKw[2]; uint2 u0[2]; float ebl[4]; float ebL; };
DEVI void gdn_load(GdnLd& L, const Params& p, int unit, int eb, int w, int mt, int g, int fr, int fq) {
    const u16* GQ = (const u16*)(p.ws + WS_GQ) + (size_t)unit * 8192; const u16* GW = (const u16*)(p.ws + WS_GW) + (size_t)unit * 8192;
    const u16* GP = (const u16*)(p.ws + WS_GP) + (size_t)unit * 4096; const u16* GU0 = (const u16*)(p.ws + WS_GU0) + (size_t)unit * 8192;
    const u16* GKW = (const u16*)(p.ws + WS_GKW) + (size_t)unit * 8192; const float* GSC = (const float*)(p.ws + WS_GSC) + (size_t)unit * 80;
#pragma unroll
    for (int kk = 0; kk < 4; ++kk) { L.fW[kk] = *(const bf16x8*)(GW + (mt * 16 + fr) * 128 + kk * 32 + fq * 8); L.fQ[kk] = *(const bf16x8*)(GQ + (mt * 16 + fr) * 128 + kk * 32 + fq * 8); }
#pragma unroll
    for (int k2 = 0; k2 < 2; ++k2) { L.fP[k2] = *(const bf16x8*)(GP + (mt * 16 + fr) * 64 + k2 * 32 + fq * 8); L.fKw[k2] = *(const bf16x8*)(GKW + (w * 16 + fr) * 64 + k2 * 32 + fq * 8); }
#pragma unroll
    for (int n = 0; n < 2; ++n) L.u0[n] = *(const uint2*)(GU0 + (eb * 64 + (g * 2 + n) * 16 + fr) * 64 + mt * 16 + fq * 4);
    const f32x4 e4 = *(const f32x4*)(GSC + mt * 16 + fq * 4);
    L.ebl[0] = e4[0]; L.ebl[1] = e4[1]; L.ebl[2] = e4[2]; L.ebl[3] = e4[3]; L.ebL = GSC[64];
}
DEVI void gdn_seq(const Params& p, int role, char* smem) {
    const int tid = threadIdx.x, lane0 = tid & 63, w0 = tid >> 6;
    const int b = role >> 4, h = (role >> 1) & 7, eb = role & 1;
    u16* Sts = (u16*)smem;
    u16* Uts = Sts + 64 * 136;
    for (int i = tid; i < 64 * 136 / 2; i += NTHR) ((unsigned*)Sts)[i] = 0u;
    u16* hbuf = (u16*)(p.ws + WS_HBUF);
    f32x4 accSt[4];
#pragma unroll
    for (int m = 0; m < 4; ++m) accSt[m] = (f32x4){0.f, 0.f, 0.f, 0.f};
    const int ubase = (b * 8 + h) * 32;
    GdnLd L;
    gdn_load(L, p, ubase, eb, w0, w0 & 3, w0 >> 2, lane0 & 15, lane0 >> 4);
    __syncthreads();
    for (int c = 0; c < 32; ++c) {
        int lane = lane0, w = w0; asm volatile("" : "+v"(lane), "+v"(w));
        const int fr = lane & 15, fq = lane >> 4, mt = w & 3, g = w >> 2;
        const long row0 = (long)b * 2048 + c * 64;
        f32x4 aWS[2], accO[2];
        aWS[0] = aWS[1] = accO[0] = accO[1] = (f32x4){0.f, 0.f, 0.f, 0.f};
#pragma unroll
        for (int kk = 0; kk < 4; ++kk)
#pragma unroll
            for (int n = 0; n < 2; ++n) { const bf16x8 bS = *(const bf16x8*)(Sts + ((g * 2 + n) * 16 + fr) * 136 + kk * 32 + fq * 8);
                aWS[n] = mfma16(L.fW[kk], bS, aWS[n]); accO[n] = mfma16(L.fQ[kk], bS, accO[n]); }
#pragma unroll
        for (int n = 0; n < 2; ++n) {
            const float u0 = __uint_as_float(L.u0[n].x << 16), u1 = __uint_as_float(L.u0[n].x & 0xFFFF0000u);
            const float u2 = __uint_as_float(L.u0[n].y << 16), u3 = __uint_as_float(L.u0[n].y & 0xFFFF0000u);
            uint2 pu; pu.x = pack2(u0 - aWS[n][0], u1 - aWS[n][1]); pu.y = pack2(u2 - aWS[n][2], u3 - aWS[n][3]);
            *(uint2*)(Uts + ((g * 2 + n) * 16 + fr) * 72 + mt * 16 + fq * 4) = pu;
#pragma unroll
            for (int j = 0; j < 4; ++j) accO[n][j] *= L.ebl[j]; }
        const bf16x8 fP0 = L.fP[0], fP1 = L.fP[1], fK0 = L.fKw[0], fK1 = L.fKw[1]; const float ebL = L.ebL;
        __syncthreads();
        if (c + 1 < 32) gdn_load(L, p, ubase + c + 1, eb, w, mt, g, fr, fq);
#pragma unroll
        for (int n = 0; n < 2; ++n) {
            accO[n] = mfma16(fP0, *(const bf16x8*)(Uts + ((g * 2 + n) * 16 + fr) * 72 + fq * 8), accO[n]);
            accO[n] = mfma16(fP1, *(const bf16x8*)(Uts + ((g * 2 + n) * 16 + fr) * 72 + 32 + fq * 8), accO[n]); }
#pragma unroll
        for (int n = 0; n < 2; ++n)
#pragma unroll
            for (int j = 0; j < 4; ++j) hbuf[(row0 + mt * 16 + fq * 4 + j) * DM + 1024 + h * 128 + eb * 64 + (g * 2 + n) * 16 + fr] = f2bf(accO[n][j]);
#pragma unroll
        for (int m = 0; m < 4; ++m) { accSt[m] *= ebL;
            accSt[m] = mfma16(fK0, *(const bf16x8*)(Uts + (m * 16 + fr) * 72 + fq * 8), accSt[m]);
            accSt[m] = mfma16(fK1, *(const bf16x8*)(Uts + (m * 16 + fr) * 72 + 32 + fq * 8), accSt[m]);
            uint2 ps; ps.x = pack2(accSt[m][0], accSt[m][1]); ps.y = pack2(accSt[m][2], accSt[m][3]);
            *(uint2*)(Sts + (m * 16 + fr) * 136 + w * 16 + fq * 4) = ps; }
        __syncthreads();
    }
    const int lane = lane0, w = w0, fr = lane & 15, fq = lane >> 4;
    float* pS = p.out + O_PS + (size_t)(b * 8 + h) * 16384;
#pragma unroll
    for (int m = 0; m < 4; ++m)
#pragma unroll
        for (int j = 0; j < 4; ++j) pS[(size_t)(w * 16 + fq * 4 + j) * 128 + eb * 64 + m * 16 + fr] = accSt[m][j];
    __syncthreads();
}

DEVI void mlstm_sample(const Params& p, int item, char* smem) {
    int tid = threadIdx.x; asm volatile("" : "+v"(tid));
    const int lane = tid & 63, w = tid >> 6;
    const int bs = item >> 2, h = item & 3;
    float* qs = (float*)smem; float* ks = qs + 1024; float* vs = ks + 1024; float* red = vs + 1024; float* num = red + 8192; float* sc = num + 1024; float* sc2 = sc + 32;
    const float* proj = (const float*)(p.ws + WS_PROJ); const float* gates = (const float*)(p.ws + WS_GATES); u16* mix = (u16*)(p.ws + WS_MIX);
    const size_t row0 = NPT + (size_t)bs * 4;
    for (int i = tid; i < 3072; i += NTHR) { const int which = i >> 10, t = (i >> 8) & 3, d = i & 255;
        float v = proj[(row0 + t) * PLD + which * 1024 + h * 256 + d]; if (which == 1) v *= 0.0625f; qs[i] = v; }
    float m = p.st_m[bs * 4 + h]; float fw[4], iw[4], flo[4];
    const float ib = p.m_i_bias[h], fb = p.m_f_bias[h];
#pragma unroll
    for (int t = 0; t < 4; ++t) { const float iv = gates[(row0 + t) * 24 + h] + ib; const float lf = logsigf_(gates[(row0 + t) * 24 + 4 + h] + fb);
        const float mn = fmaxf(lf + m, iv); fw[t] = __expf(lf + m - mn); iw[t] = __expf(iv - mn); flo[t] = __expf(-mn); m = mn; }
    __syncthreads();
    float qn[4] = {0.f, 0.f, 0.f, 0.f};
    if (tid < 256) { float n = p.st_n[(bs * 4 + h) * 256 + tid];
#pragma unroll
        for (int t = 0; t < 4; ++t) { n = fw[t] * n + iw[t] * ks[t * 256 + tid]; qn[t] = qs[t * 256 + tid] * n; }
        p.out[O_SN + (bs * 4 + h) * 256 + tid] = n; }
#pragma unroll
    for (int t = 0; t < 4; ++t) { const float r = wsum(qn[t]); if (lane == 0) sc[w * 4 + t] = r; }
    const float* Cin = p.st_C + (size_t)(bs * 4 + h) * 65536; float* Cout = p.out + O_SC + (size_t)(bs * 4 + h) * 65536;
    f32x4 pn[4];
#pragma unroll
    for (int t = 0; t < 4; ++t) pn[t] = (f32x4){0.f, 0.f, 0.f, 0.f};
#pragma unroll 1
    for (int hf = 0; hf < 2; ++hf) {
        const int d0 = w * 32 + hf * 16;
        f32x4 Cr[16];
#pragma unroll
        for (int i = 0; i < 16; ++i) Cr[i] = *(const f32x4*)(Cin + (size_t)(d0 + i) * 256 + lane * 4);
#pragma unroll
        for (int t = 0; t < 4; ++t) { const f32x4 vt = *(const f32x4*)(vs + t * 256 + lane * 4) * iw[t]; f32x4 a = pn[t];
#pragma unroll
            for (int i = 0; i < 16; ++i) { Cr[i] = fw[t] * Cr[i] + ks[t * 256 + d0 + i] * vt; a += qs[t * 256 + d0 + i] * Cr[i]; }
            pn[t] = a; }
#pragma unroll
        for (int i = 0; i < 16; ++i) *(f32x4*)(Cout + (size_t)(d0 + i) * 256 + lane * 4) = Cr[i];
    }
#pragma unroll
    for (int t = 0; t < 4; ++t) *(f32x4*)(red + (t * 8 + w) * 256 + lane * 4) = pn[t];
    __syncthreads();
    for (int o = tid; o < 1024; o += NTHR) { const int t = o >> 8, e = o & 255; float sacc = 0.f;
#pragma unroll
        for (int g = 0; g < 8; ++g) sacc += red[(t * 8 + g) * 256 + e];
        num[t * 256 + e] = sacc; }
    __syncthreads();
    float hv[4];
    if (tid < 256) {
#pragma unroll
        for (int t = 0; t < 4; ++t) { float den = 0.f;
#pragma unroll
            for (int g = 0; g < 8; ++g) den += sc[g * 4 + t];
            hv[t] = num[t * 256 + tid] / fmaxf(fabsf(den), flo[t]);
            const float r = wsum(hv[t] * hv[t]); if (lane == 0) sc2[w * 4 + t] = r; }
    }
    __syncthreads();
    if (tid < 256) {
#pragma unroll
        for (int t = 0; t < 4; ++t) { const float ss = sc2[t] + sc2[4 + t] + sc2[8 + t] + sc2[12 + t]; const float rs = rsqrtf(ss * (1.f / 256.f) + 1e-6f);
            const float mo = proj[(row0 + t) * PLD + 3072 + h * 256 + tid];
            mix[(row0 + t) * DM + h * 256 + tid] = f2bf(hv[t] * rs * p.m_norm_g[h * 256 + tid] * sigmoidf_(mo)); }
    }
    if (tid == 0) p.out[O_SM + bs * 4 + h] = m;
    __syncthreads();
}

DEVI void gdn_sample(const Params& p, int item, char* smem) {
    int tid = threadIdx.x; asm volatile("" : "+v"(tid));
    const int lane = tid & 63, w = tid >> 6;
    const int bs = item >> 3, h = item & 7;
    float* qkv = (float*)smem;
    float* red = qkv + 1536;
    float* ored = red + 1024;
    float* sc = ored + 2048;
    const float* proj = (const float*)(p.ws + WS_PROJ); const float* gates = (const float*)(p.ws + WS_GATES); u16* mix = (u16*)(p.ws + WS_MIX);
    const size_t row0 = NPT + (size_t)bs * 4;
    if (tid < 384) { const int which = tid >> 7, dch = tid & 127, ch = which * 1024 + h * 128 + dch;
        float xp[7];
#pragma unroll
        for (int j = 0; j < 3; ++j) xp[j] = p.st_conv[(size_t)(bs * 3 + j) * 3072 + ch];
#pragma unroll
        for (int t = 0; t < 4; ++t) xp[3 + t] = proj[(row0 + t) * PLD + 4096 + ch];
        float cw[4];
#pragma unroll
        for (int j = 0; j < 4; ++j) cw[j] = p.conv_w[j * 3072 + ch];
#pragma unroll
        for (int t = 0; t < 4; ++t) qkv[(which * 4 + t) * 128 + dch] = siluf_(cw[0] * xp[t] + cw[1] * xp[t + 1] + cw[2] * xp[t + 2] + cw[3] * xp[t + 3]); }
    float at[4], be[4];
    { const float dtb = p.g_dt_bias[h], Aexp = __expf(p.g_A_log[h]);
#pragma unroll
        for (int t = 0; t < 4; ++t) { at[t] = __expf(-Aexp * softplusf_(gates[(row0 + t) * 24 + 16 + h] + dtb)); be[t] = sigmoidf_(gates[(row0 + t) * 24 + 8 + h]); } }
    __syncthreads();
    { const int which = w >> 2, t = w & 3; float* a = qkv + (which * 4 + t) * 128; const float v0 = a[lane * 2], v1 = a[lane * 2 + 1];
        const float sc_ = rsqrtf(wsum(v0 * v0 + v1 * v1) + 1e-6f) * (which == 0 ? 0.08838834764831845f : 1.f);
        a[lane * 2] = v0 * sc_; a[lane * 2 + 1] = v1 * sc_; }
    __syncthreads();
    const float* qf = qkv; const float* kf = qkv + 512; const float* vf = qkv + 1024;
    const int e = tid & 127, dg = tid >> 7;
    const float* Sin = p.st_S + (size_t)(bs * 8 + h) * 16384; float* Sout = p.out + O_SS + (size_t)(bs * 8 + h) * 16384;
    float Sr[32];
#pragma unroll
    for (int i = 0; i < 32; ++i) Sr[i] = Sin[(dg * 32 + i) * 128 + e];
#pragma unroll
    for (int t = 0; t < 4; ++t) {
        float r = 0.f;
#pragma unroll
        for (int i = 0; i < 32; ++i) r += kf[t * 128 + dg * 32 + i] * Sr[i];
        red[((t & 1) * 4 + dg) * 128 + e] = r;
        __syncthreads();
        const float rr = red[((t & 1) * 4 + 0) * 128 + e] + red[((t & 1) * 4 + 1) * 128 + e] + red[((t & 1) * 4 + 2) * 128 + e] + red[((t & 1) * 4 + 3) * 128 + e];
        const float u = be[t] * (vf[t * 128 + e] - at[t] * rr);
        float po = 0.f;
#pragma unroll
        for (int i = 0; i < 32; ++i) { Sr[i] = at[t] * Sr[i] + kf[t * 128 + dg * 32 + i] * u; po += qf[t * 128 + dg * 32 + i] * Sr[i]; }
        ored[(t * 4 + dg) * 128 + e] = po;
    }
#pragma unroll
    for (int i = 0; i < 32; ++i) Sout[(dg * 32 + i) * 128 + e] = Sr[i];
    __syncthreads();
    float ov[4];
    if (tid < 128) {
#pragma unroll
        for (int t = 0; t < 4; ++t) { ov[t] = ored[(t * 4 + 0) * 128 + tid] + ored[(t * 4 + 1) * 128 + tid] + ored[(t * 4 + 2) * 128 + tid] + ored[(t * 4 + 3) * 128 + tid];
            const float r = wsum(ov[t] * ov[t]); if (lane == 0) sc[w * 4 + t] = r; }
    }
    __syncthreads();
    if (tid < 128) {
#pragma unroll
        for (int t = 0; t < 4; ++t) { const float rs = rsqrtf((sc[t] + sc[4 + t]) * (1.f / 128.f) + 1e-6f);
            const float gz = proj[(row0 + t) * PLD + 7168 + h * 128 + tid];
            mix[(row0 + t) * DM + 1024 + h * 128 + tid] = f2bf(ov[t] * rs * p.g_norm_g[h * 128 + tid] * siluf_(gz)); }
    }
    __syncthreads();
}

#ifndef SCM
#define SCM 15
#endif
DEVI void phase_scan(const Params& p, char* smem) {
    const int G = gridDim.x, bid = blockIdx.x;
    if (G >= 192) {
        if (bid < 64) { if (SCM & 1) mlstm_seq(p, bid, smem); }
        else if (bid < 128) { if (SCM & 2) gdn_seq(p, bid - 64, smem); }
        unsigned* q = (unsigned*)(p.ws + WS_BAR) + 64;
        volatile unsigned* lq = (volatile unsigned*)(smem + LDS_BYTES - 32);
        for (;;) {
            __syncthreads();
            if (threadIdx.x == 0) *lq = __hip_atomic_fetch_add(q, 1u, __ATOMIC_RELAXED, __HIP_MEMORY_SCOPE_AGENT);
            __syncthreads();
            const unsigned u = *lq;
            if (u >= 1536u) break;
            if (u < 512u) mlstm_sample(p, (int)u, smem); else gdn_sample(p, (int)u - 512, smem);
        }
        pop_late(p, smem, 1 << 30);
        if (p.ph_hi - p.ph_lo == 1) pop_late(p, smem, 1 << 30, 1);
    } else {
        for (int u = bid; u < 128 + 512 + 1024; u += G) {
            if (u < 64) { if (SCM & 1) mlstm_seq(p, u, smem); } else if (u < 128) { if (SCM & 2) gdn_seq(p, u - 64, smem); }
            else if (u < 640) { if (SCM & 4) mlstm_sample(p, u - 128, smem); } else { if (SCM & 8) gdn_sample(p, u - 640, smem); } }
        pop_late(p, smem, 1 << 30);
    }
}

#define XB_TMO      128
#define XB_XCNT(j)  (256  + 64 * (j))
#define XB_XSUB(j)  (1280 + 64 * (j))
#define XB_XGEN(j)  (2304 + 64 * (j))
#define XB_TOP      3328
#define XB_TOPGEN   3392
#define XCD_BAR_WORDS 3456
#define XB_SPIN_CAP (1u << 18)
#define LAS __attribute__((address_space(3)))

__device__ __forceinline__ unsigned xb_ld(unsigned* p)              { return __hip_atomic_load(p, __ATOMIC_RELAXED, __HIP_MEMORY_SCOPE_AGENT); }
__device__ __forceinline__ unsigned xb_add(unsigned* p, unsigned v) { return __hip_atomic_fetch_add(p, v, __ATOMIC_RELAXED, __HIP_MEMORY_SCOPE_AGENT); }
__device__ __forceinline__ unsigned xb_xcc_id() { return (unsigned)__builtin_amdgcn_s_getreg((3 << 11) | 20) & 0xFu; }
#define XB_SPIN(cond, bar) do { unsigned _sp = 0; while (cond) { __builtin_amdgcn_s_sleep(1); \
    if ((++_sp & 255u) == 0u) { if (xb_ld(&(bar)[XB_TMO])) break; if (_sp > XB_SPIN_CAP) { atomicAdd(&(bar)[XB_TMO], 1u); break; } } } } while (0)

struct XcdBarrier {
    unsigned* bar; unsigned x;
    volatile LAS unsigned* st;
};

__device__ __forceinline__ XcdBarrier xcd_barrier_post(unsigned* bar, volatile LAS unsigned* st) {
    XcdBarrier b; b.bar = bar; b.x = xb_xcc_id(); b.st = st;
    if (threadIdx.x == 0) (void)xb_add(&bar[XB_XCNT(b.x)], 1u);
    return b;
}
__device__ __forceinline__ void xcd_barrier_complete(unsigned* bar, unsigned x, unsigned& nloc, unsigned& nx) {
    const unsigned G = gridDim.x * gridDim.y * gridDim.z;
    unsigned sum, cnt, mine, sp = 0u;
    for (;;) {
        sum = 0u; cnt = 0u; mine = 0u;
#pragma unroll
        for (unsigned j = 0; j < 16; ++j) { const unsigned c = xb_ld(&bar[XB_XCNT(j)]); sum += c; cnt += (c > 0u) ? 1u : 0u; mine = (j == x) ? c : mine; }
        if (sum == G) break;
        __builtin_amdgcn_s_sleep(1);
        if ((++sp & 255u) == 0u) { if (xb_ld(&bar[XB_TMO])) break; if (sp > XB_SPIN_CAP) { atomicAdd(&bar[XB_TMO], 1u); break; } }
    }
    nloc = mine > 0u ? mine : 1u; nx = cnt > 0u ? cnt : 1u;
}

__device__ __forceinline__ void xcd_barrier(const XcdBarrier& b) {
    asm volatile("s_waitcnt vmcnt(0)" ::: "memory");
    __syncthreads();
    if (threadIdx.x == 0) {
        unsigned* bar = b.bar;
        __builtin_amdgcn_s_waitcnt(0);
        unsigned nloc = b.st[0], nx = b.st[1];
        if (nloc == 0u) { xcd_barrier_complete(bar, b.x, nloc, nx); b.st[0] = nloc; b.st[1] = nx; }
        const unsigned old = xb_add(&bar[XB_XSUB(b.x)], 1u);
        const unsigned gen = old / nloc;
        if (old + 1u == (gen + 1u) * nloc) {
            __builtin_amdgcn_fence(__ATOMIC_RELEASE, "agent");
            asm volatile("s_waitcnt vmcnt(0)" ::: "memory");
            const unsigned og = xb_add(&bar[XB_TOP], 1u);
            const unsigned tg = og / nx;
            if (og + 1u == (tg + 1u) * nx) xb_add(&bar[XB_TOPGEN], 1u);
            else XB_SPIN(xb_ld(&bar[XB_TOPGEN]) == tg, bar);
            __builtin_amdgcn_fence(__ATOMIC_ACQUIRE, "agent");
            xb_add(&bar[XB_XGEN(b.x)], 1u);
            asm volatile("s_waitcnt vmcnt(0)" ::: "memory");
        } else {
            XB_SPIN(xb_ld(&bar[XB_XGEN(b.x)]) == gen, bar);
            __builtin_amdgcn_fence(__ATOMIC_ACQUIRE, "agent");
            asm volatile("s_waitcnt vmcnt(0)" ::: "memory");
        }
    }
    __syncthreads();
}

__global__ void __launch_bounds__(NTHR) fwd_kernel(Params p) {
    extern __shared__ __attribute__((aligned(16))) char smem[];
    cg::grid_group grid = cg::this_grid();
    const int lo = p.ph_lo, hi = p.ph_hi;
    if (lo == 777) grid.sync();
    volatile LAS unsigned* xst = (volatile LAS unsigned*)(smem + LDS_BYTES - 16);
    if (threadIdx.x < 2) xst[threadIdx.x] = 0u;
    __syncthreads();
    XcdBarrier xbar; xbar.bar = (unsigned*)(p.ws + WS_BAR); xbar.x = 0; xbar.st = xst;
    if (hi - lo > 1) xbar = xcd_barrier_post((unsigned*)(p.ws + WS_BAR), xst);
#ifndef PHMASK
#define PHMASK 0xFFFF
#endif
#define PHASE(k) if (((PHMASK >> (k)) & 1) && lo <= (k) && (k) < hi)
#define SEAM(k) if (lo <= (k) && (k) + 1 < hi) xcd_barrier(xbar)
    PHASE(0) phase_prep(p, smem);
    SEAM(0);
    PHASE(2) phase_modulate(p);
    SEAM(2);
    PHASE(3) { PEpiProj e{(float*)(p.ws + WS_PROJ), (float*)(p.ws + WS_GATES)}; pg8_run((const u16*)(p.ws + WS_AH), (const u16*)(p.ws + WS_WIN), NTOK, 8448, DM, smem, e);
        if (hi - lo > 1 && 4 * (int)gridDim.x + (int)blockIdx.x >= 34 * 33) pop_late(p, smem, 9); }
    SEAM(3);
    PHASE(4) { for (int u = blockIdx.x; u < 1536; u += gridDim.x) { if (u < 512) mlstm_pre(p, u, smem); else gdn_pre(p, u - 512, smem); } }
    SEAM(4);
    PHASE(5) phase_scan(p, smem);
    SEAM(5);
    PHASE(6) phase_post(p);
    SEAM(6);
    PHASE(7) { PEpiRes e{p.x_prompt, p.x_sample, nullptr, (const float*)(p.ws + WS_ADA), 2 * DM, (float*)(p.ws + WS_X1), (float*)(p.ws + WS_PART), DM / 8};
        pg8_run_split((const u16*)(p.ws + WS_MIX), (const u16*)(p.ws + WS_WOUT), DM, DM, 8, smem, e);
        if (hi - lo > 1 && blockIdx.x >= 128) pop_late(p, smem, 2, 1); }
    SEAM(7);
    PHASE(8) phase_ln1(p);
    SEAM(8);
    PHASE(9) { PEpiGU e{(u16*)(p.ws + WS_ACT)}; pg8_run((const u16*)(p.ws + WS_AH), (const u16*)(p.ws + WS_WGU), NTOK, 2 * DFF, DM, smem, e);
        if (hi - lo > 1) { if (5 * (int)gridDim.x + (int)blockIdx.x >= 34 * 44) pop_late(p, smem, 9, 1); pop_late(p, smem, 1 << 30, 1); } }
    SEAM(9);
    PHASE(10) { PEpiRes e{p.x_prompt, p.x_sample, (const float*)(p.ws + WS_X1), (const float*)(p.ws + WS_ADA), 5 * DM, p.out + O_YP, (float*)(p.ws + WS_PART), DFF / 11};
        pg8_run_split((const u16*)(p.ws + WS_ACT), (const u16*)(p.ws + WS_WDOWN), DM, DFF, 11, smem, e); }
    SEAM(10);
    PHASE(11) phase_ln2(p);
}

extern "C" void kernel_launch(void* const* d_in, const int* in_sizes, int n_in, void* d_out, int out_size, void* d_ws, size_t ws_size,
                              hipStream_t stream) {
    static int grid = 0;
    if (grid == 0) {
        if (n_in != 26 || ws_size < WS_END) { fprintf(stderr, "kernel_launch: unexpected n_in %d / ws_size %zu\n", n_in, ws_size); grid = -1; return; }
        int dev = 0, cus = 0, per_cu = 0;
        hipGetDevice(&dev);
        hipDeviceGetAttribute(&cus, hipDeviceAttributeMultiprocessorCount, dev);
        hipFuncSetAttribute((const void*)fwd_kernel, hipFuncAttributeMaxDynamicSharedMemorySize, LDS_BYTES);
        hipOccupancyMaxActiveBlocksPerMultiprocessor(&per_cu, (const void*)fwd_kernel, NTHR, LDS_BYTES);
        if (per_cu < 1) { fprintf(stderr, "kernel_launch: occupancy query says %d blocks/CU\n", per_cu); grid = -1; return; }
        grid = cus * per_cu;
    }
    if (grid < 0) return;
    Params p{};
    const float** f = (const float**)&p;
    for (int i = 0; i < 26; ++i) f[i] = (const float*)d_in[i];
    p.out = (float*)d_out; p.ws = (unsigned char*)d_ws;
    hipMemsetAsync((char*)d_ws + WS_BAR, 0, XCD_BAR_WORDS * 4, stream);
#if FUSED
    p.ph_lo = 0; p.ph_hi = 12;
    void* args[] = {&p};
    hipError_t e = hipLaunchCooperativeKernel((const void*)fwd_kernel, dim3(grid), dim3(NTHR), args, LDS_BYTES, stream);
    if (e != hipSuccess) fprintf(stderr, "cooperative launch failed: %s (grid %d)\n", hipGetErrorString(e), grid);
#else
    for (int ph = 0; ph < 12; ++ph) { p.ph_lo = ph; p.ph_hi = ph + 1; hipLaunchKernelGGL(fwd_kernel, dim3(grid), dim3(NTHR), LDS_BYTES, stream, p); }
#endif
}
```

```cpp
#include <hip/hip_runtime.h>
#include <hip/hip_cooperative_groups.h>
#include <cstdio>
namespace cg = cooperative_groups;

#ifndef FUSED
#define FUSED 1
#endif

#define DEVI __device__ __forceinline__
typedef unsigned short u16;
typedef short bf16x8 __attribute__((ext_vector_type(8)));
typedef float f32x4 __attribute__((ext_vector_type(4)));

constexpr int NTHR = 512;
constexpr int DM = 2048, NTOK = 8704, NPT = 8192, INC = 8216, PLD = 8192, DFF = 5632, ADAW = 12288;
constexpr int LDS_BYTES = 158 * 1024;
constexpr float ALPHA = 1.189207115002721f;

constexpr size_t O_YP = 0, O_PC = 17825792, O_PN = 18874368, O_PM = 18878464, O_PS = 18878480, O_PCONV = 19402768,
                 O_SC = 19439632, O_SN = 52994064, O_SM = 53125136, O_SS = 53125648, O_SCONV = 69902864;
constexpr size_t WS_WOUT = 0, WS_WGU = 8388608, WS_WDOWN = 54525952, WS_ADA = 77594624, WS_AC = 84082688,
                 WS_WIN = 85131264, WS_WADA = 119734272, WS_HBUF = WS_WIN, WS_AH = 170065920, WS_MIX = 205717504,
                 WS_PROJ = 241369088, WS_X1 = 85131264  , WS_ACT = WS_PROJ + 71303168, WS_GATES = 527417344, WS_GQ = 152240128, WS_GW = 169017344, WS_GP = 185794560, WS_GSC = 194183168,
                 WS_GU0 = 528252928, WS_GKW = 545030144, WS_MKT = 561807360, WS_MVT = 578584576,
                 WS_PART = 528252928  , WS_MP = 194510848, WS_MSC = 198705152, WS_MQ = 118685696, WS_BAR = 595361792, WS_END = 595378176;

struct Params {
    const float* x_prompt; const float* x_sample; const float* st_C; const float* st_n; const float* st_m; const float* st_S;
    const float* st_conv; const float* c_prompt; const float* c_sample; const float* w_ada; const float* b_ada; const float* w_in;
    const float* m_i_bias; const float* m_f_bias; const float* m_norm_g; const float* conv_w; const float* g_dt_bias;
    const float* g_A_log; const float* g_norm_g; const float* w_out; const float* ln1_g; const float* ln1_b; const float* w_gu;
    const float* w_down; const float* ln2_g; const float* ln2_b;
    float* out; unsigned char* ws;
    int ph_lo, ph_hi;
};

typedef float f32x2_t __attribute__((ext_vector_type(2)));
typedef __bf16 bf16x2_t __attribute__((ext_vector_type(2)));
DEVI unsigned pack2(float a, float b) { const f32x2_t v = {a, b}; const bf16x2_t r = __builtin_convertvector(v, bf16x2_t); return __builtin_bit_cast(unsigned, r); }
DEVI u16 f2bf(float f) { const __bf16 r = (__bf16)f; return __builtin_bit_cast(u16, r); }
DEVI float bf2f(u16 b) { return __uint_as_float(((unsigned)b) << 16); }
DEVI float wsum(float v) { for (int o = 32; o; o >>= 1) v += __shfl_xor(v, o); return v; }
DEVI float sigmoidf_(float x) { return 1.f / (1.f + __expf(-x)); }
DEVI float siluf_(float x) { return x / (1.f + __expf(-x)); }
DEVI float softplusf_(float x) { return fmaxf(x, 0.f) + log1pf(__expf(-fabsf(x))); }
DEVI float logsigf_(float x) { return fminf(x, 0.f) - log1pf(__expf(-fabsf(x))); }
DEVI f32x4 mfma16(bf16x8 a, bf16x8 b, f32x4 c) { return __builtin_amdgcn_mfma_f32_16x16x32_bf16(a, b, c, 0, 0, 0); }
DEVI int tok_batch(int row) { return row < NPT ? (row >> 11) : 4 + ((row - NPT) >> 2); }
DEVI const float* x_row(const Params& p, int row) { return row < NPT ? p.x_prompt + (size_t)row * DM : p.x_sample + (size_t)(row - NPT) * DM; }

template <int MT, int NT>
DEVI void mma_lds(f32x4 (&acc)[MT][NT], const u16* A, int lda, const u16* B, int ldb, int K, int fr, int fq) {
    for (int k = 0; k < K; k += 32) {
        bf16x8 a[MT], b[NT];
#pragma unroll
        for (int m = 0; m < MT; ++m) a[m] = *(const bf16x8*)(A + (m * 16 + fr) * lda + k + fq * 8);
#pragma unroll
        for (int n = 0; n < NT; ++n) b[n] = *(const bf16x8*)(B + (n * 16 + fr) * ldb + k + fq * 8);
#pragma unroll
        for (int m = 0; m < MT; ++m)
#pragma unroll
            for (int n = 0; n < NT; ++n) acc[m][n] = mfma16(a[m], b[n], acc[m][n]);
    }
}

namespace pg8 {
#define PG8_LAS __attribute__((address_space(3)))
typedef unsigned short bf16_t;
typedef short bf16x8 __attribute__((ext_vector_type(8)));
typedef float f32x4 __attribute__((ext_vector_type(4)));
typedef unsigned u32x4 __attribute__((ext_vector_type(4)));
constexpr int BM = 256, BK = 64, HALF = 128, HTB = HALF * BK * 2  , STAGE_BYTES = 8 * HTB, NXCD = 8, WGM = 8;

__host__ __device__ __forceinline__ int lds_byte(int r, int c) { const int st = (r >> 4) * 2 + (c >> 5), rr = r & 15, cc = c & 31, ob = rr * 64 + cc * 2; return st * 1024 + (ob ^ (((ob >> 9) & 1) << 5)); }
__host__ __device__ __forceinline__ void stage_rc(int b, int& R, int& C) { const int st = b / 1024, sb = b % 1024, swz = sb ^ (((sb >> 9) & 1) << 5); R = (st >> 1) * 16 + swz / 64; C = (st & 1) * 32 + (swz % 64) / 2; }
__host__ __device__ __forceinline__ int perm32(int rho) { const int n = rho >> 4, i = rho & 15; return 8 * (i >> 2) + 4 * n + (i & 3); }

struct Unit { int pm, pn, k0, nt; };
struct Gemm { const bf16_t* A; const bf16_t* Bt; int M, N, K; };

struct StaticOrder {
    int nM, nN, nwg, G, c, Kt;
    __host__ __device__ void init(int M, int N, int G_, int c_, int K_ = 0) { nM = M / BM; nN = N / BM; nwg = nM * nN; G = G_; c = c_; Kt = K_ / BK; }
    __host__ __device__ bool next(int i, Unit& u) const {
        const long L = (long)i * G + c; if (L >= nwg) return false;
        int wgid = (int)L; { const int q = nwg / NXCD, r = nwg % NXCD, xcd = wgid % NXCD, off = wgid / NXCD; wgid = (xcd < r ? xcd * (q + 1) : r * (q + 1) + (xcd - r) * q) + off; }
        const int nig = WGM * nN, gid = wgid / nig, fm = gid * WGM, gsz = (nM - fm) < WGM ? (nM - fm) : WGM;
        u.pm = fm + ((wgid % nig) % gsz); u.pn = (wgid % nig) / gsz; u.k0 = 0; u.nt = Kt; return true;
    }
    __device__ __forceinline__ void a_ready(const Unit&) const {}
    __device__ __forceinline__ void done(const Unit&) const {}
};
__device__ __forceinline__ unsigned cvt_pk_bf16(float lo, float hi) { unsigned r; asm volatile("v_cvt_pk_bf16_f32 %0, %1, %2" : "=v"(r) : "v"(lo), "v"(hi)); return r; }
template <class Epi, class Sched, bool STAMP = false>
__device__ __forceinline__ void gemm_phase(PG8_LAS unsigned char* lds, const Gemm g, const Sched& S, const Epi& E, unsigned long long* stamps) {
    const int tid = threadIdx.x, wid = __builtin_amdgcn_readfirstlane(tid >> 6), lane = tid & 63, wr = wid >> 2, wc = wid & 3, fr = lane & 15, fq = lane >> 4;
    const int K = g.K;
    int ts_lo = 0, ts_hi = 0, nts = 0; const unsigned long long rt_entry = STAMP ? (unsigned long long)wall_clock64() : 0ull;
#define PG8_STAMP() do { if (STAMP && wid == 0 && nts < 64) { const unsigned long long _c = (unsigned long long)clock64(); \
        ts_lo = (lane == nts) ? (int)(unsigned)_c : ts_lo; ts_hi = (lane == nts) ? (int)(unsigned)(_c >> 32) : ts_hi; ++nts; } } while (0)
    PG8_STAMP();
    unsigned voffA[2], voffB[2];
#pragma unroll
    for (int i = 0; i < 2; ++i) { int R, C; stage_rc(tid * 16 + i * 8192, R, C); const int Rb = Epi::PERM ? ((R & ~31) + perm32(R & 31)) : R;
        voffA[i] = (unsigned)(R * K + C) * 2u; voffB[i] = (unsigned)(Rb * K + C) * 2u; }
    const size_t kstep = (size_t)(BK * 2);
    const size_t hstep = (size_t)HALF * K * 2;
    const size_t tstep = 2 * hstep;
    const unsigned ldsw = (unsigned)wid * 1024u;
    const int aoff = lds_byte(wr * 64 + fr, fq * 8), boff = lds_byte(wc * 32 + fr, fq * 8);
#define PG8_SA(b, h) (((b) * 2 + (h)) * HTB)
#define PG8_SB(b, h) ((4 + (b) * 2 + (h)) * HTB)
#define PG8_STAGE(bufoff, gbase, voff) do { _Pragma("unroll") for (int _i = 0; _i < 2; ++_i) \
        __builtin_amdgcn_global_load_lds((const unsigned*)((const char*)(gbase) + (voff)[_i]), (PG8_LAS unsigned*)(lds + (bufoff) + ldsw + _i * 8192), 16, 0, 0); } while (0)
#define PG8_LDA(dst, b, h) do { _Pragma("unroll") for (int m = 0; m < 4; ++m) _Pragma("unroll") for (int k = 0; k < 2; ++k) dst[m][k] = *(const PG8_LAS bf16x8*)(lds + PG8_SA(b, h) + aoff + m * 2048 + k * 1024); } while (0)
#define PG8_LDB(dst, b, h) do { _Pragma("unroll") for (int n = 0; n < 2; ++n) _Pragma("unroll") for (int k = 0; k < 2; ++k) dst[n][k] = *(const PG8_LAS bf16x8*)(lds + PG8_SB(b, h) + boff + n * 2048 + k * 1024); } while (0)
#define PG8_MMA(ai, bj, At, Bt) do { __builtin_amdgcn_s_setprio(1); _Pragma("unroll") for (int m = 0; m < 4; ++m) _Pragma("unroll") for (int n = 0; n < 2; ++n) _Pragma("unroll") for (int k = 0; k < 2; ++k) \
        acc[ai][bj][m][n] = __builtin_amdgcn_mfma_f32_16x16x32_bf16(Bt[n][k], At[m][k], acc[ai][bj][m][n], 0, 0, 0); __builtin_amdgcn_s_setprio(0); } while (0)
#define PG8_WAIT_V(n) asm volatile("s_waitcnt vmcnt(" #n ")" ::: "memory")
#define PG8_WAIT_L(n) asm volatile("s_waitcnt lgkmcnt(" #n ")" ::: "memory")
#define PG8_BAR __builtin_amdgcn_s_barrier()
#define PG8_SCHED __builtin_amdgcn_sched_barrier(0)
    Unit cur, nxt; int ui = 0;
    if (!S.next(0, cur)) return;
    f32x4 acc[2][2][4][2];
#pragma unroll
    for (int a = 0; a < 2; ++a)
#pragma unroll
        for (int b = 0; b < 2; ++b)
#pragma unroll
            for (int m = 0; m < 4; ++m)
#pragma unroll
                for (int n = 0; n < 2; ++n) acc[a][b][m][n] = (f32x4){0.f, 0.f, 0.f, 0.f};
    bf16x8 At[4][2], B0[2][2], B1[2][2];
    const char* cA = (const char*)g.A + (size_t)cur.pm * tstep + (size_t)cur.k0 * 2; const char* cB = (const char*)g.Bt + (size_t)cur.pn * tstep + (size_t)cur.k0 * 2;
    S.a_ready(cur);
    PG8_STAGE(PG8_SB(0, 0), cB, voffB); PG8_STAGE(PG8_SA(0, 0), cA, voffA); PG8_STAGE(PG8_SB(0, 1), cB + hstep, voffB); PG8_STAGE(PG8_SA(0, 1), cA + hstep, voffA);
    if (wr == 1) PG8_BAR;
    PG8_WAIT_V(4); PG8_BAR;
    PG8_STAGE(PG8_SB(1, 0), cB + kstep, voffB); PG8_STAGE(PG8_SA(1, 0), cA + kstep, voffA); PG8_STAGE(PG8_SB(1, 1), cB + hstep + kstep, voffB);
    PG8_WAIT_V(6); PG8_BAR;
    PG8_STAMP();
    for (;;) {
        const bool has_next = S.next(ui + 1, nxt);
        const char* nA = has_next ? (const char*)g.A + (size_t)nxt.pm * tstep + (size_t)nxt.k0 * 2 : cA; const char* nB = has_next ? (const char*)g.Bt + (size_t)nxt.pn * tstep + (size_t)nxt.k0 * 2 : cB;
        const int nt = cur.nt;
        for (int t = 0; t < nt; t += 2) {
            const bool last = (t == nt - 2);
            const char* a1 = cA + (size_t)(t + 1) * kstep;
            const char* a2 = last ? nA : cA + (size_t)(t + 2) * kstep; const char* b2 = last ? nB : cB + (size_t)(t + 2) * kstep;
            const char* a3 = a2 + kstep; const char* b3 = b2 + kstep;
            if (last && has_next) S.a_ready(nxt);
            PG8_LDB(B0, 0, 0); PG8_SCHED; PG8_LDA(At, 0, 0); PG8_STAGE(PG8_SA(1, 1), a1 + hstep, voffA);
            PG8_WAIT_L(8); PG8_BAR; PG8_WAIT_L(0); PG8_MMA(0, 0, At, B0); PG8_BAR; PG8_SCHED;
            PG8_LDB(B1, 0, 1); PG8_STAGE(PG8_SB(0, 0), b2, voffB);
            PG8_BAR; PG8_WAIT_L(0); PG8_MMA(0, 1, At, B1); PG8_BAR;
            PG8_LDA(At, 0, 1); PG8_STAGE(PG8_SA(0, 0), a2, voffA);
            PG8_BAR; PG8_WAIT_L(0); PG8_MMA(1, 0, At, B0); PG8_BAR; PG8_SCHED;
            PG8_STAGE(PG8_SB(0, 1), b2 + hstep, voffB);
            PG8_WAIT_V(6); PG8_BAR; PG8_MMA(1, 1, At, B1); PG8_BAR;
            PG8_LDB(B0, 1, 0); PG8_SCHED; PG8_LDA(At, 1, 0); PG8_STAGE(PG8_SA(0, 1), a2 + hstep, voffA);
            PG8_WAIT_L(8); PG8_BAR; PG8_WAIT_L(0); PG8_MMA(0, 0, At, B0); PG8_BAR; PG8_SCHED;
            PG8_LDB(B1, 1, 1); PG8_STAGE(PG8_SB(1, 0), b3, voffB);
            PG8_BAR; PG8_WAIT_L(0); PG8_MMA(0, 1, At, B1); PG8_BAR;
            PG8_LDA(At, 1, 1); PG8_STAGE(PG8_SA(1, 0), a3, voffA);
            PG8_BAR; PG8_WAIT_L(0); PG8_MMA(1, 0, At, B0); PG8_BAR; PG8_SCHED;
            PG8_STAGE(PG8_SB(1, 1), b3 + hstep, voffB);
            PG8_WAIT_V(6); PG8_BAR; PG8_MMA(1, 1, At, B1); PG8_BAR;
        }
        PG8_STAMP();
        if constexpr (!Epi::AFTER_DRAIN) { E(acc, cur, wr, wc, fr, fq); S.done(cur); }
        PG8_STAMP();
        if (!has_next) break;
#pragma unroll
        for (int a = 0; a < 2; ++a)
#pragma unroll
            for (int b = 0; b < 2; ++b)
#pragma unroll
                for (int m = 0; m < 4; ++m)
#pragma unroll
                    for (int n = 0; n < 2; ++n) acc[a][b][m][n] = (f32x4){0.f, 0.f, 0.f, 0.f};
        cur = nxt; cA = nA; cB = nB; ++ui;
    }
    PG8_WAIT_V(0);
    if (wr == 0) PG8_BAR;
    PG8_BAR;
    if constexpr (Epi::AFTER_DRAIN) { E.fused(acc, cur, wr, wc, fr, fq, lds, wid, lane); S.done(cur); }
    PG8_STAMP();
    if (STAMP && wid == 0) { stamps[lane] = lane < nts ? (((unsigned long long)(unsigned)ts_hi << 32) | (unsigned)ts_lo) : 0ull;
        if (lane == 62) stamps[62] = rt_entry; if (lane == 63) stamps[63] = (unsigned long long)wall_clock64(); }
#undef PG8_STAMP
#undef PG8_SA
#undef PG8_SB
#undef PG8_STAGE
#undef PG8_LDA
#undef PG8_LDB
#undef PG8_MMA
#undef PG8_WAIT_V
#undef PG8_WAIT_L
#undef PG8_BAR
#undef PG8_SCHED
}
}

DEVI void transpose_tile4(const float* src, int ldsrc, int nvalid, int k0, int c00, int c01, int c02, int c03, u16* dst, int ldd, u16* t) {
    int tid = threadIdx.x; asm volatile("" : "+v"(tid));
    const int kr = tid >> 4, n4 = (tid & 15) * 4;
    float4 v[4][2];
#pragma unroll
    for (int q = 0; q < 4; ++q) { const int c0 = q == 0 ? c00 : q == 1 ? c01 : q == 2 ? c02 : c03;
#pragma unroll
        for (int i = 0; i < 2; ++i) { v[q][i] = make_float4(0.f, 0.f, 0.f, 0.f);
            if (c0 + n4 < nvalid) { const f32x4 t4 = __builtin_nontemporal_load((const f32x4*)(src + (size_t)(k0 + kr + 32 * i) * ldsrc + c0 + n4)); v[q][i] = make_float4(t4[0], t4[1], t4[2], t4[3]); } } }
#pragma unroll
    for (int q = 0; q < 4; ++q)
#pragma unroll
        for (int i = 0; i < 2; ++i) { const int k = kr + 32 * i; u16* tq = t + q * 64 * 72;
            tq[(n4 + 0) * 72 + k] = f2bf(v[q][i].x); tq[(n4 + 1) * 72 + k] = f2bf(v[q][i].y); tq[(n4 + 2) * 72 + k] = f2bf(v[q][i].z); tq[(n4 + 3) * 72 + k] = f2bf(v[q][i].w); }
    __syncthreads();
#pragma unroll
    for (int q = 0; q < 4; ++q) { const int n = tid >> 3, kc = tid & 7;
        *(uint4*)(dst + (size_t)(q * 64 + n) * ldd + k0 + kc * 8) = *(const uint4*)(t + q * 64 * 72 + n * 72 + kc * 8); }
    __syncthreads();
}

DEVI void ada_job(const Params& p, int job, char* smem) {
    int tid = threadIdx.x; asm volatile("" : "+v"(tid));
    const int lane = tid & 63, w = tid >> 6, fr = lane & 15, fq = lane >> 4;
    u16* T = (u16*)smem;
    const int n0 = job * 64;
    float* ada = (float*)(p.ws + WS_ADA);
    f32x4 acc0[4], acc1[4];
#pragma unroll
    for (int n = 0; n < 4; ++n) acc0[n] = acc1[n] = (f32x4){0.f, 0.f, 0.f, 0.f};
    const int kr = tid >> 4, n4 = (tid & 15) * 4;
    const int r0 = 16 * w + fr;
    const float* c0 = (r0 < 4 ? p.c_prompt + (size_t)r0 * DM : p.c_sample + (size_t)(r0 - 4) * DM) + fq * 8;
    const bool v1 = (fr < 4);
    const float* c1 = p.c_sample + (size_t)(124 + (v1 ? fr : 0)) * DM + fq * 8;
    const float* wsrc = p.w_ada + (size_t)kr * ADAW + n0 + n4;
    float4 wv[4][2];
#pragma unroll
    for (int q = 0; q < 4; ++q)
#pragma unroll
        for (int i = 0; i < 2; ++i) wv[q][i] = *(const float4*)(wsrc + (size_t)(q * 64 + 32 * i) * ADAW);
    for (int gk = 0; gk < 8; ++gk) {
#pragma unroll
        for (int q = 0; q < 4; ++q)
#pragma unroll
            for (int i = 0; i < 2; ++i) { const int k = kr + 32 * i; u16* tq = T + q * 64 * 72;
                tq[(n4 + 0) * 72 + k] = f2bf(wv[q][i].x); tq[(n4 + 1) * 72 + k] = f2bf(wv[q][i].y); tq[(n4 + 2) * 72 + k] = f2bf(wv[q][i].z); tq[(n4 + 3) * 72 + k] = f2bf(wv[q][i].w); }
        __syncthreads();
        if (gk + 1 < 8) {
#pragma unroll
            for (int q = 0; q < 4; ++q)
#pragma unroll
                for (int i = 0; i < 2; ++i) wv[q][i] = *(const float4*)(wsrc + (size_t)((gk + 1) * 256 + q * 64 + 32 * i) * ADAW);
        }
#pragma unroll
        for (int q = 0; q < 4; ++q) { const int kt = gk * 4 + q; const u16* Tc = T + q * 64 * 72;
            bf16x8 a0[2], a1[2];
#pragma unroll
            for (int k2 = 0; k2 < 2; ++k2) { const f32x4 x0 = *(const f32x4*)(c0 + kt * 64 + k2 * 32), x1 = *(const f32x4*)(c0 + kt * 64 + k2 * 32 + 4);
                bf16x8 qq; qq[0] = (short)f2bf(siluf_(x0[0])); qq[1] = (short)f2bf(siluf_(x0[1])); qq[2] = (short)f2bf(siluf_(x0[2])); qq[3] = (short)f2bf(siluf_(x0[3]));
                qq[4] = (short)f2bf(siluf_(x1[0])); qq[5] = (short)f2bf(siluf_(x1[1])); qq[6] = (short)f2bf(siluf_(x1[2])); qq[7] = (short)f2bf(siluf_(x1[3])); a0[k2] = qq; }
            if (w == 0) {
#pragma unroll
                for (int k2 = 0; k2 < 2; ++k2) { const f32x4 x0 = *(const f32x4*)(c1 + kt * 64 + k2 * 32), x1 = *(const f32x4*)(c1 + kt * 64 + k2 * 32 + 4);
                    bf16x8 qq; qq[0] = (short)f2bf(siluf_(x0[0])); qq[1] = (short)f2bf(siluf_(x0[1])); qq[2] = (short)f2bf(siluf_(x0[2])); qq[3] = (short)f2bf(siluf_(x0[3]));
                    qq[4] = (short)f2bf(siluf_(x1[0])); qq[5] = (short)f2bf(siluf_(x1[1])); qq[6] = (short)f2bf(siluf_(x1[2])); qq[7] = (short)f2bf(siluf_(x1[3]));
#pragma unroll
                    for (int e = 0; e < 8; ++e) qq[e] = v1 ? qq[e] : (short)0;
                    a1[k2] = qq; }
            }
#pragma unroll
            for (int k2 = 0; k2 < 2; ++k2)
#pragma unroll
                for (int n = 0; n < 4; ++n) { const bf16x8 bb = *(const bf16x8*)(Tc + (n * 16 + fr) * 72 + k2 * 32 + fq * 8);
                    acc0[n] = mfma16(a0[k2], bb, acc0[n]); if (w == 0) acc1[n] = mfma16(a1[k2], bb, acc1[n]); }
        }
        __syncthreads();
    }
#pragma unroll
    for (int n = 0; n < 4; ++n) { const int col = n0 + n * 16 + fr; const float bias = p.b_ada[col];
#pragma unroll
        for (int j = 0; j < 4; ++j) { ada[(size_t)(16 * w + fq * 4 + j) * ADAW + col] = acc0[n][j] + bias;
            if (w == 0 && fq == 0) ada[(size_t)(128 + j) * ADAW + col] = acc1[n][j] + bias; } }
    __syncthreads();
}

DEVI void phase_prep(const Params& p, char* smem) {
    u16* t = (u16*)smem;
    u16* WinT = (u16*)(p.ws + WS_WIN);
    constexpr int JA = 192, JB = 32 * 33;
    constexpr int TOT = JA + JB;
    for (int job = blockIdx.x; job < TOT; job += gridDim.x) {
        int j = job;
        if (j < JA) { ada_job(p, j, smem); continue; }
        j -= JA;
        { const int kt = j & 31, rg = j >> 5, c = rg * 256; transpose_tile4(p.w_in, INC, INC, kt * 64, c, c + 64, c + 128, c + 192, WinT + (size_t)rg * 256 * DM, DM, t); }
    }
}
constexpr int N_LATE_TR = 32 * 8 + 32 * 44 + 88 * 8;
DEVI void late_transpose(const Params& p, int j, char* smem) {
    u16* t = (u16*)smem; u16* WoutT = (u16*)(p.ws + WS_WOUT); u16* WguT = (u16*)(p.ws + WS_WGU); u16* WdownT = (u16*)(p.ws + WS_WDOWN);
    if (j < 32 * 8) { const int kt = j & 31, rg = j >> 5, c = rg * 256; transpose_tile4(p.w_out, DM, DM, kt * 64, c, c + 64, c + 128, c + 192, WoutT + (size_t)rg * 256 * DM, DM, t); return; }
    j -= 32 * 8;
    if (j < 32 * 44) { const int kt = j & 31, jj = j >> 5;
        transpose_tile4(p.w_gu, 2 * DFF, 2 * DFF, kt * 64, 128 * jj, 128 * jj + 64, DFF + 128 * jj, DFF + 128 * jj + 64, WguT + (size_t)jj * 256 * DM, DM, t); return; }
    j -= 32 * 44;
    { const int kt = j % 88, rg = j / 88, c = rg * 256; transpose_tile4(p.w_down, DM, DM, kt * 64, c, c + 64, c + 128, c + 192, WdownT + (size_t)rg * 256 * DFF, DFF, t); }
}
DEVI void pop_late(const Params& p, char* smem, int maxjobs, int list = 0) {
    unsigned* q2 = (unsigned*)(p.ws + WS_BAR) + 96 + 4 * list;
    const unsigned base = list ? 32 * 8 + 32 * 44 : 0, cnt = list ? 88 * 8 : 32 * 8 + 32 * 44;
    volatile unsigned* lq = (volatile unsigned*)(smem + LDS_BYTES - 32);
    for (int n = 0; n < maxjobs; ++n) {
        __syncthreads();
        if (threadIdx.x == 0) *lq = __hip_atomic_fetch_add(q2, 1u, __ATOMIC_RELAXED, __HIP_MEMORY_SCOPE_AGENT);
        __syncthreads();
        const unsigned u = *lq;
        if (u >= cnt) break;
        late_transpose(p, (int)(base + u), smem);
    }
    __syncthreads();
}

struct PEpiProj { static constexpr bool PERM = false, AFTER_DRAIN = false; float* C; float* gates;
    DEVI void operator()(const pg8::f32x4 (&acc)[2][2][4][2], const pg8::Unit& u, int wr, int wc, int fr, int fq) const {
        const int row0 = u.pm * 256 + wr * 64 + fr, col0 = u.pn * 256 + wc * 32 + 4 * fq;
        if (u.pn == 32) {
            if (wc == 0) {
#pragma unroll
                for (int ai = 0; ai < 2; ++ai)
#pragma unroll
                    for (int m = 0; m < 4; ++m) { float* gp = gates + (size_t)(row0 + ai * 128 + m * 16) * 24 + 4 * fq;
                        *(f32x4*)gp = acc[ai][0][m][0]; if (fq < 2) *(f32x4*)(gp + 16) = acc[ai][0][m][1]; }
            }
            return;
        }
#pragma unroll
        for (int ai = 0; ai < 2; ++ai)
#pragma unroll
            for (int m = 0; m < 4; ++m) { float* rowp = C + (size_t)(row0 + ai * 128 + m * 16) * PLD + col0;
#pragma unroll
                for (int bj = 0; bj < 2; ++bj)
#pragma unroll
                    for (int n = 0; n < 2; ++n) *(f32x4*)(rowp + bj * 128 + n * 16) = acc[ai][bj][m][n]; }
    } };
struct PEpiRes { static constexpr bool PERM = false, AFTER_DRAIN = false;
    const float* xp; const float* xs; const float* res; const float* ada; int gofs; float* out; float* part; int klen;
    DEVI void operator()(const pg8::f32x4 (&acc)[2][2][4][2], const pg8::Unit& u, int wr, int wc, int fr, int fq) const {
        const int row0 = u.pm * 256 + wr * 64 + fr, col0 = u.pn * 256 + wc * 32 + 4 * fq;
        const bool sliced = (u.pm >= 32);
#pragma unroll
        for (int ai = 0; ai < 2; ++ai)
#pragma unroll
            for (int m = 0; m < 4; ++m) { const int row = row0 + ai * 128 + m * 16; const int b = tok_batch(row);
                const float* rp = res ? res + (size_t)row * DM : (row < NPT ? xp + (size_t)row * DM : xs + (size_t)(row - NPT) * DM);
                const float* gp = ada + (size_t)b * ADAW + gofs; float* op = out + (size_t)row * DM;
#pragma unroll
                for (int bj = 0; bj < 2; ++bj)
#pragma unroll
                    for (int n = 0; n < 2; ++n) { const int col = col0 + bj * 128 + n * 16;
                        const f32x4 g = *(const f32x4*)(gp + col);
                        if (sliced) {
                            *(f32x4*)(part + ((size_t)(u.k0 / klen) * 512 + (row - NPT)) * DM + col) = acc[ai][bj][m][n];
                        } else { const f32x4 r = *(const f32x4*)(rp + col);
                            *(f32x4*)(op + col) = ALPHA * r + (1.f + g) * acc[ai][bj][m][n]; } } }
    } };
struct PEpiGU { static constexpr bool PERM = true, AFTER_DRAIN = false; u16* act;
    DEVI void operator()(const pg8::f32x4 (&acc)[2][2][4][2], const pg8::Unit& u, int wr, int wc, int fr, int fq) const {
        const int row0 = u.pm * 256 + wr * 64 + fr, col0 = u.pn * 128 + wc * 32 + 8 * fq;
#pragma unroll
        for (int ai = 0; ai < 2; ++ai)
#pragma unroll
            for (int m = 0; m < 4; ++m) { const int row = row0 + ai * 128 + m * 16;
                const f32x4 g0 = acc[ai][0][m][0], g1 = acc[ai][0][m][1], u0 = acc[ai][1][m][0], u1 = acc[ai][1][m][1];
                uint4 w; w.x = pack2(siluf_(g0[0]) * u0[0], siluf_(g0[1]) * u0[1]); w.y = pack2(siluf_(g0[2]) * u0[2], siluf_(g0[3]) * u0[3]);
                w.z = pack2(siluf_(g1[0]) * u1[0], siluf_(g1[1]) * u1[1]); w.w = pack2(siluf_(g1[2]) * u1[2], siluf_(g1[3]) * u1[3]);
                *(uint4*)(act + (size_t)row * DFF + col0) = w; }
    } };
struct SplitOrder : pg8::StaticOrder {
    int KS, Kfull;
    __device__ void init2(int N, int K, int G_, int c_, int KS_) { init(NPT, N, G_, c_, K); KS = KS_; Kfull = K; }
    __device__ bool next(int i, pg8::Unit& u) const {
        if (i == 0) return pg8::StaticOrder::next(0, u);
        if (i > 1 || c >= 16 * KS) return false;
        const int slice = c % KS, tile = c / KS;
        u.pm = 32 + (tile >> 3); u.pn = tile & 7; u.k0 = slice * (Kfull / KS); u.nt = Kfull / KS / 64; return true;
    }
};
template <class Epi>
DEVI void pg8_run_split(const u16* A, const u16* Bt, int N, int K, int KS, char* smem, const Epi& e) {
    pg8::Gemm g{(const pg8::bf16_t*)A, (const pg8::bf16_t*)Bt, NTOK, N, K}; SplitOrder S; S.init2(N, K, (int)gridDim.x, (int)blockIdx.x, KS);
    pg8::gemm_phase<Epi, SplitOrder, false>((PG8_LAS unsigned char*)smem, g, S, e, nullptr);
}
template <class Epi>
DEVI void pg8_run(const u16* A, const u16* Bt, int M, int N, int K, char* smem, const Epi& e) {
    pg8::Gemm g{(const pg8::bf16_t*)A, (const pg8::bf16_t*)Bt, M, N, K}; pg8::StaticOrder S; S.init(M, N, (int)gridDim.x, (int)blockIdx.x, K);
    pg8::gemm_phase<Epi, pg8::StaticOrder, false>((PG8_LAS unsigned char*)smem, g, S, e, nullptr);
}

DEVI void modulate_row(const Params& p, int row, int lane) {
    const float* ada = (const float*)(p.ws + WS_ADA); u16* Ah = (u16*)(p.ws + WS_AH);
    const float* xr = x_row(p, row); const float* ar = ada + (size_t)tok_batch(row) * ADAW;
#pragma unroll
    for (int i = 0; i < 8; ++i) { const int col = i * 256 + lane * 4;
        const f32x4 x = *(const f32x4*)(xr + col), sh = *(const f32x4*)(ar + col), sc = *(const f32x4*)(ar + DM + col);
        const f32x4 h = x * (1.f + sc) + sh; uint2 w; w.x = pack2(h[0], h[1]); w.y = pack2(h[2], h[3]);
        *(uint2*)(Ah + (size_t)row * DM + col) = w; }
}
DEVI void phase_modulate(const Params& p) {
    const int lane = threadIdx.x & 63, gw = blockIdx.x * 8 + (threadIdx.x >> 6), nw = gridDim.x * 8;
    for (int sr = gw; sr < 4 * (NTOK - NPT); sr += nw) if ((sr & 3) == 0) modulate_row(p, NPT + (sr >> 2), lane);
    for (int row = gw; row < NPT; row += nw) modulate_row(p, row, lane);
}
DEVI void ln_row(f32x4 (&v)[8], const float* g, const float* bta, int lane) {
    float s = 0.f;
#pragma unroll
    for (int i = 0; i < 8; ++i) s += v[i][0] + v[i][1] + v[i][2] + v[i][3];
    const float mu = wsum(s) * (1.f / DM);
    float q = 0.f;
#pragma unroll
    for (int i = 0; i < 8; ++i) { v[i] = v[i] - mu; q += v[i][0] * v[i][0] + v[i][1] * v[i][1] + v[i][2] * v[i][2] + v[i][3] * v[i][3]; }
    const float rs = rsqrtf(wsum(q) * (1.f / DM) + 1e-5f);
#pragma unroll
    for (int i = 0; i < 8; ++i) { const int col = i * 256 + lane * 4; v[i] = v[i] * rs * *(const f32x4*)(g + col) + *(const f32x4*)(bta + col); }
}
DEVI void ln1_row(const Params& p, int row, int lane) {
    const float* ada = (const float*)(p.ws + WS_ADA); u16* Ah = (u16*)(p.ws + WS_AH); float* x1 = (float*)(p.ws + WS_X1);
    float* xr = x1 + (size_t)row * DM; const float* ar = ada + (size_t)tok_batch(row) * ADAW;
    f32x4 v[8];
    if (row < NPT) {
#pragma unroll
        for (int i = 0; i < 8; ++i) v[i] = *(const f32x4*)(xr + i * 256 + lane * 4);
    } else { const float* part = (const float*)(p.ws + WS_PART) + (size_t)(row - NPT) * DM; const float* xs = p.x_sample + (size_t)(row - NPT) * DM;
#pragma unroll
        for (int i = 0; i < 8; ++i) { const int col = i * 256 + lane * 4; f32x4 a = {0.f, 0.f, 0.f, 0.f};
#pragma unroll
            for (int k = 0; k < 8; ++k) a += *(const f32x4*)(part + (size_t)k * 512 * DM + col);
            v[i] = ALPHA * *(const f32x4*)(xs + col) + (1.f + *(const f32x4*)(ar + 2 * DM + col)) * a; } }
    ln_row(v, p.ln1_g, p.ln1_b, lane);
#pragma unroll
    for (int i = 0; i < 8; ++i) { const int col = i * 256 + lane * 4; *(f32x4*)(xr + col) = v[i];
        const f32x4 sh = *(const f32x4*)(ar + 3 * DM + col), sc = *(const f32x4*)(ar + 4 * DM + col);
        const f32x4 h = v[i] * (1.f + sc) + sh; uint2 w; w.x = pack2(h[0], h[1]); w.y = pack2(h[2], h[3]);
        *(uint2*)(Ah + (size_t)row * DM + col) = w; }
}
DEVI void phase_ln1(const Params& p) {
    const int lane = threadIdx.x & 63, gw = blockIdx.x * 8 + (threadIdx.x >> 6), nw = gridDim.x * 8;
    for (int sr = gw; sr < 4 * (NTOK - NPT); sr += nw) if ((sr & 3) == 0) ln1_row(p, NPT + (sr >> 2), lane);
    for (int row = gw; row < NPT; row += nw) ln1_row(p, row, lane);
}
DEVI void ln2_row(const Params& p, int row, int lane) {
    float* xr = p.out + O_YP + (size_t)row * DM;
    f32x4 v[8];
    if (row < NPT) {
#pragma unroll
        for (int i = 0; i < 8; ++i) v[i] = *(const f32x4*)(xr + i * 256 + lane * 4);
    } else { const float* part = (const float*)(p.ws + WS_PART) + (size_t)(row - NPT) * DM; const float* x1r = (const float*)(p.ws + WS_X1) + (size_t)row * DM;
        const float* ar = (const float*)(p.ws + WS_ADA) + (size_t)tok_batch(row) * ADAW;
#pragma unroll
        for (int i = 0; i < 8; ++i) { const int col = i * 256 + lane * 4; f32x4 a = {0.f, 0.f, 0.f, 0.f};
#pragma unroll
            for (int k = 0; k < 11; ++k) a += *(const f32x4*)(part + (size_t)k * 512 * DM + col);
            v[i] = ALPHA * *(const f32x4*)(x1r + col) + (1.f + *(const f32x4*)(ar + 5 * DM + col)) * a; } }
    ln_row(v, p.ln2_g, p.ln2_b, lane);
#pragma unroll
    for (int i = 0; i < 8; ++i) *(f32x4*)(xr + i * 256 + lane * 4) = v[i];
}
DEVI void phase_ln2(const Params& p) {
    const int lane = threadIdx.x & 63, gw = blockIdx.x * 8 + (threadIdx.x >> 6), nw = gridDim.x * 8;
    for (int sr = gw; sr < 4 * (NTOK - NPT); sr += nw) if ((sr & 3) == 0) ln2_row(p, NPT + (sr >> 2), lane);
    for (int row = gw; row < NPT; row += nw) ln2_row(p, row, lane);
}
DEVI void phase_post(const Params& p) {
    const float* proj = (const float*)(p.ws + WS_PROJ); const float* gates = (const float*)(p.ws + WS_GATES); const u16* hbuf = (const u16*)(p.ws + WS_HBUF); u16* mix = (u16*)(p.ws + WS_MIX);
    const int lane = threadIdx.x & 63, gw = blockIdx.x * 8 + (threadIdx.x >> 6), nw = gridDim.x * 8;
    for (int row = gw; row < NPT; row += nw) {
        const u16* hr = hbuf + (size_t)row * DM; const float* pr = proj + (size_t)row * PLD; u16* mr = mix + (size_t)row * DM;
#pragma unroll
        for (int h = 0; h < 4; ++h) { const int col = h * 256 + lane * 4;
            const uint2 hv2 = *(const uint2*)(hr + col); const f32x4 v = {__uint_as_float(hv2.x << 16), __uint_as_float(hv2.x & 0xFFFF0000u), __uint_as_float(hv2.y << 16), __uint_as_float(hv2.y & 0xFFFF0000u)}; const float ss = wsum(v[0] * v[0] + v[1] * v[1] + v[2] * v[2] + v[3] * v[3]);
            const float rs = rsqrtf(ss * (1.f / 256.f) + 1e-6f);
            const f32x4 g = *(const f32x4*)(p.m_norm_g + col), o = *(const f32x4*)(pr + 3072 + col);
            uint2 w; w.x = pack2(v[0] * rs * g[0] * sigmoidf_(o[0]), v[1] * rs * g[1] * sigmoidf_(o[1]));
            w.y = pack2(v[2] * rs * g[2] * sigmoidf_(o[2]), v[3] * rs * g[3] * sigmoidf_(o[3]));
            *(uint2*)(mr + col) = w; }
#pragma unroll
        for (int h = 0; h < 8; ++h) { const int c = h * 128 + lane * 2;
            const unsigned hv1 = *(const unsigned*)(hr + 1024 + c); const float v0 = __uint_as_float(hv1 << 16), v1 = __uint_as_float(hv1 & 0xFFFF0000u); const float ss = wsum(v0 * v0 + v1 * v1);
            const float rs = rsqrtf(ss * (1.f / 128.f) + 1e-6f);
            const float z0 = pr[7168 + c], z1 = pr[7168 + c + 1];
            *(unsigned*)(mr + 1024 + c) = pack2(v0 * rs * p.g_norm_g[c] * siluf_(z0), v1 * rs * p.g_norm_g[c + 1] * siluf_(z1)); }
    }
    const int total = (4 + 128) * 3 * 3072;
    for (int i = blockIdx.x * NTHR + threadIdx.x; i < total; i += gridDim.x * NTHR) {
        const int ch = i % 3072, rj = i / 3072, j = rj % 3, b = rj / 3;
        if (b < 4) p.out[O_PCONV + (size_t)(b * 3 + j) * 3072 + ch] = proj[(size_t)(b * 2048 + 2045 + j) * PLD + 4096 + ch];
        else p.out[O_SCONV + (size_t)((b - 4) * 3 + j) * 3072 + ch] = proj[(size_t)(NPT + (b - 4) * 4 + 1 + j) * PLD + 4096 + ch];
    }
}

DEVI float scan_add(float x, int lane) { for (int o = 1; o < 64; o <<= 1) { const float y = __shfl_up(x, o); if (lane >= o) x += y; } return x; }
DEVI float scan_max(float x, int lane) { for (int o = 1; o < 64; o <<= 1) { const float y = __shfl_up(x, o); if (lane >= o) x = fmaxf(x, y); } return x; }

DEVI void mlstm_pre(const Params& p, int unit, char* smem) {
    int tid = threadIdx.x; asm volatile("" : "+v"(tid));
    const int lane = tid & 63, w = tid >> 6, fr = lane & 15, fq = lane >> 4;
    const int b = unit >> 7, h = (unit >> 5) & 3, c = unit & 31;
    u16* Qs = (u16*)smem;
    u16* Ks = Qs + 64 * 264;
    const float* proj = (const float*)(p.ws + WS_PROJ); const float* gates = (const float*)(p.ws + WS_GATES);
    u16* MP = (u16*)(p.ws + WS_MP) + (size_t)unit * 4096; u16* MKT = (u16*)(p.ws + WS_MKT) + (size_t)unit * 16384; u16* MQ = (u16*)(p.ws + WS_MQ) + (size_t)unit * 16384;
    u16* MVT = (u16*)(p.ws + WS_MVT) + (size_t)unit * 16384; float* MSC = (float*)(p.ws + WS_MSC) + (size_t)unit * 128;
    const size_t row0 = (size_t)b * 2048 + c * 64;
    const float iv = gates[(row0 + lane) * 24 + h] + p.m_i_bias[h];
    const float fv = gates[(row0 + lane) * 24 + 4 + h] + p.m_f_bias[h];
    const float bt = scan_add(logsigf_(fv), lane);
    const float av = iv - bt;
    const float ml = scan_max(av, lane);
    const float wt = __expf(av - __shfl(ml, 63));
    if (w == 0) { MSC[lane] = bt; MSC[64 + lane] = ml; }
    {
        unsigned kt[4][4], vt[4][4];
#pragma unroll
        for (int i = 0; i < 8; ++i) { const int s = w * 8 + i; const float* pr = proj + (row0 + s) * PLD + h * 256 + lane * 4;
            const f32x4 qv = *(const f32x4*)(pr), kv = *(const f32x4*)(pr + 1024) * 0.0625f, vv = *(const f32x4*)(pr + 2048);
            uint2 pq; pq.x = pack2(qv[0], qv[1]); pq.y = pack2(qv[2], qv[3]); *(uint2*)(Qs + s * 264 + lane * 4) = pq; *(uint2*)(MQ + s * 256 + lane * 4) = pq;
            uint2 pk; pk.x = pack2(kv[0], kv[1]); pk.y = pack2(kv[2], kv[3]); *(uint2*)(Ks + s * 264 + lane * 4) = pk;
            const float ws_ = __shfl(wt, s);
#pragma unroll
            for (int dd = 0; dd < 4; ++dd) { const unsigned kb = f2bf(kv[dd] * ws_), vb = f2bf(vv[dd]);
                if (i & 1) { kt[dd][i >> 1] |= kb << 16; vt[dd][i >> 1] |= vb << 16; } else { kt[dd][i >> 1] = kb; vt[dd][i >> 1] = vb; } } }
#pragma unroll
        for (int dd = 0; dd < 4; ++dd) {
            *(uint4*)(MKT + (lane * 4 + dd) * 64 + w * 8) = make_uint4(kt[dd][0], kt[dd][1], kt[dd][2], kt[dd][3]);
            *(uint4*)(MVT + (lane * 4 + dd) * 64 + w * 8) = make_uint4(vt[dd][0], vt[dd][1], vt[dd][2], vt[dd][3]); }
    }
    __syncthreads();
    {
        const int mt = w & 3, g = w >> 2;
        f32x4 acc[2]; acc[0] = acc[1] = (f32x4){0.f, 0.f, 0.f, 0.f};
#pragma unroll
        for (int kk = 0; kk < 8; ++kk) { const bf16x8 aQ = *(const bf16x8*)(Qs + (mt * 16 + fr) * 264 + kk * 32 + fq * 8);
#pragma unroll
            for (int n = 0; n < 2; ++n) acc[n] = mfma16(*(const bf16x8*)(Ks + ((g * 2 + n) * 16 + fr) * 264 + kk * 32 + fq * 8), aQ, acc[n]); }
        const int t = mt * 16 + fr; const float mlt = __shfl(ml, t);
#pragma unroll
        for (int n = 0; n < 2; ++n) { float pv[4];
#pragma unroll
            for (int j = 0; j < 4; ++j) { const int s = (g * 2 + n) * 16 + fq * 4 + j; const float as_ = __shfl(av, s);
                pv[j] = (s <= t) ? acc[n][j] * __expf(as_ - mlt) : 0.f; }
            uint2 pp; pp.x = pack2(pv[0], pv[1]); pp.y = pack2(pv[2], pv[3]);
            *(uint2*)(MP + t * 64 + (g * 2 + n) * 16 + fq * 4) = pp; }
    }
    __syncthreads();
}

struct MlLd { bf16x8 fP[2]; bf16x8 fV[4][2]; bf16x8 fK[2][2]; bf16x8 fQ[8]; float bt, ml; };
DEVI void ml_loadQ(MlLd& L, const Params& p, int unit, int mt, int fr, int fq) {
    const u16* MQ = (const u16*)(p.ws + WS_MQ) + (size_t)unit * 16384;
#pragma unroll
    for (int kk = 0; kk < 8; ++kk) L.fQ[kk] = *(const bf16x8*)(MQ + (mt * 16 + fr) * 256 + kk * 32 + fq * 8);
}
DEVI void ml_loadP(MlLd& L, const Params& p, int unit, int mt, int fr, int fq) {
    const u16* MP = (const u16*)(p.ws + WS_MP) + (size_t)unit * 4096;
#pragma unroll
    for (int k2 = 0; k2 < 2; ++k2) L.fP[k2] = *(const bf16x8*)(MP + (mt * 16 + fr) * 64 + k2 * 32 + fq * 8);
}
DEVI void ml_loadVK(MlLd& L, const Params& p, int unit, int eb, int w, int fr, int fq) {
    const u16* MKT = (const u16*)(p.ws + WS_MKT) + (size_t)unit * 16384; const u16* MVT = (const u16*)(p.ws + WS_MVT) + (size_t)unit * 16384;
#pragma unroll
    for (int k2 = 0; k2 < 2; ++k2) {
#pragma unroll
        for (int m = 0; m < 4; ++m) L.fV[m][k2] = *(const bf16x8*)(MVT + (eb * 64 + m * 16 + fr) * 64 + k2 * 32 + fq * 8);
#pragma unroll
        for (int n = 0; n < 2; ++n) L.fK[n][k2] = *(const bf16x8*)(MKT + (w * 32 + n * 16 + fr) * 64 + k2 * 32 + fq * 8); }
}
DEVI void ml_loadS(MlLd& L, const Params& p, int unit, int lane) {
    const float* MSC = (const float*)(p.ws + WS_MSC) + (size_t)unit * 128; L.bt = MSC[lane]; L.ml = MSC[64 + lane];
}
DEVI void mlstm_load(MlLd& L, const Params& p, int unit, int eb, int lane, int w, int mt, int fr, int fq) {
    ml_loadQ(L, p, unit, mt, fr, fq); ml_loadP(L, p, unit, mt, fr, fq); ml_loadVK(L, p, unit, eb, w, fr, fq); ml_loadS(L, p, unit, lane);
}
DEVI void mlstm_seq(const Params& p, int role, char* smem) {
    const int tid = threadIdx.x, lane0 = tid & 63, w0 = tid >> 6;
    const int b = role >> 4, h = (role >> 2) & 3, eb = role & 3;
    u16* Cts = (u16*)smem;
    for (int i = tid; i < 2 * 80 * 264 / 2; i += NTHR) ((unsigned*)Cts)[i] = 0u;
    u16* hbuf = (u16*)(p.ws + WS_HBUF);
    f32x4 accC[5][2];
#pragma unroll
    for (int m = 0; m < 5; ++m) { accC[m][0] = (f32x4){0.f, 0.f, 0.f, 0.f}; accC[m][1] = (f32x4){0.f, 0.f, 0.f, 0.f}; }
    float mcar = 0.f;
    const int ubase = (b * 4 + h) * 32;
    MlLd L;
    mlstm_load(L, p, ubase, eb, lane0, w0, w0 & 3, lane0 & 15, lane0 >> 4);
    __syncthreads();
    for (int c = 0; c < 32; ++c) {
        int lane = lane0, w = w0; asm volatile("" : "+v"(lane), "+v"(w));
        const int fr = lane & 15, fq = lane >> 4, mt = w & 3, g = w >> 2;
        const size_t row0 = (size_t)b * 2048 + c * 64;
        const u16* Cc = Cts + (c & 1) * 80 * 264; u16* Cn = Cts + ((c & 1) ^ 1) * 80 * 264;
        const float bt = L.bt, ml = L.ml;
        const float mr = fmaxf(ml, mcar);
        const float bL = __shfl(bt, 63), mrL = __shfl(mr, 63), mlL = __shfl(ml, 63);
        const float mnew = bL + mrL, decay = __expf(bL + mcar - mnew), rho = __expf(mlL - mrL);
        const float iw = __expf(mcar - mr), rt = __expf(ml - mr), flo = __expf(-(bt + mr));
        bf16x8 one8;
#pragma unroll
        for (int i = 0; i < 8; ++i) one8[i] = (fr == 0) ? (short)0x3F80 : (short)0;
        const bool more = (c + 1 < 32); const int nu = ubase + c + 1;
        if (more) ml_loadS(L, p, nu, lane);
        f32x4 accH1[3]; accH1[0] = accH1[1] = accH1[2] = (f32x4){0.f, 0.f, 0.f, 0.f};
#pragma unroll
        for (int kk = 0; kk < 8; ++kk) { const bf16x8 q = L.fQ[kk];
#pragma unroll
            for (int n = 0; n < 3; ++n) { const int et = n < 2 ? g * 2 + n : 4;
                accH1[n] = mfma16(q, *(const bf16x8*)(Cc + (et * 16 + fr) * 264 + kk * 32 + fq * 8), accH1[n]); } }
        __builtin_amdgcn_sched_barrier(0);
        if (more) ml_loadQ(L, p, nu, mt, fr, fq);
        __builtin_amdgcn_sched_barrier(0);
        f32x4 accH2[3]; accH2[0] = accH2[1] = accH2[2] = (f32x4){0.f, 0.f, 0.f, 0.f};
#pragma unroll
        for (int k2 = 0; k2 < 2; ++k2) {
#pragma unroll
            for (int n = 0; n < 2; ++n) { bf16x8 bv;
#pragma unroll
                for (int i = 0; i < 8; ++i) bv[i] = g ? L.fV[2 + n][k2][i] : L.fV[n][k2][i];
                accH2[n] = mfma16(L.fP[k2], bv, accH2[n]); }
            accH2[2] = mfma16(L.fP[k2], one8, accH2[2]); }
        __builtin_amdgcn_sched_barrier(0);
        if (more) ml_loadP(L, p, nu, mt, fr, fq);
        __builtin_amdgcn_sched_barrier(0);
#pragma unroll
        for (int j = 0; j < 4; ++j) { const int t = mt * 16 + fq * 4 + j;
            const float iwt = __shfl(iw, t), rtt = __shfl(rt, t), fl = __shfl(flo, t);
            const float h0 = iwt * accH1[0][j] + rtt * accH2[0][j], h1 = iwt * accH1[1][j] + rtt * accH2[1][j], hd = iwt * accH1[2][j] + rtt * accH2[2][j];
            const float den = __shfl(hd, fq * 16); const float dn = fmaxf(fabsf(den), fl);
            hbuf[(row0 + t) * DM + h * 256 + eb * 64 + (g * 2) * 16 + fr] = f2bf(h0 / dn);
            hbuf[(row0 + t) * DM + h * 256 + eb * 64 + (g * 2 + 1) * 16 + fr] = f2bf(h1 / dn); }
        __builtin_amdgcn_sched_barrier(0);
        {
            f32x4 tmp[5][2];
#pragma unroll
            for (int m = 0; m < 5; ++m) { tmp[m][0] = (f32x4){0.f, 0.f, 0.f, 0.f}; tmp[m][1] = (f32x4){0.f, 0.f, 0.f, 0.f}; }
#pragma unroll
            for (int k2 = 0; k2 < 2; ++k2)
#pragma unroll
                for (int m = 0; m < 5; ++m)
#pragma unroll
                    for (int n = 0; n < 2; ++n) tmp[m][n] = mfma16(m < 4 ? L.fV[m < 4 ? m : 0][k2] : one8, L.fK[n][k2], tmp[m][n]);
            __builtin_amdgcn_sched_barrier(0);
            if (more) ml_loadVK(L, p, nu, eb, w, fr, fq);
            __builtin_amdgcn_sched_barrier(0);
#pragma unroll
            for (int m = 0; m < 5; ++m)
#pragma unroll
                for (int n = 0; n < 2; ++n) { accC[m][n] = decay * accC[m][n] + rho * tmp[m][n];
#pragma unroll
                    for (int j = 0; j < 4; ++j) Cn[(m * 16 + fq * 4 + j) * 264 + w * 32 + n * 16 + fr] = f2bf(accC[m][n][j]); }
        }
        __builtin_amdgcn_sched_barrier(0);
        mcar = mnew;
        __syncthreads();
    }
    const int lane = lane0, w = w0, fr = lane & 15, fq = lane >> 4;
    float* pC = p.out + O_PC + (size_t)(b * 4 + h) * 65536;
#pragma unroll
    for (int m = 0; m < 4; ++m)
#pragma unroll
        for (int n = 0; n < 2; ++n) *(f32x4*)(pC + (size_t)(w * 32 + n * 16 + fr) * 256 + eb * 64 + m * 16 + fq * 4) = accC[m][n];
    if (eb == 0 && fq == 0) { p.out[O_PN + (b * 4 + h) * 256 + w * 32 + fr] = accC[4][0][0]; p.out[O_PN + (b * 4 + h) * 256 + w * 32 + 16 + fr] = accC[4][1][0]; }
    if (eb == 0 && tid == 0) p.out[O_PM + b * 4 + h] = mcar;
    __syncthreads();
}

DEVI void gdn_pre(const Params& p, int unit, char* smem) {
    int tid = threadIdx.x; asm volatile("" : "+v"(tid));
    const int lane = tid & 63, w = tid >> 6, fr = lane & 15, fq = lane >> 4;
    const int b = unit >> 8, h = (unit >> 5) & 7, c = unit & 31;
    u16* Ks = (u16*)smem;
    u16* Qs = Ks + 64 * 136;
    u16* KbT = Qs + 64 * 136;
    u16* VbT = KbT + 128 * 72;
    u16* KwT = VbT + 128 * 72;
    u16* Mb = KwT + 128 * 72;
    u16* Mtb = Mb + 2 * 64 * 72;
    u16* Ts = Mtb + 2 * 64 * 72;
    u16* Ps = Ts + 64 * 72;
    const float* proj = (const float*)(p.ws + WS_PROJ); const float* gates = (const float*)(p.ws + WS_GATES);
    u16* GQ = (u16*)(p.ws + WS_GQ) + (size_t)unit * 8192; u16* GW = (u16*)(p.ws + WS_GW) + (size_t)unit * 8192;
    u16* GP = (u16*)(p.ws + WS_GP) + (size_t)unit * 4096; u16* GU0 = (u16*)(p.ws + WS_GU0) + (size_t)unit * 8192;
    u16* GKW = (u16*)(p.ws + WS_GKW) + (size_t)unit * 8192; float* GSC = (float*)(p.ws + WS_GSC) + (size_t)unit * 80;
    const float dtb = p.g_dt_bias[h], Aexp = __expf(p.g_A_log[h]);
    const int mt = w & 3, g = w >> 2;
    const int chq = h * 128 + 2 * lane, chk = 1024 + chq, chv = 2048 + chq;
    const long row0 = (long)b * 2048 + c * 64;
    const float ga = gates[(row0 + lane) * 24 + 16 + h] + dtb;
    const float la = -Aexp * softplusf_(ga);
    const float beta = sigmoidf_(gates[(row0 + lane) * 24 + 8 + h]);
    const float bc = scan_add(la, lane);
    const float bL = __shfl(bc, 63);
    const float eb_ = __expf(bc);
    if (w == 0) { GSC[lane] = eb_; if (lane == 0) GSC[64] = __expf(bL); }
    {
        float2 cq[4], ck[4], cv[4];
#pragma unroll
        for (int j = 0; j < 4; ++j) { cq[j] = *(const float2*)(p.conv_w + j * 3072 + chq); ck[j] = *(const float2*)(p.conv_w + j * 3072 + chk); cv[j] = *(const float2*)(p.conv_w + j * 3072 + chv); }
        float2 rq[11], rk[11], rv[11];
#pragma unroll
        for (int j = 0; j < 11; ++j) { const long tg = (long)c * 64 + w * 8 - 3 + j;
            if (tg >= 0) { const float* pr = proj + ((long)b * 2048 + tg) * PLD + 4096;
                rq[j] = *(const float2*)(pr + chq); rk[j] = *(const float2*)(pr + chk); rv[j] = *(const float2*)(pr + chv); }
            else { rq[j] = make_float2(0.f, 0.f); rk[j] = make_float2(0.f, 0.f); rv[j] = make_float2(0.f, 0.f); } }
        unsigned kb0[4], kb1[4], kw0[4], kw1[4], vb0[4], vb1[4];
#pragma unroll
        for (int i = 0; i < 8; ++i) { const int s = w * 8 + i;
            float yq0 = cq[0].x * rq[i].x + cq[1].x * rq[i + 1].x + cq[2].x * rq[i + 2].x + cq[3].x * rq[i + 3].x;
            float yq1 = cq[0].y * rq[i].y + cq[1].y * rq[i + 1].y + cq[2].y * rq[i + 2].y + cq[3].y * rq[i + 3].y;
            float yk0 = ck[0].x * rk[i].x + ck[1].x * rk[i + 1].x + ck[2].x * rk[i + 2].x + ck[3].x * rk[i + 3].x;
            float yk1 = ck[0].y * rk[i].y + ck[1].y * rk[i + 1].y + ck[2].y * rk[i + 2].y + ck[3].y * rk[i + 3].y;
            float yv0 = cv[0].x * rv[i].x + cv[1].x * rv[i + 1].x + cv[2].x * rv[i + 2].x + cv[3].x * rv[i + 3].x;
            float yv1 = cv[0].y * rv[i].y + cv[1].y * rv[i + 1].y + cv[2].y * rv[i + 2].y + cv[3].y * rv[i + 3].y;
            yq0 = siluf_(yq0); yq1 = siluf_(yq1); yk0 = siluf_(yk0); yk1 = siluf_(yk1); yv0 = siluf_(yv0); yv1 = siluf_(yv1);
            const float rqn = rsqrtf(wsum(yq0 * yq0 + yq1 * yq1) + 1e-6f) * 0.08838834764831845f;
            const float rkn = rsqrtf(wsum(yk0 * yk0 + yk1 * yk1) + 1e-6f);
            yq0 *= rqn; yq1 *= rqn; yk0 *= rkn; yk1 *= rkn;
            *(unsigned*)(Qs + s * 136 + 2 * lane) = pack2(yq0, yq1);
            *(unsigned*)(Ks + s * 136 + 2 * lane) = pack2(yk0, yk1);
            const float bs_ = __shfl(bc, s), bets = __shfl(beta, s);
            const float f1 = bets * __expf(bs_), f2 = __expf(bL - bs_);
            const unsigned a0 = f2bf(yk0 * f1), a1 = f2bf(yk1 * f1), w0_ = f2bf(yk0 * f2), w1_ = f2bf(yk1 * f2), v0_ = f2bf(yv0 * bets), v1_ = f2bf(yv1 * bets);
            if (i & 1) { kb0[i >> 1] |= a0 << 16; kb1[i >> 1] |= a1 << 16; kw0[i >> 1] |= w0_ << 16; kw1[i >> 1] |= w1_ << 16; vb0[i >> 1] |= v0_ << 16; vb1[i >> 1] |= v1_ << 16; }
            else { kb0[i >> 1] = a0; kb1[i >> 1] = a1; kw0[i >> 1] = w0_; kw1[i >> 1] = w1_; vb0[i >> 1] = v0_; vb1[i >> 1] = v1_; } }
        *(uint4*)(KbT + (2 * lane) * 72 + w * 8) = make_uint4(kb0[0], kb0[1], kb0[2], kb0[3]);
        *(uint4*)(KbT + (2 * lane + 1) * 72 + w * 8) = make_uint4(kb1[0], kb1[1], kb1[2], kb1[3]);
        *(uint4*)(KwT + (2 * lane) * 72 + w * 8) = make_uint4(kw0[0], kw0[1], kw0[2], kw0[3]);
        *(uint4*)(KwT + (2 * lane + 1) * 72 + w * 8) = make_uint4(kw1[0], kw1[1], kw1[2], kw1[3]);
        *(uint4*)(VbT + (2 * lane) * 72 + w * 8) = make_uint4(vb0[0], vb0[1], vb0[2], vb0[3]);
        *(uint4*)(VbT + (2 * lane + 1) * 72 + w * 8) = make_uint4(vb1[0], vb1[1], vb1[2], vb1[3]);
    }
    __syncthreads();
    {
        f32x4 aKK[2], aQK[2];
#pragma unroll
        for (int n = 0; n < 2; ++n) aKK[n] = aQK[n] = (f32x4){0.f, 0.f, 0.f, 0.f};
#pragma unroll
        for (int k = 0; k < 128; k += 32) {
            const bf16x8 fK = *(const bf16x8*)(Ks + (mt * 16 + fr) * 136 + k + fq * 8), fQ = *(const bf16x8*)(Qs + (mt * 16 + fr) * 136 + k + fq * 8);
#pragma unroll
            for (int n = 0; n < 2; ++n) { const bf16x8 bK = *(const bf16x8*)(Ks + ((g * 2 + n) * 16 + fr) * 136 + k + fq * 8);
                aKK[n] = mfma16(fK, bK, aKK[n]); aQK[n] = mfma16(fQ, bK, aQK[n]); }
        }
#pragma unroll
        for (int n = 0; n < 2; ++n) { const int s = (g * 2 + n) * 16 + fr; const float bs_ = __shfl(bc, s);
#pragma unroll
            for (int j = 0; j < 4; ++j) { const int l = mt * 16 + fq * 4 + j; const float bl = __shfl(bc, l), betl = __shfl(beta, l);
                const float dec = __expf(fminf(bl - bs_, 0.f));
                const float nm = (s < l) ? -betl * aKK[n][j] * dec : 0.f; const u16 nmb = f2bf(nm);
                Mb[l * 72 + s] = nmb; Mtb[s * 72 + l] = nmb; Ts[l * 72 + s] = (l == s) ? (u16)0x3F80 : nmb;
                Ps[l * 72 + s] = f2bf((s <= l) ? aQK[n][j] * dec : 0.f); } }
    }
    __syncthreads();
    {
        f32x4 accT[4];
        if (w >= 4) {
#pragma unroll
            for (int n = 0; n < 4; ++n)
#pragma unroll
                for (int j = 0; j < 4; ++j) accT[n][j] = bf2f(Ts[((w - 4) * 16 + fq * 4 + j) * 72 + n * 16 + fr]);
        }
        for (int k = 1; k <= 6; ++k) {
            const int cur = (k - 1) & 1;
            const u16* Mc = Mb + cur * 64 * 72; const u16* Mtc = Mtb + cur * 64 * 72;
            if (w < 4) {
                if (k <= 5) {
                    f32x4 am[1][4];
#pragma unroll
                    for (int n = 0; n < 4; ++n) am[0][n] = (f32x4){0.f, 0.f, 0.f, 0.f};
                    mma_lds<1, 4>(am, Mc + (w * 16) * 72, 72, Mtc, 72, 64, fr, fq);
                    u16* Mn = Mb + (cur ^ 1) * 64 * 72; u16* Mtn = Mtb + (cur ^ 1) * 64 * 72;
#pragma unroll
                    for (int n = 0; n < 4; ++n)
#pragma unroll
                        for (int j = 0; j < 4; ++j) { const int l = w * 16 + fq * 4 + j, s = n * 16 + fr; const u16 v = f2bf(am[0][n][j]); Mn[l * 72 + s] = v; Mtn[s * 72 + l] = v; }
                }
            } else if (k >= 2) {
                f32x4 at[1][4];
#pragma unroll
                for (int n = 0; n < 4; ++n) at[0][n] = accT[n];
                mma_lds<1, 4>(at, Ts + ((w - 4) * 16) * 72, 72, Mtc, 72, 64, fr, fq);
#pragma unroll
                for (int n = 0; n < 4; ++n) { accT[n] = at[0][n];
#pragma unroll
                    for (int j = 0; j < 4; ++j) Ts[((w - 4) * 16 + fq * 4 + j) * 72 + n * 16 + fr] = f2bf(accT[n][j]); }
            }
            __syncthreads();
        }
    }
    {
        f32x4 aW[4], aU[4];
#pragma unroll
        for (int n = 0; n < 4; ++n) aW[n] = aU[n] = (f32x4){0.f, 0.f, 0.f, 0.f};
#pragma unroll
        for (int k2 = 0; k2 < 2; ++k2) { const bf16x8 aT = *(const bf16x8*)(Ts + (mt * 16 + fr) * 72 + k2 * 32 + fq * 8);
#pragma unroll
            for (int n = 0; n < 4; ++n) { const bf16x8 bK = *(const bf16x8*)(KbT + ((g * 4 + n) * 16 + fr) * 72 + k2 * 32 + fq * 8);
                const bf16x8 bV = *(const bf16x8*)(VbT + ((g * 4 + n) * 16 + fr) * 72 + k2 * 32 + fq * 8);
                aW[n] = mfma16(bK, aT, aW[n]);
                aU[n] = mfma16(aT, bV, aU[n]); } }
#pragma unroll
        for (int n = 0; n < 4; ++n) {
            uint2 pw; pw.x = pack2(aW[n][0], aW[n][1]); pw.y = pack2(aW[n][2], aW[n][3]);
            *(uint2*)(GW + (mt * 16 + fr) * 128 + (g * 4 + n) * 16 + fq * 4) = pw;
            uint2 pu; pu.x = pack2(aU[n][0], aU[n][1]); pu.y = pack2(aU[n][2], aU[n][3]);
            *(uint2*)(GU0 + ((g * 4 + n) * 16 + fr) * 64 + mt * 16 + fq * 4) = pu; }
#pragma unroll
        for (int i = 0; i < 2; ++i) { const int id = tid + i * NTHR;
            *(uint4*)(GQ + (id >> 4) * 128 + (id & 15) * 8) = *(const uint4*)(Qs + (id >> 4) * 136 + (id & 15) * 8);
            *(uint4*)(GKW + (id >> 3) * 64 + (id & 7) * 8) = *(const uint4*)(KwT + (id >> 3) * 72 + (id & 7) * 8); }
        *(uint4*)(GP + (tid >> 3) * 64 + (tid & 7) * 8) = *(const uint4*)(Ps + (tid >> 3) * 72 + (tid & 7) * 8);
    }
    __syncthreads();
}

struct GdnLd { bf16x8 fW[4], fQ[4], fP[2], fKw[2]; uint2 u0[2]; float ebl[4]; float ebL; };
DEVI void gdn_load(GdnLd& L, const Params& p, int unit, int eb, int w, int mt, int g, int fr, int fq) {
    const u16* GQ = (const u16*)(p.ws + WS_GQ) + (size_t)unit * 8192; const u16* GW = (const u16*)(p.ws + WS_GW) + (size_t)unit * 8192;
    const u16* GP = (const u16*)(p.ws + WS_GP) + (size_t)unit * 4096; const u16* GU0 = (const u16*)(p.ws + WS_GU0) + (size_t)unit * 8192;
    const u16* GKW = (const u16*)(p.ws + WS_GKW) + (size_t)unit * 8192; const float* GSC = (const float*)(p.ws + WS_GSC) + (size_t)unit * 80;
#pragma unroll
    for (int kk = 0; kk < 4; ++kk) { L.fW[kk] = *(const bf16x8*)(GW + (mt * 16 + fr) * 128 + kk * 32 + fq * 8); L.fQ[kk] = *(const bf16x8*)(GQ + (mt * 16 + fr) * 128 + kk * 32 + fq * 8); }
#pragma unroll
    for (int k2 = 0; k2 < 2; ++k2) { L.fP[k2] = *(const bf16x8*)(GP + (mt * 16 + fr) * 64 + k2 * 32 + fq * 8); L.fKw[k2] = *(const bf16x8*)(GKW + (w * 16 + fr) * 64 + k2 * 32 + fq * 8); }
#pragma unroll
    for (int n = 0; n < 2; ++n) L.u0[n] = *(const uint2*)(GU0 + (eb * 64 + (g * 2 + n) * 16 + fr) * 64 + mt * 16 + fq * 4);
    const f32x4 e4 = *(const f32x4*)(GSC + mt * 16 + fq * 4);
    L.ebl[0] = e4[0]; L.ebl[1] = e4[1]; L.ebl[2] = e4[2]; L.ebl[3] = e4[3]; L.ebL = GSC[64];
}
DEVI void gdn_seq(const Params& p, int role, char* smem) {
    const int tid = threadIdx.x, lane0 = tid & 63, w0 = tid >> 6;
    const int b = role >> 4, h = (role >> 1) & 7, eb = role & 1;
    u16* Sts = (u16*)smem;
    u16* Uts = Sts + 64 * 136;
    for (int i = tid; i < 64 * 136 / 2; i += NTHR) ((unsigned*)Sts)[i] = 0u;
    u16* hbuf = (u16*)(p.ws + WS_HBUF);
    f32x4 accSt[4];
#pragma unroll
    for (int m = 0; m < 4; ++m) accSt[m] = (f32x4){0.f, 0.f, 0.f, 0.f};
    const int ubase = (b * 8 + h) * 32;
    GdnLd L;
    gdn_load(L, p, ubase, eb, w0, w0 & 3, w0 >> 2, lane0 & 15, lane0 >> 4);
    __syncthreads();
    for (int c = 0; c < 32; ++c) {
        int lane = lane0, w = w0; asm volatile("" : "+v"(lane), "+v"(w));
        const int fr = lane & 15, fq = lane >> 4, mt = w & 3, g = w >> 2;
        const long row0 = (long)b * 2048 + c * 64;
        f32x4 aWS[2], accO[2];
        aWS[0] = aWS[1] = accO[0] = accO[1] = (f32x4){0.f, 0.f, 0.f, 0.f};
#pragma unroll
        for (int kk = 0; kk < 4; ++kk)
#pragma unroll
            for (int n = 0; n < 2; ++n) { const bf16x8 bS = *(const bf16x8*)(Sts + ((g * 2 + n) * 16 + fr) * 136 + kk * 32 + fq * 8);
                aWS[n] = mfma16(L.fW[kk], bS, aWS[n]); accO[n] = mfma16(L.fQ[kk], bS, accO[n]); }
#pragma unroll
        for (int n = 0; n < 2; ++n) {
            const float u0 = __uint_as_float(L.u0[n].x << 16), u1 = __uint_as_float(L.u0[n].x & 0xFFFF0000u);
            const float u2 = __uint_as_float(L.u0[n].y << 16), u3 = __uint_as_float(L.u0[n].y & 0xFFFF0000u);
            uint2 pu; pu.x = pack2(u0 - aWS[n][0], u1 - aWS[n][1]); pu.y = pack2(u2 - aWS[n][2], u3 - aWS[n][3]);
            *(uint2*)(Uts + ((g * 2 + n) * 16 + fr) * 72 + mt * 16 + fq * 4) = pu;
#pragma unroll
            for (int j = 0; j < 4; ++j) accO[n][j] *= L.ebl[j]; }
        const bf16x8 fP0 = L.fP[0], fP1 = L.fP[1], fK0 = L.fKw[0], fK1 = L.fKw[1]; const float ebL = L.ebL;
        __syncthreads();
        if (c + 1 < 32) gdn_load(L, p, ubase + c + 1, eb, w, mt, g, fr, fq);
#pragma unroll
        for (int n = 0; n < 2; ++n) {
            accO[n] = mfma16(fP0, *(const bf16x8*)(Uts + ((g * 2 + n) * 16 + fr) * 72 + fq * 8), accO[n]);
            accO[n] = mfma16(fP1, *(const bf16x8*)(Uts + ((g * 2 + n) * 16 + fr) * 72 + 32 + fq * 8), accO[n]); }
#pragma unroll
        for (int n = 0; n < 2; ++n)
#pragma unroll
            for (int j = 0; j < 4; ++j) hbuf[(row0 + mt * 16 + fq * 4 + j) * DM + 1024 + h * 128 + eb * 64 + (g * 2 + n) * 16 + fr] = f2bf(accO[n][j]);
#pragma unroll
        for (int m = 0; m < 4; ++m) { accSt[m] *= ebL;
            accSt[m] = mfma16(fK0, *(const bf16x8*)(Uts + (m * 16 + fr) * 72 + fq * 8), accSt[m]);
            accSt[m] = mfma16(fK1, *(const bf16x8*)(Uts + (m * 16 + fr) * 72 + 32 + fq * 8), accSt[m]);
            uint2 ps; ps.x = pack2(accSt[m][0], accSt[m][1]); ps.y = pack2(accSt[m][2], accSt[m][3]);
            *(uint2*)(Sts + (m * 16 + fr) * 136 + w * 16 + fq * 4) = ps; }
        __syncthreads();
    }
    const int lane = lane0, w = w0, fr = lane & 15, fq = lane >> 4;
    float* pS = p.out + O_PS + (size_t)(b * 8 + h) * 16384;
#pragma unroll
    for (int m = 0; m < 4; ++m)
#pragma unroll
        for (int j = 0; j < 4; ++j) pS[(size_t)(w * 16 + fq * 4 + j) * 128 + eb * 64 + m * 16 + fr] = accSt[m][j];
    __syncthreads();
}

DEVI void mlstm_sample(const Params& p, int item, char* smem) {
    int tid = threadIdx.x; asm volatile("" : "+v"(tid));
    const int lane = tid & 63, w = tid >> 6;
    const int bs = item >> 2, h = item & 3;
    float* qs = (float*)smem; float* ks = qs + 1024; float* vs = ks + 1024; float* red = vs + 1024; float* num = red + 8192; float* sc = num + 1024; float* sc2 = sc + 32;
    const float* proj = (const float*)(p.ws + WS_PROJ); const float* gates = (const float*)(p.ws + WS_GATES); u16* mix = (u16*)(p.ws + WS_MIX);
    const size_t row0 = NPT + (size_t)bs * 4;
    for (int i = tid; i < 3072; i += NTHR) { const int which = i >> 10, t = (i >> 8) & 3, d = i & 255;
        float v = proj[(row0 + t) * PLD + which * 1024 + h * 256 + d]; if (which == 1) v *= 0.0625f; qs[i] = v; }
    float m = p.st_m[bs * 4 + h]; float fw[4], iw[4], flo[4];
    const float ib = p.m_i_bias[h], fb = p.m_f_bias[h];
#pragma unroll
    for (int t = 0; t < 4; ++t) { const float iv = gates[(row0 + t) * 24 + h] + ib; const float lf = logsigf_(gates[(row0 + t) * 24 + 4 + h] + fb);
        const float mn = fmaxf(lf + m, iv); fw[t] = __expf(lf + m - mn); iw[t] = __expf(iv - mn); flo[t] = __expf(-mn); m = mn; }
    __syncthreads();
    float qn[4] = {0.f, 0.f, 0.f, 0.f};
    if (tid < 256) { float n = p.st_n[(bs * 4 + h) * 256 + tid];
#pragma unroll
        for (int t = 0; t < 4; ++t) { n = fw[t] * n + iw[t] * ks[t * 256 + tid]; qn[t] = qs[t * 256 + tid] * n; }
        p.out[O_SN + (bs * 4 + h) * 256 + tid] = n; }
#pragma unroll
    for (int t = 0; t < 4; ++t) { const float r = wsum(qn[t]); if (lane == 0) sc[w * 4 + t] = r; }
    const float* Cin = p.st_C + (size_t)(bs * 4 + h) * 65536; float* Cout = p.out + O_SC + (size_t)(bs * 4 + h) * 65536;
    f32x4 pn[4];
#pragma unroll
    for (int t = 0; t < 4; ++t) pn[t] = (f32x4){0.f, 0.f, 0.f, 0.f};
#pragma unroll 1
    for (int hf = 0; hf < 2; ++hf) {
        const int d0 = w * 32 + hf * 16;
        f32x4 Cr[16];
#pragma unroll
        for (int i = 0; i < 16; ++i) Cr[i] = __builtin_nontemporal_load((const f32x4*)(Cin + (size_t)(d0 + i) * 256 + lane * 4));
#pragma unroll
        for (int t = 0; t < 4; ++t) { const f32x4 vt = *(const f32x4*)(vs + t * 256 + lane * 4) * iw[t]; f32x4 a = pn[t];
#pragma unroll
            for (int i = 0; i < 16; ++i) { Cr[i] = fw[t] * Cr[i] + ks[t * 256 + d0 + i] * vt; a += qs[t * 256 + d0 + i] * Cr[i]; }
            pn[t] = a; }
#pragma unroll
        for (int i = 0; i < 16; ++i) __builtin_nontemporal_store(Cr[i], (f32x4*)(Cout + (size_t)(d0 + i) * 256 + lane * 4));
    }
#pragma unroll
    for (int t = 0; t < 4; ++t) *(f32x4*)(red + (t * 8 + w) * 256 + lane * 4) = pn[t];
    __syncthreads();
    for (int o = tid; o < 1024; o += NTHR) { const int t = o >> 8, e = o & 255; float sacc = 0.f;
#pragma unroll
        for (int g = 0; g < 8; ++g) sacc += red[(t * 8 + g) * 256 + e];
        num[t * 256 + e] = sacc; }
    __syncthreads();
    float hv[4];
    if (tid < 256) {
#pragma unroll
        for (int t = 0; t < 4; ++t) { float den = 0.f;
#pragma unroll
            for (int g = 0; g < 8; ++g) den += sc[g * 4 + t];
            hv[t] = num[t * 256 + tid] / fmaxf(fabsf(den), flo[t]);
            const float r = wsum(hv[t] * hv[t]); if (lane == 0) sc2[w * 4 + t] = r; }
    }
    __syncthreads();
    if (tid < 256) {
#pragma unroll
        for (int t = 0; t < 4; ++t) { const float ss = sc2[t] + sc2[4 + t] + sc2[8 + t] + sc2[12 + t]; const float rs = rsqrtf(ss * (1.f / 256.f) + 1e-6f);
            const float mo = proj[(row0 + t) * PLD + 3072 + h * 256 + tid];
            mix[(row0 + t) * DM + h * 256 + tid] = f2bf(hv[t] * rs * p.m_norm_g[h * 256 + tid] * sigmoidf_(mo)); }
    }
    if (tid == 0) p.out[O_SM + bs * 4 + h] = m;
    __syncthreads();
}

DEVI void gdn_sample(const Params& p, int item, char* smem) {
    int tid = threadIdx.x; asm volatile("" : "+v"(tid));
    const int lane = tid & 63, w = tid >> 6;
    const int bs = item >> 3, h = item & 7;
    float* qkv = (float*)smem;
    float* red = qkv + 1536;
    float* ored = red + 1024;
    float* sc = ored + 2048;
    const float* proj = (const float*)(p.ws + WS_PROJ); const float* gates = (const float*)(p.ws + WS_GATES); u16* mix = (u16*)(p.ws + WS_MIX);
    const size_t row0 = NPT + (size_t)bs * 4;
    if (tid < 384) { const int which = tid >> 7, dch = tid & 127, ch = which * 1024 + h * 128 + dch;
        float xp[7];
#pragma unroll
        for (int j = 0; j < 3; ++j) xp[j] = p.st_conv[(size_t)(bs * 3 + j) * 3072 + ch];
#pragma unroll
        for (int t = 0; t < 4; ++t) xp[3 + t] = proj[(row0 + t) * PLD + 4096 + ch];
        float cw[4];
#pragma unroll
        for (int j = 0; j < 4; ++j) cw[j] = p.conv_w[j * 3072 + ch];
#pragma unroll
        for (int t = 0; t < 4; ++t) qkv[(which * 4 + t) * 128 + dch] = siluf_(cw[0] * xp[t] + cw[1] * xp[t + 1] + cw[2] * xp[t + 2] + cw[3] * xp[t + 3]); }
    float at[4], be[4];
    { const float dtb = p.g_dt_bias[h], Aexp = __expf(p.g_A_log[h]);
#pragma unroll
        for (int t = 0; t < 4; ++t) { at[t] = __expf(-Aexp * softplusf_(gates[(row0 + t) * 24 + 16 + h] + dtb)); be[t] = sigmoidf_(gates[(row0 + t) * 24 + 8 + h]); } }
    __syncthreads();
    { const int which = w >> 2, t = w & 3; float* a = qkv + (which * 4 + t) * 128; const float v0 = a[lane * 2], v1 = a[lane * 2 + 1];
        const float sc_ = rsqrtf(wsum(v0 * v0 + v1 * v1) + 1e-6f) * (which == 0 ? 0.08838834764831845f : 1.f);
        a[lane * 2] = v0 * sc_; a[lane * 2 + 1] = v1 * sc_; }
    __syncthreads();
    const float* qf = qkv; const float* kf = qkv + 512; const float* vf = qkv + 1024;
    const int e = tid & 127, dg = tid >> 7;
    const float* Sin = p.st_S + (size_t)(bs * 8 + h) * 16384; float* Sout = p.out + O_SS + (size_t)(bs * 8 + h) * 16384;
    float Sr[32];
#pragma unroll
    for (int i = 0; i < 32; ++i) Sr[i] = __builtin_nontemporal_load(Sin + (dg * 32 + i) * 128 + e);
#pragma unroll
    for (int t = 0; t < 4; ++t) {
        float r = 0.f;
#pragma unroll
        for (int i = 0; i < 32; ++i) r += kf[t * 128 + dg * 32 + i] * Sr[i];
        red[((t & 1) * 4 + dg) * 128 + e] = r;
        __syncthreads();
        const float rr = red[((t & 1) * 4 + 0) * 128 + e] + red[((t & 1) * 4 + 1) * 128 + e] + red[((t & 1) * 4 + 2) * 128 + e] + red[((t & 1) * 4 + 3) * 128 + e];
        const float u = be[t] * (vf[t * 128 + e] - at[t] * rr);
        float po = 0.f;
#pragma unroll
        for (int i = 0; i < 32; ++i) { Sr[i] = at[t] * Sr[i] + kf[t * 128 + dg * 32 + i] * u; po += qf[t * 128 + dg * 32 + i] * Sr[i]; }
        ored[(t * 4 + dg) * 128 + e] = po;
    }
#pragma unroll
    for (int i = 0; i < 32; ++i) __builtin_nontemporal_store(Sr[i], Sout + (dg * 32 + i) * 128 + e);
    __syncthreads();
    float ov[4];
    if (tid < 128) {
#pragma unroll
        for (int t = 0; t < 4; ++t) { ov[t] = ored[(t * 4 + 0) * 128 + tid] + ored[(t * 4 + 1) * 128 + tid] + ored[(t * 4 + 2) * 128 + tid] + ored[(t * 4 + 3) * 128 + tid];
            const float r = wsum(ov[t] * ov[t]); if (lane == 0) sc[w * 4 + t] = r; }
    }
    __syncthreads();
    if (tid < 128) {
#pragma unroll
        for (int t = 0; t < 4; ++t) { const float rs = rsqrtf((sc[t] + sc[4 + t]) * (1.f / 128.f) + 1e-6f);
            const float gz = proj[(row0 + t) * PLD + 7168 + h * 128 + tid];
            mix[(row0 + t) * DM + 1024 + h * 128 + tid] = f2bf(ov[t] * rs * p.g_norm_g[h * 128 + tid] * siluf_(gz)); }
    }
    __syncthreads();
}

#ifndef SCM
#define SCM 15
#endif
DEVI void phase_scan(const Params& p, char* smem) {
    const int G = gridDim.x, bid = blockIdx.x;
    if (G >= 192) {
        if (bid < 64) { if (SCM & 1) mlstm_seq(p, bid, smem); }
        else if (bid < 128) { if (SCM & 2) gdn_seq(p, bid - 64, smem); }
        unsigned* q = (unsigned*)(p.ws + WS_BAR) + 64;
        volatile unsigned* lq = (volatile unsigned*)(smem + LDS_BYTES - 32);
        for (;;) {
            __syncthreads();
            if (threadIdx.x == 0) *lq = __hip_atomic_fetch_add(q, 1u, __ATOMIC_RELAXED, __HIP_MEMORY_SCOPE_AGENT);
            __syncthreads();
            const unsigned u = *lq;
            if (u >= 1536u) break;
            if (u < 512u) mlstm_sample(p, (int)u, smem); else gdn_sample(p, (int)u - 512, smem);
        }
        pop_late(p, smem, 1 << 30);
        if (p.ph_hi - p.ph_lo == 1) pop_late(p, smem, 1 << 30, 1);
    } else {
        for (int u = bid; u < 128 + 512 + 1024; u += G) {
            if (u < 64) { if (SCM & 1) mlstm_seq(p, u, smem); } else if (u < 128) { if (SCM & 2) gdn_seq(p, u - 64, smem); }
            else if (u < 640) { if (SCM & 4) mlstm_sample(p, u - 128, smem); } else { if (SCM & 8) gdn_sample(p, u - 640, smem); } }
        pop_late(p, smem, 1 << 30);
    }
}

#define XB_TMO      128
#define XB_XCNT(j)  (256  + 64 * (j))
#define XB_XSUB(j)  (1280 + 64 * (j))
#define XB_XGEN(j)  (2304 + 64 * (j))
#define XB_TOP      3328
#define XB_TOPGEN   3392
#define XCD_BAR_WORDS 3456
#define XB_SPIN_CAP (1u << 18)
#define LAS __attribute__((address_space(3)))

__device__ __forceinline__ unsigned xb_ld(unsigned* p)              { return __hip_atomic_load(p, __ATOMIC_RELAXED, __HIP_MEMORY_SCOPE_AGENT); }
__device__ __forceinline__ unsigned xb_add(unsigned* p, unsigned v) { return __hip_atomic_fetch_add(p, v, __ATOMIC_RELAXED, __HIP_MEMORY_SCOPE_AGENT); }
__device__ __forceinline__ unsigned xb_xcc_id() { return (unsigned)__builtin_amdgcn_s_getreg((3 << 11) | 20) & 0xFu; }
#define XB_SPIN(cond, bar) do { unsigned _sp = 0; while (cond) { __builtin_amdgcn_s_sleep(1); \
    if ((++_sp & 255u) == 0u) { if (xb_ld(&(bar)[XB_TMO])) break; if (_sp > XB_SPIN_CAP) { atomicAdd(&(bar)[XB_TMO], 1u); break; } } } } while (0)

struct XcdBarrier {
    unsigned* bar; unsigned x;
    volatile LAS unsigned* st;
};

__device__ __forceinline__ XcdBarrier xcd_barrier_post(unsigned* bar, volatile LAS unsigned* st) {
    XcdBarrier b; b.bar = bar; b.x = xb_xcc_id(); b.st = st;
    if (threadIdx.x == 0) (void)xb_add(&bar[XB_XCNT(b.x)], 1u);
    return b;
}
__device__ __forceinline__ void xcd_barrier_complete(unsigned* bar, unsigned x, unsigned& nloc, unsigned& nx) {
    const unsigned G = gridDim.x * gridDim.y * gridDim.z;
    unsigned sum, cnt, mine, sp = 0u;
    for (;;) {
        sum = 0u; cnt = 0u; mine = 0u;
#pragma unroll
        for (unsigned j = 0; j < 16; ++j) { const unsigned c = xb_ld(&bar[XB_XCNT(j)]); sum += c; cnt += (c > 0u) ? 1u : 0u; mine = (j == x) ? c : mine; }
        if (sum == G) break;
        __builtin_amdgcn_s_sleep(1);
        if ((++sp & 255u) == 0u) { if (xb_ld(&bar[XB_TMO])) break; if (sp > XB_SPIN_CAP) { atomicAdd(&bar[XB_TMO], 1u); break; } }
    }
    nloc = mine > 0u ? mine : 1u; nx = cnt > 0u ? cnt : 1u;
}

__device__ __forceinline__ void xcd_barrier(const XcdBarrier& b) {
    asm volatile("s_waitcnt vmcnt(0)" ::: "memory");
    __syncthreads();
    if (threadIdx.x == 0) {
        unsigned* bar = b.bar;
        __builtin_amdgcn_s_waitcnt(0);
        unsigned nloc = b.st[0], nx = b.st[1];
        if (nloc == 0u) { xcd_barrier_complete(bar, b.x, nloc, nx); b.st[0] = nloc; b.st[1] = nx; }
        const unsigned old = xb_add(&bar[XB_XSUB(b.x)], 1u);
        const unsigned gen = old / nloc;
        if (old + 1u == (gen + 1u) * nloc) {
            __builtin_amdgcn_fence(__ATOMIC_RELEASE, "agent");
            asm volatile("s_waitcnt vmcnt(0)" ::: "memory");
            const unsigned og = xb_add(&bar[XB_TOP], 1u);
            const unsigned tg = og / nx;
            if (og + 1u == (tg + 1u) * nx) xb_add(&bar[XB_TOPGEN], 1u);
            else XB_SPIN(xb_ld(&bar[XB_TOPGEN]) == tg, bar);
            __builtin_amdgcn_fence(__ATOMIC_ACQUIRE, "agent");
            xb_add(&bar[XB_XGEN(b.x)], 1u);
            asm volatile("s_waitcnt vmcnt(0)" ::: "memory");
        } else {
            XB_SPIN(xb_ld(&bar[XB_XGEN(b.x)]) == gen, bar);
            __builtin_amdgcn_fence(__ATOMIC_ACQUIRE, "agent");
            asm volatile("s_waitcnt vmcnt(0)" ::: "memory");
        }
    }
    __syncthreads();
}

__global__ void __launch_bounds__(NTHR) fwd_kernel(Params p) {
    extern __shared__ __attribute__((aligned(16))) char smem[];
    cg::grid_group grid = cg::this_grid();
    const int lo = p.ph_lo, hi = p.ph_hi;
    if (lo == 777) grid.sync();
    volatile LAS unsigned* xst = (volatile LAS unsigned*)(smem + LDS_BYTES - 16);
    if (threadIdx.x < 2) xst[threadIdx.x] = 0u;
    __syncthreads();
    XcdBarrier xbar; xbar.bar = (unsigned*)(p.ws + WS_BAR); xbar.x = 0; xbar.st = xst;
    if (hi - lo > 1) xbar = xcd_barrier_post((unsigned*)(p.ws + WS_BAR), xst);
#ifndef PHMASK
#define PHMASK 0xFFFF
#endif
#define PHASE(k) if (((PHMASK >> (k)) & 1) && lo <= (k) && (k) < hi)
#define SEAM(k) if (lo <= (k) && (k) + 1 < hi) xcd_barrier(xbar)
    PHASE(0) phase_prep(p, smem);
    SEAM(0);
    PHASE(2) phase_modulate(p);
    SEAM(2);
    PHASE(3) { PEpiProj e{(float*)(p.ws + WS_PROJ), (float*)(p.ws + WS_GATES)}; pg8_run((const u16*)(p.ws + WS_AH), (const u16*)(p.ws + WS_WIN), NTOK, 8448, DM, smem, e);
        if (hi - lo > 1 && 4 * (int)gridDim.x + (int)blockIdx.x >= 34 * 33) pop_late(p, smem, 9); }
    SEAM(3);
    PHASE(4) { for (int u = blockIdx.x; u < 1536; u += gridDim.x) { if (u < 512) mlstm_pre(p, u, smem); else gdn_pre(p, u - 512, smem); } }
    SEAM(4);
    PHASE(5) phase_scan(p, smem);
    SEAM(5);
    PHASE(6) phase_post(p);
    SEAM(6);
    PHASE(7) { PEpiRes e{p.x_prompt, p.x_sample, nullptr, (const float*)(p.ws + WS_ADA), 2 * DM, (float*)(p.ws + WS_X1), (float*)(p.ws + WS_PART), DM / 8};
        pg8_run_split((const u16*)(p.ws + WS_MIX), (const u16*)(p.ws + WS_WOUT), DM, DM, 8, smem, e);
        if (hi - lo > 1 && blockIdx.x >= 128) pop_late(p, smem, 2, 1); }
    SEAM(7);
    PHASE(8) phase_ln1(p);
    SEAM(8);
    PHASE(9) { PEpiGU e{(u16*)(p.ws + WS_ACT)}; pg8_run((const u16*)(p.ws + WS_AH), (const u16*)(p.ws + WS_WGU), NTOK, 2 * DFF, DM, smem, e);
        if (hi - lo > 1) { if (5 * (int)gridDim.x + (int)blockIdx.x >= 34 * 44) pop_late(p, smem, 9, 1); pop_late(p, smem, 1 << 30, 1); } }
    SEAM(9);
    PHASE(10) { PEpiRes e{p.x_prompt, p.x_sample, (const float*)(p.ws + WS_X1), (const float*)(p.ws + WS_ADA), 5 * DM, p.out + O_YP, (float*)(p.ws + WS_PART), DFF / 11};
        pg8_run_split((const u16*)(p.ws + WS_ACT), (const u16*)(p.ws + WS_WDOWN), DM, DFF, 11, smem, e); }
    SEAM(10);
    PHASE(11) phase_ln2(p);
}

extern "C" void kernel_launch(void* const* d_in, const int* in_sizes, int n_in, void* d_out, int out_size, void* d_ws, size_t ws_size,
                              hipStream_t stream) {
    static int grid = 0;
    if (grid == 0) {
        if (n_in != 26 || ws_size < WS_END) { fprintf(stderr, "kernel_launch: unexpected n_in %d / ws_size %zu\n", n_in, ws_size); grid = -1; return; }
        int dev = 0, cus = 0, per_cu = 0;
        hipGetDevice(&dev);
        hipDeviceGetAttribute(&cus, hipDeviceAttributeMultiprocessorCount, dev);
        hipFuncSetAttribute((const void*)fwd_kernel, hipFuncAttributeMaxDynamicSharedMemorySize, LDS_BYTES);
        hipOccupancyMaxActiveBlocksPerMultiprocessor(&per_cu, (const void*)fwd_kernel, NTHR, LDS_BYTES);
        if (per_cu < 1) { fprintf(stderr, "kernel_launch: occupancy query says %d blocks/CU\n", per_cu); grid = -1; return; }
        grid = cus * per_cu;
    }
    if (grid < 0) return;
    Params p{};
    const float** f = (const float**)&p;
    for (int i = 0; i < 26; ++i) f[i] = (const float*)d_in[i];
    p.out = (float*)d_out; p.ws = (unsigned char*)d_ws;
    hipMemsetAsync((char*)d_ws + WS_BAR, 0, XCD_BAR_WORDS * 4, stream);
#if FUSED
    p.ph_lo = 0; p.ph_hi = 12;
    void* args[] = {&p};
    hipError_t e = hipLaunchCooperativeKernel((const void*)fwd_kernel, dim3(grid), dim3(NTHR), args, LDS_BYTES, stream);
    if (e != hipSuccess) fprintf(stderr, "cooperative launch failed: %s (grid %d)\n", hipGetErrorString(e), grid);
#else
    for (int ph = 0; ph < 12; ++ph) { p.ph_lo = ph; p.ph_hi = ph + 1; hipLaunchKernelGGL(fwd_kernel, dim3(grid), dim3(NTHR), LDS_BYTES, stream, p); }
#endif
}
```

```cpp
#include <hip/hip_runtime.h>
#include <hip/hip_cooperative_groups.h>
#include <cstdio>
namespace cg = cooperative_groups;

#ifndef FUSED
#define FUSED 1
#endif

#define DEVI __device__ __forceinline__
typedef unsigned short u16;
typedef short bf16x8 __attribute__((ext_vector_type(8)));
typedef float f32x4 __attribute__((ext_vector_type(4)));

constexpr int NTHR = 512;
constexpr int DM = 2048, NTOK = 8704, NPT = 8192, INC = 8216, PLD = 8192, DFF = 5632, ADAW = 12288;
constexpr int LDS_BYTES = 158 * 1024;
constexpr float ALPHA = 1.189207115002721f;

constexpr size_t O_YP = 0, O_PC = 17825792, O_PN = 18874368, O_PM = 18878464, O_PS = 18878480, O_PCONV = 19402768,
                 O_SC = 19439632, O_SN = 52994064, O_SM = 53125136, O_SS = 53125648, O_SCONV = 69902864;
constexpr size_t WS_WOUT = 0, WS_WGU = 8388608, WS_WDOWN = 54525952, WS_ADA = 77594624, WS_AC = 84082688,
                 WS_WIN = 85131264, WS_WADA = 119734272, WS_HBUF = WS_WIN, WS_AH = 170065920, WS_MIX = 205717504,
                 WS_PROJ = 241369088, WS_X1 = 85131264  , WS_ACT = WS_PROJ + 71303168, WS_GATES = 527417344, WS_GQ = 152240128, WS_GW = 169017344, WS_GP = 185794560, WS_GSC = 194183168,
                 WS_GU0 = 528252928, WS_GKW = 545030144, WS_MKT = 561807360, WS_MVT = 578584576,
                 WS_PART = 528252928  , WS_MP = 194510848, WS_MSC = 198705152, WS_MQ = 118685696, WS_BAR = 595361792, WS_END = 595378176;

struct Params {
    const float* x_prompt; const float* x_sample; const float* st_C; const float* st_n; const float* st_m; const float* st_S;
    const float* st_conv; const float* c_prompt; const float* c_sample; const float* w_ada; const float* b_ada; const float* w_in;
    const float* m_i_bias; const float* m_f_bias; const float* m_norm_g; const float* conv_w; const float* g_dt_bias;
    const float* g_A_log; const float* g_norm_g; const float* w_out; const float* ln1_g; const float* ln1_b; const float* w_gu;
    const float* w_down; const float* ln2_g; const float* ln2_b;
    float* out; unsigned char* ws;
    int ph_lo, ph_hi;
};

typedef float f32x2_t __attribute__((ext_vector_type(2)));
typedef __bf16 bf16x2_t __attribute__((ext_vector_type(2)));
DEVI unsigned pack2(float a, float b) { const f32x2_t v = {a, b}; const bf16x2_t r = __builtin_convertvector(v, bf16x2_t); return __builtin_bit_cast(unsigned, r); }
DEVI u16 f2bf(float f) { const __bf16 r = (__bf16)f; return __builtin_bit_cast(u16, r); }
DEVI float bf2f(u16 b) { return __uint_as_float(((unsigned)b) << 16); }
DEVI float wsum(float v) { for (int o = 32; o; o >>= 1) v += __shfl_xor(v, o); return v; }
DEVI float sigmoidf_(float x) { return 1.f / (1.f + __expf(-x)); }
DEVI float siluf_(float x) { return x / (1.f + __expf(-x)); }
DEVI float softplusf_(float x) { return fmaxf(x, 0.f) + log1pf(__expf(-fabsf(x))); }
DEVI float logsigf_(float x) { return fminf(x, 0.f) - log1pf(__expf(-fabsf(x))); }
DEVI f32x4 mfma16(bf16x8 a, bf16x8 b, f32x4 c) { return __builtin_amdgcn_mfma_f32_16x16x32_bf16(a, b, c, 0, 0, 0); }
DEVI int tok_batch(int row) { return row < NPT ? (row >> 11) : 4 + ((row - NPT) >> 2); }
DEVI const float* x_row(const Params& p, int row) { return row < NPT ? p.x_prompt + (size_t)row * DM : p.x_sample + (size_t)(row - NPT) * DM; }

template <int MT, int NT>
DEVI void mma_lds(f32x4 (&acc)[MT][NT], const u16* A, int lda, const u16* B, int ldb, int K, int fr, int fq) {
    for (int k = 0; k < K; k += 32) {
        bf16x8 a[MT], b[NT];
#pragma unroll
        for (int m = 0; m < MT; ++m) a[m] = *(const bf16x8*)(A + (m * 16 + fr) * lda + k + fq * 8);
#pragma unroll
        for (int n = 0; n < NT; ++n) b[n] = *(const bf16x8*)(B + (n * 16 + fr) * ldb + k + fq * 8);
#pragma unroll
        for (int m = 0; m < MT; ++m)
#pragma unroll
            for (int n = 0; n < NT; ++n) acc[m][n] = mfma16(a[m], b[n], acc[m][n]);
    }
}

namespace pg8 {
#define PG8_LAS __attribute__((address_space(3)))
typedef unsigned short bf16_t;
typedef short bf16x8 __attribute__((ext_vector_type(8)));
typedef float f32x4 __attribute__((ext_vector_type(4)));
typedef unsigned u32x4 __attribute__((ext_vector_type(4)));
constexpr int BM = 256, BK = 64, HALF = 128, HTB = HALF * BK * 2  , STAGE_BYTES = 8 * HTB, NXCD = 8, WGM = 8;

__host__ __device__ __forceinline__ int lds_byte(int r, int c) { const int st = (r >> 4) * 2 + (c >> 5), rr = r & 15, cc = c & 31, ob = rr * 64 + cc * 2; return st * 1024 + (ob ^ (((ob >> 9) & 1) << 5)); }
__host__ __device__ __forceinline__ void stage_rc(int b, int& R, int& C) { const int st = b / 1024, sb = b % 1024, swz = sb ^ (((sb >> 9) & 1) << 5); R = (st >> 1) * 16 + swz / 64; C = (st & 1) * 32 + (swz % 64) / 2; }
__host__ __device__ __forceinline__ int perm32(int rho) { const int n = rho >> 4, i = rho & 15; return 8 * (i >> 2) + 4 * n + (i & 3); }

struct Unit { int pm, pn, k0, nt; };
struct Gemm { const bf16_t* A; const bf16_t* Bt; int M, N, K; };

struct StaticOrder {
    int nM, nN, nwg, G, c, Kt;
    __host__ __device__ void init(int M, int N, int G_, int c_, int K_ = 0) { nM = M / BM; nN = N / BM; nwg = nM * nN; G = G_; c = c_; Kt = K_ / BK; }
    __host__ __device__ bool next(int i, Unit& u) const {
        const long L = (long)i * G + c; if (L >= nwg) return false;
        int wgid = (int)L; { const int q = nwg / NXCD, r = nwg % NXCD, xcd = wgid % NXCD, off = wgid / NXCD; wgid = (xcd < r ? xcd * (q + 1) : r * (q + 1) + (xcd - r) * q) + off; }
        const int nig = WGM * nN, gid = wgid / nig, fm = gid * WGM, gsz = (nM - fm) < WGM ? (nM - fm) : WGM;
        u.pm = fm + ((wgid % nig) % gsz); u.pn = (wgid % nig) / gsz; u.k0 = 0; u.nt = Kt; return true;
    }
    __device__ __forceinline__ void a_ready(const Unit&) const {}
    __device__ __forceinline__ void done(const Unit&) const {}
};
__device__ __forceinline__ unsigned cvt_pk_bf16(float lo, float hi) { unsigned r; asm volatile("v_cvt_pk_bf16_f32 %0, %1, %2" : "=v"(r) : "v"(lo), "v"(hi)); return r; }
template <class Epi, class Sched, bool STAMP = false>
__device__ __forceinline__ void gemm_phase(PG8_LAS unsigned char* lds, const Gemm g, const Sched& S, const Epi& E, unsigned long long* stamps) {
    const int tid = threadIdx.x, wid = __builtin_amdgcn_readfirstlane(tid >> 6), lane = tid & 63, wr = wid >> 2, wc = wid & 3, fr = lane & 15, fq = lane >> 4;
    const int K = g.K;
    int ts_lo = 0, ts_hi = 0, nts = 0; const unsigned long long rt_entry = STAMP ? (unsigned long long)wall_clock64() : 0ull;
#define PG8_STAMP() do { if (STAMP && wid == 0 && nts < 64) { const unsigned long long _c = (unsigned long long)clock64(); \
        ts_lo = (lane == nts) ? (int)(unsigned)_c : ts_lo; ts_hi = (lane == nts) ? (int)(unsigned)(_c >> 32) : ts_hi; ++nts; } } while (0)
    PG8_STAMP();
    unsigned voffA[2], voffB[2];
#pragma unroll
    for (int i = 0; i < 2; ++i) { int R, C; stage_rc(tid * 16 + i * 8192, R, C); const int Rb = Epi::PERM ? ((R & ~31) + perm32(R & 31)) : R;
        voffA[i] = (unsigned)(R * K + C) * 2u; voffB[i] = (unsigned)(Rb * K + C) * 2u; }
    const size_t kstep = (size_t)(BK * 2);
    const size_t hstep = (size_t)HALF * K * 2;
    const size_t tstep = 2 * hstep;
    const unsigned ldsw = (unsigned)wid * 1024u;
    const int aoff = lds_byte(wr * 64 + fr, fq * 8), boff = lds_byte(wc * 32 + fr, fq * 8);
#define PG8_SA(b, h) (((b) * 2 + (h)) * HTB)
#define PG8_SB(b, h) ((4 + (b) * 2 + (h)) * HTB)
#define PG8_STAGE(bufoff, gbase, voff) do { _Pragma("unroll") for (int _i = 0; _i < 2; ++_i) \
        __builtin_amdgcn_global_load_lds((const unsigned*)((const char*)(gbase) + (voff)[_i]), (PG8_LAS unsigned*)(lds + (bufoff) + ldsw + _i * 8192), 16, 0, 0); } while (0)
#define PG8_LDA(dst, b, h) do { _Pragma("unroll") for (int m = 0; m < 4; ++m) _Pragma("unroll") for (int k = 0; k < 2; ++k) dst[m][k] = *(const PG8_LAS bf16x8*)(lds + PG8_SA(b, h) + aoff + m * 2048 + k * 1024); } while (0)
#define PG8_LDB(dst, b, h) do { _Pragma("unroll") for (int n = 0; n < 2; ++n) _Pragma("unroll") for (int k = 0; k < 2; ++k) dst[n][k] = *(const PG8_LAS bf16x8*)(lds + PG8_SB(b, h) + boff + n * 2048 + k * 1024); } while (0)
#define PG8_MMA(ai, bj, At, Bt) do { __builtin_amdgcn_s_setprio(1); _Pragma("unroll") for (int m = 0; m < 4; ++m) _Pragma("unroll") for (int n = 0; n < 2; ++n) _Pragma("unroll") for (int k = 0; k < 2; ++k) \
        acc[ai][bj][m][n] = __builtin_amdgcn_mfma_f32_16x16x32_bf16(Bt[n][k], At[m][k], acc[ai][bj][m][n], 0, 0, 0); __builtin_amdgcn_s_setprio(0); } while (0)
#define PG8_WAIT_V(n) asm volatile("s_waitcnt vmcnt(" #n ")" ::: "memory")
#define PG8_WAIT_L(n) asm volatile("s_waitcnt lgkmcnt(" #n ")" ::: "memory")
#define PG8_BAR __builtin_amdgcn_s_barrier()
#define PG8_SCHED __builtin_amdgcn_sched_barrier(0)
    Unit cur, nxt; int ui = 0;
    if (!S.next(0, cur)) return;
    f32x4 acc[2][2][4][2];
#pragma unroll
    for (int a = 0; a < 2; ++a)
#pragma unroll
        for (int b = 0; b < 2; ++b)
#pragma unroll
            for (int m = 0; m < 4; ++m)
#pragma unroll
                for (int n = 0; n < 2; ++n) acc[a][b][m][n] = (f32x4){0.f, 0.f, 0.f, 0.f};
    bf16x8 At[4][2], B0[2][2], B1[2][2];
    const char* cA = (const char*)g.A + (size_t)cur.pm * tstep + (size_t)cur.k0 * 2; const char* cB = (const char*)g.Bt + (size_t)cur.pn * tstep + (size_t)cur.k0 * 2;
    S.a_ready(cur);
    PG8_STAGE(PG8_SB(0, 0), cB, voffB); PG8_STAGE(PG8_SA(0, 0), cA, voffA); PG8_STAGE(PG8_SB(0, 1), cB + hstep, voffB); PG8_STAGE(PG8_SA(0, 1), cA + hstep, voffA);
    if (wr == 1) PG8_BAR;
    PG8_WAIT_V(4); PG8_BAR;
    PG8_STAGE(PG8_SB(1, 0), cB + kstep, voffB); PG8_STAGE(PG8_SA(1, 0), cA + kstep, voffA); PG8_STAGE(PG8_SB(1, 1), cB + hstep + kstep, voffB);
    PG8_WAIT_V(6); PG8_BAR;
    PG8_STAMP();
    for (;;) {
        const bool has_next = S.next(ui + 1, nxt);
        const char* nA = has_next ? (const char*)g.A + (size_t)nxt.pm * tstep + (size_t)nxt.k0 * 2 : cA; const char* nB = has_next ? (const char*)g.Bt + (size_t)nxt.pn * tstep + (size_t)nxt.k0 * 2 : cB;
        const int nt = cur.nt;
        for (int t = 0; t < nt; t += 2) {
            const bool last = (t == nt - 2);
            const char* a1 = cA + (size_t)(t + 1) * kstep;
            const char* a2 = last ? nA : cA + (size_t)(t + 2) * kstep; const char* b2 = last ? nB : cB + (size_t)(t + 2) * kstep;
            const char* a3 = a2 + kstep; const char* b3 = b2 + kstep;
            if (last && has_next) S.a_ready(nxt);
            PG8_LDB(B0, 0, 0); PG8_SCHED; PG8_LDA(At, 0, 0); PG8_STAGE(PG8_SA(1, 1), a1 + hstep, voffA);
            PG8_WAIT_L(8); PG8_BAR; PG8_WAIT_L(0); PG8_MMA(0, 0, At, B0); PG8_BAR; PG8_SCHED;
            PG8_LDB(B1, 0, 1); PG8_STAGE(PG8_SB(0, 0), b2, voffB);
            PG8_BAR; PG8_WAIT_L(0); PG8_MMA(0, 1, At, B1); PG8_BAR;
            PG8_LDA(At, 0, 1); PG8_STAGE(PG8_SA(0, 0), a2, voffA);
            PG8_BAR; PG8_WAIT_L(0); PG8_MMA(1, 0, At, B0); PG8_BAR; PG8_SCHED;
            PG8_STAGE(PG8_SB(0, 1), b2 + hstep, voffB);
            PG8_WAIT_V(6); PG8_BAR; PG8_MMA(1, 1, At, B1); PG8_BAR;
            PG8_LDB(B0, 1, 0); PG8_SCHED; PG8_LDA(At, 1, 0); PG8_STAGE(PG8_SA(0, 1), a2 + hstep, voffA);
            PG8_WAIT_L(8); PG8_BAR; PG8_WAIT_L(0); PG8_MMA(0, 0, At, B0); PG8_BAR; PG8_SCHED;
            PG8_LDB(B1, 1, 1); PG8_STAGE(PG8_SB(1, 0), b3, voffB);
            PG8_BAR; PG8_WAIT_L(0); PG8_MMA(0, 1, At, B1); PG8_BAR;
            PG8_LDA(At, 1, 1); PG8_STAGE(PG8_SA(1, 0), a3, voffA);
            PG8_BAR; PG8_WAIT_L(0); PG8_MMA(1, 0, At, B0); PG8_BAR; PG8_SCHED;
            PG8_STAGE(PG8_SB(1, 1), b3 + hstep, voffB);
            PG8_WAIT_V(6); PG8_BAR; PG8_MMA(1, 1, At, B1); PG8_BAR;
        }
        PG8_STAMP();
        if constexpr (!Epi::AFTER_DRAIN) { E(acc, cur, wr, wc, fr, fq); S.done(cur); }
        PG8_STAMP();
        if (!has_next) break;
#pragma unroll
        for (int a = 0; a < 2; ++a)
#pragma unroll
            for (int b = 0; b < 2; ++b)
#pragma unroll
                for (int m = 0; m < 4; ++m)
#pragma unroll
                    for (int n = 0; n < 2; ++n) acc[a][b][m][n] = (f32x4){0.f, 0.f, 0.f, 0.f};
        cur = nxt; cA = nA; cB = nB; ++ui;
    }
    PG8_WAIT_V(0);
    if (wr == 0) PG8_BAR;
    PG8_BAR;
    if constexpr (Epi::AFTER_DRAIN) { E.fused(acc, cur, wr, wc, fr, fq, lds, wid, lane); S.done(cur); }
    PG8_STAMP();
    if (STAMP && wid == 0) { stamps[lane] = lane < nts ? (((unsigned long long)(unsigned)ts_hi << 32) | (unsigned)ts_lo) : 0ull;
        if (lane == 62) stamps[62] = rt_entry; if (lane == 63) stamps[63] = (unsigned long long)wall_clock64(); }
#undef PG8_STAMP
#undef PG8_SA
#undef PG8_SB
#undef PG8_STAGE
#undef PG8_LDA
#undef PG8_LDB
#undef PG8_MMA
#undef PG8_WAIT_V
#undef PG8_WAIT_L
#undef PG8_BAR
#undef PG8_SCHED
}
}

DEVI void transpose_tile4(const float* src, int ldsrc, int nvalid, int k0, int c00, int c01, int c02, int c03, u16* dst, int ldd, u16* t) {
    int tid = threadIdx.x; asm volatile("" : "+v"(tid));
    const int kr = tid >> 4, n4 = (tid & 15) * 4;
    float4 v[4][2];
#pragma unroll
    for (int q = 0; q < 4; ++q) { const int c0 = q == 0 ? c00 : q == 1 ? c01 : q == 2 ? c02 : c03;
#pragma unroll
        for (int i = 0; i < 2; ++i) { v[q][i] = make_float4(0.f, 0.f, 0.f, 0.f);
            if (c0 + n4 < nvalid) { const f32x4 t4 = __builtin_nontemporal_load((const f32x4*)(src + (size_t)(k0 + kr + 32 * i) * ldsrc + c0 + n4)); v[q][i] = make_float4(t4[0], t4[1], t4[2], t4[3]); } } }
#pragma unroll
    for (int q = 0; q < 4; ++q)
#pragma unroll
        for (int i = 0; i < 2; ++i) { const int k = kr + 32 * i; u16* tq = t + q * 64 * 72;
            tq[(n4 + 0) * 72 + k] = f2bf(v[q][i].x); tq[(n4 + 1) * 72 + k] = f2bf(v[q][i].y); tq[(n4 + 2) * 72 + k] = f2bf(v[q][i].z); tq[(n4 + 3) * 72 + k] = f2bf(v[q][i].w); }
    __syncthreads();
#pragma unroll
    for (int q = 0; q < 4; ++q) { const int n = tid >> 3, kc = tid & 7;
        *(uint4*)(dst + (size_t)(q * 64 + n) * ldd + k0 + kc * 8) = *(const uint4*)(t + q * 64 * 72 + n * 72 + kc * 8); }
    __syncthreads();
}

DEVI void ada_job(const Params& p, int job, char* smem) {
    int tid = threadIdx.x; asm volatile("" : "+v"(tid));
    const int lane = tid & 63, w = tid >> 6, fr = lane & 15, fq = lane >> 4;
    u16* T = (u16*)smem;
    const int n0 = job * 64;
    float* ada = (float*)(p.ws + WS_ADA);
    f32x4 acc0[4], acc1[4];
#pragma unroll
    for (int n = 0; n < 4; ++n) acc0[n] = acc1[n] = (f32x4){0.f, 0.f, 0.f, 0.f};
    const int kr = tid >> 4, n4 = (tid & 15) * 4;
    const int r0 = 16 * w + fr;
    const float* c0 = (r0 < 4 ? p.c_prompt + (size_t)r0 * DM : p.c_sample + (size_t)(r0 - 4) * DM) + fq * 8;
    const bool v1 = (fr < 4);
    const float* c1 = p.c_sample + (size_t)(124 + (v1 ? fr : 0)) * DM + fq * 8;
    const float* wsrc = p.w_ada + (size_t)kr * ADAW + n0 + n4;
    float4 wv[4][2];
#pragma unroll
    for (int q = 0; q < 4; ++q)
#pragma unroll
        for (int i = 0; i < 2; ++i) { const f32x4 t4 = __builtin_nontemporal_load((const f32x4*)(wsrc + (size_t)(q * 64 + 32 * i) * ADAW)); wv[q][i] = make_float4(t4[0], t4[1], t4[2], t4[3]); }
    for (int gk = 0; gk < 8; ++gk) {
#pragma unroll
        for (int q = 0; q < 4; ++q)
#pragma unroll
            for (int i = 0; i < 2; ++i) { const int k = kr + 32 * i; u16* tq = T + q * 64 * 72;
                tq[(n4 + 0) * 72 + k] = f2bf(wv[q][i].x); tq[(n4 + 1) * 72 + k] = f2bf(wv[q][i].y); tq[(n4 + 2) * 72 + k] = f2bf(wv[q][i].z); tq[(n4 + 3) * 72 + k] = f2bf(wv[q][i].w); }
        __syncthreads();
        if (gk + 1 < 8) {
#pragma unroll
            for (int q = 0; q < 4; ++q)
#pragma unroll
                for (int i = 0; i < 2; ++i) { const f32x4 t4 = __builtin_nontemporal_load((const f32x4*)(wsrc + (size_t)((gk + 1) * 256 + q * 64 + 32 * i) * ADAW)); wv[q][i] = make_float4(t4[0], t4[1], t4[2], t4[3]); }
        }
#pragma unroll
        for (int q = 0; q < 4; ++q) { const int kt = gk * 4 + q; const u16* Tc = T + q * 64 * 72;
            bf16x8 a0[2], a1[2];
#pragma unroll
            for (int k2 = 0; k2 < 2; ++k2) { const f32x4 x0 = *(const f32x4*)(c0 + kt * 64 + k2 * 32), x1 = *(const f32x4*)(c0 + kt * 64 + k2 * 32 + 4);
                bf16x8 qq; qq[0] = (short)f2bf(siluf_(x0[0])); qq[1] = (short)f2bf(siluf_(x0[1])); qq[2] = (short)f2bf(siluf_(x0[2])); qq[3] = (short)f2bf(siluf_(x0[3]));
                qq[4] = (short)f2bf(siluf_(x1[0])); qq[5] = (short)f2bf(siluf_(x1[1])); qq[6] = (short)f2bf(siluf_(x1[2])); qq[7] = (short)f2bf(siluf_(x1[3])); a0[k2] = qq; }
            if (w == 0) {
#pragma unroll
                for (int k2 = 0; k2 < 2; ++k2) { const f32x4 x0 = *(const f32x4*)(c1 + kt * 64 + k2 * 32), x1 = *(const f32x4*)(c1 + kt * 64 + k2 * 32 + 4);
                    bf16x8 qq; qq[0] = (short)f2bf(siluf_(x0[0])); qq[1] = (short)f2bf(siluf_(x0[1])); qq[2] = (short)f2bf(siluf_(x0[2])); qq[3] = (short)f2bf(siluf_(x0[3]));
                    qq[4] = (short)f2bf(siluf_(x1[0])); qq[5] = (short)f2bf(siluf_(x1[1])); qq[6] = (short)f2bf(siluf_(x1[2])); qq[7] = (short)f2bf(siluf_(x1[3]));
#pragma unroll
                    for (int e = 0; e < 8; ++e) qq[e] = v1 ? qq[e] : (short)0;
                    a1[k2] = qq; }
            }
#pragma unroll
            for (int k2 = 0; k2 < 2; ++k2)
#pragma unroll
                for (int n = 0; n < 4; ++n) { const bf16x8 bb = *(const bf16x8*)(Tc + (n * 16 + fr) * 72 + k2 * 32 + fq * 8);
                    acc0[n] = mfma16(a0[k2], bb, acc0[n]); if (w == 0) acc1[n] = mfma16(a1[k2], bb, acc1[n]); }
        }
        __syncthreads();
    }
#pragma unroll
    for (int n = 0; n < 4; ++n) { const int col = n0 + n * 16 + fr; const float bias = p.b_ada[col];
#pragma unroll
        for (int j = 0; j < 4; ++j) { ada[(size_t)(16 * w + fq * 4 + j) * ADAW + col] = acc0[n][j] + bias;
            if (w == 0 && fq == 0) ada[(size_t)(128 + j) * ADAW + col] = acc1[n][j] + bias; } }
    __syncthreads();
}

DEVI void phase_prep(const Params& p, char* smem) {
    u16* t = (u16*)smem;
    u16* WinT = (u16*)(p.ws + WS_WIN);
    constexpr int JA = 192, JB = 32 * 33;
    constexpr int TOT = JA + JB;
    for (int job = blockIdx.x; job < TOT; job += gridDim.x) {
        int j = job;
        if (j < JA) { ada_job(p, j, smem); continue; }
        j -= JA;
        { const int kt = j & 31, rg = j >> 5, c = rg * 256; transpose_tile4(p.w_in, INC, INC, kt * 64, c, c + 64, c + 128, c + 192, WinT + (size_t)rg * 256 * DM, DM, t); }
    }
}
constexpr int N_LATE_TR = 32 * 8 + 32 * 44 + 88 * 8;
DEVI void late_transpose(const Params& p, int j, char* smem) {
    u16* t = (u16*)smem; u16* WoutT = (u16*)(p.ws + WS_WOUT); u16* WguT = (u16*)(p.ws + WS_WGU); u16* WdownT = (u16*)(p.ws + WS_WDOWN);
    if (j < 32 * 8) { const int kt = j & 31, rg = j >> 5, c = rg * 256; transpose_tile4(p.w_out, DM, DM, kt * 64, c, c + 64, c + 128, c + 192, WoutT + (size_t)rg * 256 * DM, DM, t); return; }
    j -= 32 * 8;
    if (j < 32 * 44) { const int kt = j & 31, jj = j >> 5;
        transpose_tile4(p.w_gu, 2 * DFF, 2 * DFF, kt * 64, 128 * jj, 128 * jj + 64, DFF + 128 * jj, DFF + 128 * jj + 64, WguT + (size_t)jj * 256 * DM, DM, t); return; }
    j -= 32 * 44;
    { const int kt = j % 88, rg = j / 88, c = rg * 256; transpose_tile4(p.w_down, DM, DM, kt * 64, c, c + 64, c + 128, c + 192, WdownT + (size_t)rg * 256 * DFF, DFF, t); }
}
DEVI void pop_late(const Params& p, char* smem, int maxjobs, int list = 0) {
    unsigned* q2 = (unsigned*)(p.ws + WS_BAR) + 96 + 4 * list;
    const unsigned base = list ? 32 * 8 + 32 * 44 : 0, cnt = list ? 88 * 8 : 32 * 8 + 32 * 44;
    volatile unsigned* lq = (volatile unsigned*)(smem + LDS_BYTES - 32);
    for (int n = 0; n < maxjobs; ++n) {
        __syncthreads();
        if (threadIdx.x == 0) *lq = __hip_atomic_fetch_add(q2, 1u, __ATOMIC_RELAXED, __HIP_MEMORY_SCOPE_AGENT);
        __syncthreads();
        const unsigned u = *lq;
        if (u >= cnt) break;
        late_transpose(p, (int)(base + u), smem);
    }
    __syncthreads();
}

struct PEpiProj { static constexpr bool PERM = false, AFTER_DRAIN = false; float* C; float* gates;
    DEVI void operator()(const pg8::f32x4 (&acc)[2][2][4][2], const pg8::Unit& u, int wr, int wc, int fr, int fq) const {
        const int row0 = u.pm * 256 + wr * 64 + fr, col0 = u.pn * 256 + wc * 32 + 4 * fq;
        if (u.pn == 32) {
            if (wc == 0) {
#pragma unroll
                for (int ai = 0; ai < 2; ++ai)
#pragma unroll
                    for (int m = 0; m < 4; ++m) { float* gp = gates + (size_t)(row0 + ai * 128 + m * 16) * 24 + 4 * fq;
                        *(f32x4*)gp = acc[ai][0][m][0]; if (fq < 2) *(f32x4*)(gp + 16) = acc[ai][0][m][1]; }
            }
            return;
        }
#pragma unroll
        for (int ai = 0; ai < 2; ++ai)
#pragma unroll
            for (int m = 0; m < 4; ++m) { float* rowp = C + (size_t)(row0 + ai * 128 + m * 16) * PLD + col0;
#pragma unroll
                for (int bj = 0; bj < 2; ++bj)
#pragma unroll
                    for (int n = 0; n < 2; ++n) *(f32x4*)(rowp + bj * 128 + n * 16) = acc[ai][bj][m][n]; }
    } };
struct PEpiRes { static constexpr bool PERM = false, AFTER_DRAIN = false;
    const float* xp; const float* xs; const float* res; const float* ada; int gofs; float* out; float* part; int klen;
    DEVI void operator()(const pg8::f32x4 (&acc)[2][2][4][2], const pg8::Unit& u, int wr, int wc, int fr, int fq) const {
        const int row0 = u.pm * 256 + wr * 64 + fr, col0 = u.pn * 256 + wc * 32 + 4 * fq;
        const bool sliced = (u.pm >= 32);
#pragma unroll
        for (int ai = 0; ai < 2; ++ai)
#pragma unroll
            for (int m = 0; m < 4; ++m) { const int row = row0 + ai * 128 + m * 16; const int b = tok_batch(row);
                const float* rp = res ? res + (size_t)row * DM : (row < NPT ? xp + (size_t)row * DM : xs + (size_t)(row - NPT) * DM);
                const float* gp = ada + (size_t)b * ADAW + gofs; float* op = out + (size_t)row * DM;
#pragma unroll
                for (int bj = 0; bj < 2; ++bj)
#pragma unroll
                    for (int n = 0; n < 2; ++n) { const int col = col0 + bj * 128 + n * 16;
                        const f32x4 g = *(const f32x4*)(gp + col);
                        if (sliced) {
                            *(f32x4*)(part + ((size_t)(u.k0 / klen) * 512 + (row - NPT)) * DM + col) = acc[ai][bj][m][n];
                        } else { const f32x4 r = *(const f32x4*)(rp + col);
                            *(f32x4*)(op + col) = ALPHA * r + (1.f + g) * acc[ai][bj][m][n]; } } }
    } };
struct PEpiGU { static constexpr bool PERM = true, AFTER_DRAIN = false; u16* act;
    DEVI void operator()(const pg8::f32x4 (&acc)[2][2][4][2], const pg8::Unit& u, int wr, int wc, int fr, int fq) const {
        const int row0 = u.pm * 256 + wr * 64 + fr, col0 = u.pn * 128 + wc * 32 + 8 * fq;
#pragma unroll
        for (int ai = 0; ai < 2; ++ai)
#pragma unroll
            for (int m = 0; m < 4; ++m) { const int row = row0 + ai * 128 + m * 16;
                const f32x4 g0 = acc[ai][0][m][0], g1 = acc[ai][0][m][1], u0 = acc[ai][1][m][0], u1 = acc[ai][1][m][1];
                uint4 w; w.x = pack2(siluf_(g0[0]) * u0[0], siluf_(g0[1]) * u0[1]); w.y = pack2(siluf_(g0[2]) * u0[2], siluf_(g0[3]) * u0[3]);
                w.z = pack2(siluf_(g1[0]) * u1[0], siluf_(g1[1]) * u1[1]); w.w = pack2(siluf_(g1[2]) * u1[2], siluf_(g1[3]) * u1[3]);
                *(uint4*)(act + (size_t)row * DFF + col0) = w; }
    } };
struct SplitOrder : pg8::StaticOrder {
    int KS, Kfull;
    __device__ void init2(int N, int K, int G_, int c_, int KS_) { init(NPT, N, G_, c_, K); KS = KS_; Kfull = K; }
    __device__ bool next(int i, pg8::Unit& u) const {
        if (i == 0) return pg8::StaticOrder::next(0, u);
        if (i > 1 || c >= 16 * KS) return false;
        const int slice = c % KS, tile = c / KS;
        u.pm = 32 + (tile >> 3); u.pn = tile & 7; u.k0 = slice * (Kfull / KS); u.nt = Kfull / KS / 64; return true;
    }
};
template <class Epi>
DEVI void pg8_run_split(const u16* A, const u16* Bt, int N, int K, int KS, char* smem, const Epi& e) {
    pg8::Gemm g{(const pg8::bf16_t*)A, (const pg8::bf16_t*)Bt, NTOK, N, K}; SplitOrder S; S.init2(N, K, (int)gridDim.x, (int)blockIdx.x, KS);
    pg8::gemm_phase<Epi, SplitOrder, false>((PG8_LAS unsigned char*)smem, g, S, e, nullptr);
}
template <class Epi>
DEVI void pg8_run(const u16* A, const u16* Bt, int M, int N, int K, char* smem, const Epi& e) {
    pg8::Gemm g{(const pg8::bf16_t*)A, (const pg8::bf16_t*)Bt, M, N, K}; pg8::StaticOrder S; S.init(M, N, (int)gridDim.x, (int)blockIdx.x, K);
    pg8::gemm_phase<Epi, pg8::StaticOrder, false>((PG8_LAS unsigned char*)smem, g, S, e, nullptr);
}

DEVI void modulate_row(const Params& p, int row, int lane) {
    const float* ada = (const float*)(p.ws + WS_ADA); u16* Ah = (u16*)(p.ws + WS_AH);
    const float* xr = x_row(p, row); const float* ar = ada + (size_t)tok_batch(row) * ADAW;
#pragma unroll
    for (int i = 0; i < 8; ++i) { const int col = i * 256 + lane * 4;
        const f32x4 x = __builtin_nontemporal_load((const f32x4*)(xr + col)), sh = *(const f32x4*)(ar + col), sc = *(const f32x4*)(ar + DM + col);
        const f32x4 h = x * (1.f + sc) + sh; uint2 w; w.x = pack2(h[0], h[1]); w.y = pack2(h[2], h[3]);
        *(uint2*)(Ah + (size_t)row * DM + col) = w; }
}
DEVI void phase_modulate(const Params& p) {
    const int lane = threadIdx.x & 63, gw = blockIdx.x * 8 + (threadIdx.x >> 6), nw = gridDim.x * 8;
    for (int sr = gw; sr < 4 * (NTOK - NPT); sr += nw) if ((sr & 3) == 0) modulate_row(p, NPT + (sr >> 2), lane);
    for (int row = gw; row < NPT; row += nw) modulate_row(p, row, lane);
}
DEVI void ln_row(f32x4 (&v)[8], const float* g, const float* bta, int lane) {
    float s = 0.f;
#pragma unroll
    for (int i = 0; i < 8; ++i) s += v[i][0] + v[i][1] + v[i][2] + v[i][3];
    const float mu = wsum(s) * (1.f / DM);
    float q = 0.f;
#pragma unroll
    for (int i = 0; i < 8; ++i) { v[i] = v[i] - mu; q += v[i][0] * v[i][0] + v[i][1] * v[i][1] + v[i][2] * v[i][2] + v[i][3] * v[i][3]; }
    const float rs = rsqrtf(wsum(q) * (1.f / DM) + 1e-5f);
#pragma unroll
    for (int i = 0; i < 8; ++i) { const int col = i * 256 + lane * 4; v[i] = v[i] * rs * *(const f32x4*)(g + col) + *(const f32x4*)(bta + col); }
}
DEVI void ln1_row(const Params& p, int row, int lane) {
    const float* ada = (const float*)(p.ws + WS_ADA); u16* Ah = (u16*)(p.ws + WS_AH); float* x1 = (float*)(p.ws + WS_X1);
    float* xr = x1 + (size_t)row * DM; const float* ar = ada + (size_t)tok_batch(row) * ADAW;
    f32x4 v[8];
    if (row < NPT) {
#pragma unroll
        for (int i = 0; i < 8; ++i) v[i] = *(const f32x4*)(xr + i * 256 + lane * 4);
    } else { const float* part = (const float*)(p.ws + WS_PART) + (size_t)(row - NPT) * DM; const float* xs = p.x_sample + (size_t)(row - NPT) * DM;
#pragma unroll
        for (int i = 0; i < 8; ++i) { const int col = i * 256 + lane * 4; f32x4 a = {0.f, 0.f, 0.f, 0.f};
#pragma unroll
            for (int k = 0; k < 8; ++k) a += *(const f32x4*)(part + (size_t)k * 512 * DM + col);
            v[i] = ALPHA * *(const f32x4*)(xs + col) + (1.f + *(const f32x4*)(ar + 2 * DM + col)) * a; } }
    ln_row(v, p.ln1_g, p.ln1_b, lane);
#pragma unroll
    for (int i = 0; i < 8; ++i) { const int col = i * 256 + lane * 4; *(f32x4*)(xr + col) = v[i];
        const f32x4 sh = *(const f32x4*)(ar + 3 * DM + col), sc = *(const f32x4*)(ar + 4 * DM + col);
        const f32x4 h = v[i] * (1.f + sc) + sh; uint2 w; w.x = pack2(h[0], h[1]); w.y = pack2(h[2], h[3]);
        *(uint2*)(Ah + (size_t)row * DM + col) = w; }
}
DEVI void phase_ln1(const Params& p) {
    const int lane = threadIdx.x & 63, gw = blockIdx.x * 8 + (threadIdx.x >> 6), nw = gridDim.x * 8;
    for (int sr = gw; sr < 4 * (NTOK - NPT); sr += nw) if ((sr & 3) == 0) ln1_row(p, NPT + (sr >> 2), lane);
    for (int row = gw; row < NPT; row += nw) ln1_row(p, row, lane);
}
DEVI void ln2_row(const Params& p, int row, int lane) {
    float* xr = p.out + O_YP + (size_t)row * DM;
    f32x4 v[8];
    if (row < NPT) {
#pragma unroll
        for (int i = 0; i < 8; ++i) v[i] = *(const f32x4*)(xr + i * 256 + lane * 4);
    } else { const float* part = (const float*)(p.ws + WS_PART) + (size_t)(row - NPT) * DM; const float* x1r = (const float*)(p.ws + WS_X1) + (size_t)row * DM;
        const float* ar = (const float*)(p.ws + WS_ADA) + (size_t)tok_batch(row) * ADAW;
#pragma unroll
        for (int i = 0; i < 8; ++i) { const int col = i * 256 + lane * 4; f32x4 a = {0.f, 0.f, 0.f, 0.f};
#pragma unroll
            for (int k = 0; k < 11; ++k) a += *(const f32x4*)(part + (size_t)k * 512 * DM + col);
            v[i] = ALPHA * *(const f32x4*)(x1r + col) + (1.f + *(const f32x4*)(ar + 5 * DM + col)) * a; } }
    ln_row(v, p.ln2_g, p.ln2_b, lane);
#pragma unroll
    for (int i = 0; i < 8; ++i) *(f32x4*)(xr + i * 256 + lane * 4) = v[i];
}
DEVI void phase_ln2(const Params& p) {
    const int lane = threadIdx.x & 63, gw = blockIdx.x * 8 + (threadIdx.x >> 6), nw = gridDim.x * 8;
    for (int sr = gw; sr < 4 * (NTOK - NPT); sr += nw) if ((sr & 3) == 0) ln2_row(p, NPT + (sr >> 2), lane);
    for (int row = gw; row < NPT; row += nw) ln2_row(p, row, lane);
}
DEVI void phase_post(const Params& p) {
    const float* proj = (const float*)(p.ws + WS_PROJ); const float* gates = (const float*)(p.ws + WS_GATES); const u16* hbuf = (const u16*)(p.ws + WS_HBUF); u16* mix = (u16*)(p.ws + WS_MIX);
    const int lane = threadIdx.x & 63, gw = blockIdx.x * 8 + (threadIdx.x >> 6), nw = gridDim.x * 8;
    for (int row = gw; row < NPT; row += nw) {
        const u16* hr = hbuf + (size_t)row * DM; const float* pr = proj + (size_t)row * PLD; u16* mr = mix + (size_t)row * DM;
#pragma unroll
        for (int h = 0; h < 4; ++h) { const int col = h * 256 + lane * 4;
            const uint2 hv2 = *(const uint2*)(hr + col); const f32x4 v = {__uint_as_float(hv2.x << 16), __uint_as_float(hv2.x & 0xFFFF0000u), __uint_as_float(hv2.y << 16), __uint_as_float(hv2.y & 0xFFFF0000u)}; const float ss = wsum(v[0] * v[0] + v[1] * v[1] + v[2] * v[2] + v[3] * v[3]);
            const float rs = rsqrtf(ss * (1.f / 256.f) + 1e-6f);
            const f32x4 g = *(const f32x4*)(p.m_norm_g + col), o = *(const f32x4*)(pr + 3072 + col);
            uint2 w; w.x = pack2(v[0] * rs * g[0] * sigmoidf_(o[0]), v[1] * rs * g[1] * sigmoidf_(o[1]));
            w.y = pack2(v[2] * rs * g[2] * sigmoidf_(o[2]), v[3] * rs * g[3] * sigmoidf_(o[3]));
            *(uint2*)(mr + col) = w; }
#pragma unroll
        for (int h = 0; h < 8; ++h) { const int c = h * 128 + lane * 2;
            const unsigned hv1 = *(const unsigned*)(hr + 1024 + c); const float v0 = __uint_as_float(hv1 << 16), v1 = __uint_as_float(hv1 & 0xFFFF0000u); const float ss = wsum(v0 * v0 + v1 * v1);
            const float rs = rsqrtf(ss * (1.f / 128.f) + 1e-6f);
            const float z0 = pr[7168 + c], z1 = pr[7168 + c + 1];
            *(unsigned*)(mr + 1024 + c) = pack2(v0 * rs * p.g_norm_g[c] * siluf_(z0), v1 * rs * p.g_norm_g[c + 1] * siluf_(z1)); }
    }
    const int total = (4 + 128) * 3 * 3072;
    for (int i = blockIdx.x * NTHR + threadIdx.x; i < total; i += gridDim.x * NTHR) {
        const int ch = i % 3072, rj = i / 3072, j = rj % 3, b = rj / 3;
        if (b < 4) p.out[O_PCONV + (size_t)(b * 3 + j) * 3072 + ch] = proj[(size_t)(b * 2048 + 2045 + j) * PLD + 4096 + ch];
        else p.out[O_SCONV + (size_t)((b - 4) * 3 + j) * 3072 + ch] = proj[(size_t)(NPT + (b - 4) * 4 + 1 + j) * PLD + 4096 + ch];
    }
}

DEVI float scan_add(float x, int lane) { for (int o = 1; o < 64; o <<= 1) { const float y = __shfl_up(x, o); if (lane >= o) x += y; } return x; }
DEVI float scan_max(float x, int lane) { for (int o = 1; o < 64; o <<= 1) { const float y = __shfl_up(x, o); if (lane >= o) x = fmaxf(x, y); } return x; }

DEVI void mlstm_pre(const Params& p, int unit, char* smem) {
    int tid = threadIdx.x; asm volatile("" : "+v"(tid));
    const int lane = tid & 63, w = tid >> 6, fr = lane & 15, fq = lane >> 4;
    const int b = unit >> 7, h = (unit >> 5) & 3, c = unit & 31;
    u16* Qs = (u16*)smem;
    u16* Ks = Qs + 64 * 264;
    const float* proj = (const float*)(p.ws + WS_PROJ); const float* gates = (const float*)(p.ws + WS_GATES);
    u16* MP = (u16*)(p.ws + WS_MP) + (size_t)unit * 4096; u16* MKT = (u16*)(p.ws + WS_MKT) + (size_t)unit * 16384; u16* MQ = (u16*)(p.ws + WS_MQ) + (size_t)unit * 16384;
    u16* MVT = (u16*)(p.ws + WS_MVT) + (size_t)unit * 16384; float* MSC = (float*)(p.ws + WS_MSC) + (size_t)unit * 128;
    const size_t row0 = (size_t)b * 2048 + c * 64;
    const float iv = gates[(row0 + lane) * 24 + h] + p.m_i_bias[h];
    const float fv = gates[(row0 + lane) * 24 + 4 + h] + p.m_f_bias[h];
    const float bt = scan_add(logsigf_(fv), lane);
    const float av = iv - bt;
    const float ml = scan_max(av, lane);
    const float wt = __expf(av - __shfl(ml, 63));
    if (w == 0) { MSC[lane] = bt; MSC[64 + lane] = ml; }
    {
        unsigned kt[4][4], vt[4][4];
#pragma unroll
        for (int i = 0; i < 8; ++i) { const int s = w * 8 + i; const float* pr = proj + (row0 + s) * PLD + h * 256 + lane * 4;
            const f32x4 qv = __builtin_nontemporal_load((const f32x4*)(pr)), kv = __builtin_nontemporal_load((const f32x4*)(pr + 1024)) * 0.0625f, vv = __builtin_nontemporal_load((const f32x4*)(pr + 2048));
            uint2 pq; pq.x = pack2(qv[0], qv[1]); pq.y = pack2(qv[2], qv[3]); *(uint2*)(Qs + s * 264 + lane * 4) = pq; *(uint2*)(MQ + s * 256 + lane * 4) = pq;
            uint2 pk; pk.x = pack2(kv[0], kv[1]); pk.y = pack2(kv[2], kv[3]); *(uint2*)(Ks + s * 264 + lane * 4) = pk;
            const float ws_ = __shfl(wt, s);
#pragma unroll
            for (int dd = 0; dd < 4; ++dd) { const unsigned kb = f2bf(kv[dd] * ws_), vb = f2bf(vv[dd]);
                if (i & 1) { kt[dd][i >> 1] |= kb << 16; vt[dd][i >> 1] |= vb << 16; } else { kt[dd][i >> 1] = kb; vt[dd][i >> 1] = vb; } } }
#pragma unroll
        for (int dd = 0; dd < 4; ++dd) {
            *(uint4*)(MKT + (lane * 4 + dd) * 64 + w * 8) = make_uint4(kt[dd][0], kt[dd][1], kt[dd][2], kt[dd][3]);
            *(uint4*)(MVT + (lane * 4 + dd) * 64 + w * 8) = make_uint4(vt[dd][0], vt[dd][1], vt[dd][2], vt[dd][3]); }
    }
    __syncthreads();
    {
        const int mt = w & 3, g = w >> 2;
        f32x4 acc[2]; acc[0] = acc[1] = (f32x4){0.f, 0.f, 0.f, 0.f};
#pragma unroll
        for (int kk = 0; kk < 8; ++kk) { const bf16x8 aQ = *(const bf16x8*)(Qs + (mt * 16 + fr) * 264 + kk * 32 + fq * 8);
#pragma unroll
            for (int n = 0; n < 2; ++n) acc[n] = mfma16(*(const bf16x8*)(Ks + ((g * 2 + n) * 16 + fr) * 264 + kk * 32 + fq * 8), aQ, acc[n]); }
        const int t = mt * 16 + fr; const float mlt = __shfl(ml, t);
#pragma unroll
        for (int n = 0; n < 2; ++n) { float pv[4];
#pragma unroll
            for (int j = 0; j < 4; ++j) { const int s = (g * 2 + n) * 16 + fq * 4 + j; const float as_ = __shfl(av, s);
                pv[j] = (s <= t) ? acc[n][j] * __expf(as_ - mlt) : 0.f; }
            uint2 pp; pp.x = pack2(pv[0], pv[1]); pp.y = pack2(pv[2], pv[3]);
            *(uint2*)(MP + t * 64 + (g * 2 + n) * 16 + fq * 4) = pp; }
    }
    __syncthreads();
}

struct MlLd { bf16x8 fP[2]; bf16x8 fV[4][2]; bf16x8 fK[2][2]; bf16x8 fQ[8]; float bt, ml; };
DEVI void ml_loadQ(MlLd& L, const Params& p, int unit, int mt, int fr, int fq) {
    const u16* MQ = (const u16*)(p.ws + WS_MQ) + (size_t)unit * 16384;
#pragma unroll
    for (int kk = 0; kk < 8; ++kk) L.fQ[kk] = *(const bf16x8*)(MQ + (mt * 16 + fr) * 256 + kk * 32 + fq * 8);
}
DEVI void ml_loadP(MlLd& L, const Params& p, int unit, int mt, int fr, int fq) {
    const u16* MP = (const u16*)(p.ws + WS_MP) + (size_t)unit * 4096;
#pragma unroll
    for (int k2 = 0; k2 < 2; ++k2) L.fP[k2] = *(const bf16x8*)(MP + (mt * 16 + fr) * 64 + k2 * 32 + fq * 8);
}
DEVI void ml_loadVK(MlLd& L, const Params& p, int unit, int eb, int w, int fr, int fq) {
    const u16* MKT = (const u16*)(p.ws + WS_MKT) + (size_t)unit * 16384; const u16* MVT = (const u16*)(p.ws + WS_MVT) + (size_t)unit * 16384;
#pragma unroll
    for (int k2 = 0; k2 < 2; ++k2) {
#pragma unroll
        for (int m = 0; m < 4; ++m) L.fV[m][k2] = *(const bf16x8*)(MVT + (eb * 64 + m * 16 + fr) * 64 + k2 * 32 + fq * 8);
#pragma unroll
        for (int n = 0; n < 2; ++n) L.fK[n][k2] = *(const bf16x8*)(MKT + (w * 32 + n * 16 + fr) * 64 + k2 * 32 + fq * 8); }
}
DEVI void ml_loadS(MlLd& L, const Params& p, int unit, int lane) {
    const float* MSC = (const float*)(p.ws + WS_MSC) + (size_t)unit * 128; L.bt = MSC[lane]; L.ml = MSC[64 + lane];
}
DEVI void mlstm_load(MlLd& L, const Params& p, int unit, int eb, int lane, int w, int mt, int fr, int fq) {
    ml_loadQ(L, p, unit, mt, fr, fq); ml_loadP(L, p, unit, mt, fr, fq); ml_loadVK(L, p, unit, eb, w, fr, fq); ml_loadS(L, p, unit, lane);
}
DEVI void mlstm_seq(const Params& p, int role, char* smem) {
    const int tid = threadIdx.x, lane0 = tid & 63, w0 = tid >> 6;
    const int b = role >> 4, h = (role >> 2) & 3, eb = role & 3;
    u16* Cts = (u16*)smem;
    for (int i = tid; i < 2 * 80 * 264 / 2; i += NTHR) ((unsigned*)Cts)[i] = 0u;
    u16* hbuf = (u16*)(p.ws + WS_HBUF);
    f32x4 accC[5][2];
#pragma unroll
    for (int m = 0; m < 5; ++m) { accC[m][0] = (f32x4){0.f, 0.f, 0.f, 0.f}; accC[m][1] = (f32x4){0.f, 0.f, 0.f, 0.f}; }
    float mcar = 0.f;
    const int ubase = (b * 4 + h) * 32;
    MlLd L;
    mlstm_load(L, p, ubase, eb, lane0, w0, w0 & 3, lane0 & 15, lane0 >> 4);
    __syncthreads();
    for (int c = 0; c < 32; ++c) {
        int lane = lane0, w = w0; asm volatile("" : "+v"(lane), "+v"(w));
        const int fr = lane & 15, fq = lane >> 4, mt = w & 3, g = w >> 2;
        const size_t row0 = (size_t)b * 2048 + c * 64;
        const u16* Cc = Cts + (c & 1) * 80 * 264; u16* Cn = Cts + ((c & 1) ^ 1) * 80 * 264;
        const float bt = L.bt, ml = L.ml;
        const float mr = fmaxf(ml, mcar);
        const float bL = __shfl(bt, 63), mrL = __shfl(mr, 63), mlL = __shfl(ml, 63);
        const float mnew = bL + mrL, decay = __expf(bL + mcar - mnew), rho = __expf(mlL - mrL);
        const float iw = __expf(mcar - mr), rt = __expf(ml - mr), flo = __expf(-(bt + mr));
        bf16x8 one8;
#pragma unroll
        for (int i = 0; i < 8; ++i) one8[i] = (fr == 0) ? (short)0x3F80 : (short)0;
        const bool more = (c + 1 < 32); const int nu = ubase + c + 1;
        if (more) ml_loadS(L, p, nu, lane);
        f32x4 accH1[3]; accH1[0] = accH1[1] = accH1[2] = (f32x4){0.f, 0.f, 0.f, 0.f};
#pragma unroll
        for (int kk = 0; kk < 8; ++kk) { const bf16x8 q = L.fQ[kk];
#pragma unroll
            for (int n = 0; n < 3; ++n) { const int et = n < 2 ? g * 2 + n : 4;
                accH1[n] = mfma16(q, *(const bf16x8*)(Cc + (et * 16 + fr) * 264 + kk * 32 + fq * 8), accH1[n]); } }
        __builtin_amdgcn_sched_barrier(0);
        if (more) ml_loadQ(L, p, nu, mt, fr, fq);
        __builtin_amdgcn_sched_barrier(0);
        f32x4 accH2[3]; accH2[0] = accH2[1] = accH2[2] = (f32x4){0.f, 0.f, 0.f, 0.f};
#pragma unroll
        for (int k2 = 0; k2 < 2; ++k2) {
#pragma unroll
            for (int n = 0; n < 2; ++n) { bf16x8 bv;
#pragma unroll
                for (int i = 0; i < 8; ++i) bv[i] = g ? L.fV[2 + n][k2][i] : L.fV[n][k2][i];
                accH2[n] = mfma16(L.fP[k2], bv, accH2[n]); }
            accH2[2] = mfma16(L.fP[k2], one8, accH2[2]); }
        __builtin_amdgcn_sched_barrier(0);
        if (more) ml_loadP(L, p, nu, mt, fr, fq);
        __builtin_amdgcn_sched_barrier(0);
#pragma unroll
        for (int j = 0; j < 4; ++j) { const int t = mt * 16 + fq * 4 + j;
            const float iwt = __shfl(iw, t), rtt = __shfl(rt, t), fl = __shfl(flo, t);
            const float h0 = iwt * accH1[0][j] + rtt * accH2[0][j], h1 = iwt * accH1[1][j] + rtt * accH2[1][j], hd = iwt * accH1[2][j] + rtt * accH2[2][j];
            const float den = __shfl(hd, fq * 16); const float dn = fmaxf(fabsf(den), fl);
            hbuf[(row0 + t) * DM + h * 256 + eb * 64 + (g * 2) * 16 + fr] = f2bf(h0 / dn);
            hbuf[(row0 + t) * DM + h * 256 + eb * 64 + (g * 2 + 1) * 16 + fr] = f2bf(h1 / dn); }
        __builtin_amdgcn_sched_barrier(0);
        {
            f32x4 tmp[5][2];
#pragma unroll
            for (int m = 0; m < 5; ++m) { tmp[m][0] = (f32x4){0.f, 0.f, 0.f, 0.f}; tmp[m][1] = (f32x4){0.f, 0.f, 0.f, 0.f}; }
#pragma unroll
            for (int k2 = 0; k2 < 2; ++k2)
#pragma unroll
                for (int m = 0; m < 5; ++m)
#pragma unroll
                    for (int n = 0; n < 2; ++n) tmp[m][n] = mfma16(m < 4 ? L.fV[m < 4 ? m : 0][k2] : one8, L.fK[n][k2], tmp[m][n]);
            __builtin_amdgcn_sched_barrier(0);
            if (more) ml_loadVK(L, p, nu, eb, w, fr, fq);
            __builtin_amdgcn_sched_barrier(0);
#pragma unroll
            for (int m = 0; m < 5; ++m)
#pragma unroll
                for (int n = 0; n < 2; ++n) { accC[m][n] = decay * accC[m][n] + rho * tmp[m][n];
#pragma unroll
                    for (int j = 0; j < 4; ++j) Cn[(m * 16 + fq * 4 + j) * 264 + w * 32 + n * 16 + fr] = f2bf(accC[m][n][j]); }
        }
        __builtin_amdgcn_sched_barrier(0);
        mcar = mnew;
        __syncthreads();
    }
    const int lane = lane0, w = w0, fr = lane & 15, fq = lane >> 4;
    float* pC = p.out + O_PC + (size_t)(b * 4 + h) * 65536;
#pragma unroll
    for (int m = 0; m < 4; ++m)
#pragma unroll
        for (int n = 0; n < 2; ++n) *(f32x4*)(pC + (size_t)(w * 32 + n * 16 + fr) * 256 + eb * 64 + m * 16 + fq * 4) = accC[m][n];
    if (eb == 0 && fq == 0) { p.out[O_PN + (b * 4 + h) * 256 + w * 32 + fr] = accC[4][0][0]; p.out[O_PN + (b * 4 + h) * 256 + w * 32 + 16 + fr] = accC[4][1][0]; }
    if (eb == 0 && tid == 0) p.out[O_PM + b * 4 + h] = mcar;
    __syncthreads();
}

DEVI void gdn_pre(const Params& p, int unit, char* smem) {
    int tid = threadIdx.x; asm volatile("" : "+v"(tid));
    const int lane = tid & 63, w = tid >> 6, fr = lane & 15, fq = lane >> 4;
    const int b = unit >> 8, h = (unit >> 5) & 7, c = unit & 31;
    u16* Ks = (u16*)smem;
    u16* Qs = Ks + 64 * 136;
    u16* KbT = Qs + 64 * 136;
    u16* VbT = KbT + 128 * 72;
    u16* KwT = VbT + 128 * 72;
    u16* Mb = KwT + 128 * 72;
    u16* Mtb = Mb + 2 * 64 * 72;
    u16* Ts = Mtb + 2 * 64 * 72;
    u16* Ps = Ts + 64 * 72;
    const float* proj = (const float*)(p.ws + WS_PROJ); const float* gates = (const float*)(p.ws + WS_GATES);
    u16* GQ = (u16*)(p.ws + WS_GQ) + (size_t)unit * 8192; u16* GW = (u16*)(p.ws + WS_GW) + (size_t)unit * 8192;
    u16* GP = (u16*)(p.ws + WS_GP) + (size_t)unit * 4096; u16* GU0 = (u16*)(p.ws + WS_GU0) + (size_t)unit * 8192;
    u16* GKW = (u16*)(p.ws + WS_GKW) + (size_t)unit * 8192; float* GSC = (float*)(p.ws + WS_GSC) + (size_t)unit * 80;
    const float dtb = p.g_dt_bias[h], Aexp = __expf(p.g_A_log[h]);
    const int mt = w & 3, g = w >> 2;
    const int chq = h * 128 + 2 * lane, chk = 1024 + chq, chv = 2048 + chq;
    const long row0 = (long)b * 2048 + c * 64;
    const float ga = gates[(row0 + lane) * 24 + 16 + h] + dtb;
    const float la = -Aexp * softplusf_(ga);
    const float beta = sigmoidf_(gates[(row0 + lane) * 24 + 8 + h]);
    const float bc = scan_add(la, lane);
    const float bL = __shfl(bc, 63);
    const float eb_ = __expf(bc);
    if (w == 0) { GSC[lane] = eb_; if (lane == 0) GSC[64] = __expf(bL); }
    {
        float2 cq[4], ck[4], cv[4];
#pragma unroll
        for (int j = 0; j < 4; ++j) { cq[j] = *(const float2*)(p.conv_w + j * 3072 + chq); ck[j] = *(const float2*)(p.conv_w + j * 3072 + chk); cv[j] = *(const float2*)(p.conv_w + j * 3072 + chv); }
        float2 rq[11], rk[11], rv[11];
#pragma unroll
        for (int j = 0; j < 11; ++j) { const long tg = (long)c * 64 + w * 8 - 3 + j;
            if (tg >= 0) { const float* pr = proj + ((long)b * 2048 + tg) * PLD + 4096;
                rq[j] = *(const float2*)(pr + chq); rk[j] = *(const float2*)(pr + chk); rv[j] = *(const float2*)(pr + chv); }
            else { rq[j] = make_float2(0.f, 0.f); rk[j] = make_float2(0.f, 0.f); rv[j] = make_float2(0.f, 0.f); } }
        unsigned kb0[4], kb1[4], kw0[4], kw1[4], vb0[4], vb1[4];
#pragma unroll
        for (int i = 0; i < 8; ++i) { const int s = w * 8 + i;
            float yq0 = cq[0].x * rq[i].x + cq[1].x * rq[i + 1].x + cq[2].x * rq[i + 2].x + cq[3].x * rq[i + 3].x;
            float yq1 = cq[0].y * rq[i].y + cq[1].y * rq[i + 1].y + cq[2].y * rq[i + 2].y + cq[3].y * rq[i + 3].y;
            float yk0 = ck[0].x * rk[i].x + ck[1].x * rk[i + 1].x + ck[2].x * rk[i + 2].x + ck[3].x * rk[i + 3].x;
            float yk1 = ck[0].y * rk[i].y + ck[1].y * rk[i + 1].y + ck[2].y * rk[i + 2].y + ck[3].y * rk[i + 3].y;
            float yv0 = cv[0].x * rv[i].x + cv[1].x * rv[i + 1].x + cv[2].x * rv[i + 2].x + cv[3].x * rv[i + 3].x;
            float yv1 = cv[0].y * rv[i].y + cv[1].y * rv[i + 1].y + cv[2].y * rv[i + 2].y + cv[3].y * rv[i + 3].y;
            yq0 = siluf_(yq0); yq1 = siluf_(yq1); yk0 = siluf_(yk0); yk1 = siluf_(yk1); yv0 = siluf_(yv0); yv1 = siluf_(yv1);
            const float rqn = rsqrtf(wsum(yq0 * yq0 + yq1 * yq1) + 1e-6f) * 0.08838834764831845f;
            const float rkn = rsqrtf(wsum(yk0 * yk0 + yk1 * yk1) + 1e-6f);
            yq0 *= rqn; yq1 *= rqn; yk0 *= rkn; yk1 *= rkn;
            *(unsigned*)(Qs + s * 136 + 2 * lane) = pack2(yq0, yq1);
            *(unsigned*)(Ks + s * 136 + 2 * lane) = pack2(yk0, yk1);
            const float bs_ = __shfl(bc, s), bets = __shfl(beta, s);
            const float f1 = bets * __expf(bs_), f2 = __expf(bL - bs_);
            const unsigned a0 = f2bf(yk0 * f1), a1 = f2bf(yk1 * f1), w0_ = f2bf(yk0 * f2), w1_ = f2bf(yk1 * f2), v0_ = f2bf(yv0 * bets), v1_ = f2bf(yv1 * bets);
            if (i & 1) { kb0[i >> 1] |= a0 << 16; kb1[i >> 1] |= a1 << 16; kw0[i >> 1] |= w0_ << 16; kw1[i >> 1] |= w1_ << 16; vb0[i >> 1] |= v0_ << 16; vb1[i >> 1] |= v1_ << 16; }
            else { kb0[i >> 1] = a0; kb1[i >> 1] = a1; kw0[i >> 1] = w0_; kw1[i >> 1] = w1_; vb0[i >> 1] = v0_; vb1[i >> 1] = v1_; } }
        *(uint4*)(KbT + (2 * lane) * 72 + w * 8) = make_uint4(kb0[0], kb0[1], kb0[2], kb0[3]);
        *(uint4*)(KbT + (2 * lane + 1) * 72 + w * 8) = make_uint4(kb1[0], kb1[1], kb1[2], kb1[3]);
        *(uint4*)(KwT + (2 * lane) * 72 + w * 8) = make_uint4(kw0[0], kw0[1], kw0[2], kw0[3]);
        *(uint4*)(KwT + (2 * lane + 1) * 72 + w * 8) = make_uint4(kw1[0], kw1[1], kw1[2], kw1[3]);
        *(uint4*)(VbT + (2 * lane) * 72 + w * 8) = make_uint4(vb0[0], vb0[1], vb0[2], vb0[3]);
        *(uint4*)(VbT + (2 * lane + 1) * 72 + w * 8) = make_uint4(vb1[0], vb1[1], vb1[2], vb1[3]);
    }
    __syncthreads();
    {
        f32x4 aKK[2], aQK[2];
#pragma unroll
        for (int n = 0; n < 2; ++n) aKK[n] = aQK[n] = (f32x4){0.f, 0.f, 0.f, 0.f};
#pragma unroll
        for (int k = 0; k < 128; k += 32) {
            const bf16x8 fK = *(const bf16x8*)(Ks + (mt * 16 + fr) * 136 + k + fq * 8), fQ = *(const bf16x8*)(Qs + (mt * 16 + fr) * 136 + k + fq * 8);
#pragma unroll
            for (int n = 0; n < 2; ++n) { const bf16x8 bK = *(const bf16x8*)(Ks + ((g * 2 + n) * 16 + fr) * 136 + k + fq * 8);
                aKK[n] = mfma16(fK, bK, aKK[n]); aQK[n] = mfma16(fQ, bK, aQK[n]); }
        }
#pragma unroll
        for (int n = 0; n < 2; ++n) { const int s = (g * 2 + n) * 16 + fr; const float bs_ = __shfl(bc, s);
#pragma unroll
            for (int j = 0; j < 4; ++j) { const int l = mt * 16 + fq * 4 + j; const float bl = __shfl(bc, l), betl = __shfl(beta, l);
                const float dec = __expf(fminf(bl - bs_, 0.f));
                const float nm = (s < l) ? -betl * aKK[n][j] * dec : 0.f; const u16 nmb = f2bf(nm);
                Mb[l * 72 + s] = nmb; Mtb[s * 72 + l] = nmb; Ts[l * 72 + s] = (l == s) ? (u16)0x3F80 : nmb;
                Ps[l * 72 + s] = f2bf((s <= l) ? aQK[n][j] * dec : 0.f); } }
    }
    __syncthreads();
    {
        f32x4 accT[4];
        if (w >= 4) {
#pragma unroll
            for (int n = 0; n < 4; ++n)
#pragma unroll
                for (int j = 0; j < 4; ++j) accT[n][j] = bf2f(Ts[((w - 4) * 16 + fq * 4 + j) * 72 + n * 16 + fr]);
        }
        for (int k = 1; k <= 6; ++k) {
            const int cur = (k - 1) & 1;
            const u16* Mc = Mb + cur * 64 * 72; const u16* Mtc = Mtb + cur * 64 * 72;
            if (w < 4) {
                if (k <= 5) {
                    f32x4 am[1][4];
#pragma unroll
                    for (int n = 0; n < 4; ++n) am[0][n] = (f32x4){0.f, 0.f, 0.f, 0.f};
                    mma_lds<1, 4>(am, Mc + (w * 16) * 72, 72, Mtc, 72, 64, fr, fq);
                    u16* Mn = Mb + (cur ^ 1) * 64 * 72; u16* Mtn = Mtb + (cur ^ 1) * 64 * 72;
#pragma unroll
                    for (int n = 0; n < 4; ++n)
#pragma unroll
                        for (int j = 0; j < 4; ++j) { const int l = w * 16 + fq * 4 + j, s = n * 16 + fr; const u16 v = f2bf(am[0][n][j]); Mn[l * 72 + s] = v; Mtn[s * 72 + l] = v; }
                }
            } else if (k >= 2) {
                f32x4 at[1][4];
#pragma unroll
                for (int n = 0; n < 4; ++n) at[0][n] = accT[n];
                mma_lds<1, 4>(at, Ts + ((w - 4) * 16) * 72, 72, Mtc, 72, 64, fr, fq);
#pragma unroll
                for (int n = 0; n < 4; ++n) { accT[n] = at[0][n];
#pragma unroll
                    for (int j = 0; j < 4; ++j) Ts[((w - 4) * 16 + fq * 4 + j) * 72 + n * 16 + fr] = f2bf(accT[n][j]); }
            }
            __syncthreads();
        }
    }
    {
        f32x4 aW[4], aU[4];
#pragma unroll
        for (int n = 0; n < 4; ++n) aW[n] = aU[n] = (f32x4){0.f, 0.f, 0.f, 0.f};
#pragma unroll
        for (int k2 = 0; k2 < 2; ++k2) { const bf16x8 aT = *(const bf16x8*)(Ts + (mt * 16 + fr) * 72 + k2 * 32 + fq * 8);
#pragma unroll
            for (int n = 0; n < 4; ++n) { const bf16x8 bK = *(const bf16x8*)(KbT + ((g * 4 + n) * 16 + fr) * 72 + k2 * 32 + fq * 8);
                const bf16x8 bV = *(const bf16x8*)(VbT + ((g * 4 + n) * 16 + fr) * 72 + k2 * 32 + fq * 8);
                aW[n] = mfma16(bK, aT, aW[n]);
                aU[n] = mfma16(aT, bV, aU[n]); } }
#pragma unroll
        for (int n = 0; n < 4; ++n) {
            uint2 pw; pw.x = pack2(aW[n][0], aW[n][1]); pw.y = pack2(aW[n][2], aW[n][3]);
            *(uint2*)(GW + (mt * 16 + fr) * 128 + (g * 4 + n) * 16 + fq * 4) = pw;
            uint2 pu; pu.x = pack2(aU[n][0], aU[n][1]); pu.y = pack2(aU[n][2], aU[n][3]);
            *(uint2*)(GU0 + ((g * 4 + n) * 16 + fr) * 64 + mt * 16 + fq * 4) = pu; }
#pragma unroll
        for (int i = 0; i < 2; ++i) { const int id = tid + i * NTHR;
            *(uint4*)(GQ + (id >> 4) * 128 + (id & 15) * 8) = *(const uint4*)(Qs + (id >> 4) * 136 + (id & 15) * 8);
            *(uint4*)(GKW + (id >> 3) * 64 + (id & 7) * 8) = *(const uint4*)(KwT + (id >> 3) * 72 + (id & 7) * 8); }
        *(uint4*)(GP + (tid >> 3) * 64 + (tid & 7) * 8) = *(const uint4*)(Ps + (tid >> 3) * 72 + (tid & 7) * 8);
    }
    __syncthreads();
}

struct GdnLd { bf16x8 fW[4], fQ[4], fP[2], fKw[2]; uint2 u0[2]; float ebl[4]; float ebL; };
DEVI void gdn_load(GdnLd& L, const Params& p, int unit, int eb, int w, int mt, int g, int fr, int fq) {
    const u16* GQ = (const u16*)(p.ws + WS_GQ) + (size_t)unit * 8192; const u16* GW = (const u16*)(p.ws + WS_GW) + (size_t)unit * 8192;
    const u16* GP = (const u16*)(p.ws + WS_GP) + (size_t)unit * 4096; const u16* GU0 = (const u16*)(p.ws + WS_GU0) + (size_t)unit * 8192;
    const u16* GKW = (const u16*)(p.ws + WS_GKW) + (size_t)unit * 8192; const float* GSC = (const float*)(p.ws + WS_GSC) + (size_t)unit * 80;
#pragma unroll
    for (int kk = 0; kk < 4; ++kk) { L.fW[kk] = *(const bf16x8*)(GW + (mt * 16 + fr) * 128 + kk * 32 + fq * 8); L.fQ[kk] = *(const bf16x8*)(GQ + (mt * 16 + fr) * 128 + kk * 32 + fq * 8); }
#pragma unroll
    for (int k2 = 0; k2 < 2; ++k2) { L.fP[k2] = *(const bf16x8*)(GP + (mt * 16 + fr) * 64 + k2 * 32 + fq * 8); L.fKw[k2] = *(const bf16x8*)(GKW + (w * 16 + fr) * 64 + k2 * 32 + fq * 8); }
#pragma unroll
    for (int n = 0; n < 2; ++n) L.u0[n] = *(const uint2*)(GU0 + (eb * 64 + (g * 2 + n) * 16 + fr) * 64 + mt * 16 + fq * 4);
    const f32x4 e4 = *(const f32x4*)(GSC + mt * 16 + fq * 4);
    L.ebl[0] = e4[0]; L.ebl[1] = e4[1]; L.ebl[2] = e4[2]; L.ebl[3] = e4[3]; L.ebL = GSC[64];
}
DEVI void gdn_seq(const Params& p, int role, char* smem) {
    const int tid = threadIdx.x, lane0 = tid & 63, w0 = tid >> 6;
    const int b = role >> 4, h = (role >> 1) & 7, eb = role & 1;
    u16* Sts = (u16*)smem;
    u16* Uts = Sts + 64 * 136;
    for (int i = tid; i < 64 * 136 / 2; i += NTHR) ((unsigned*)Sts)[i] = 0u;
    u16* hbuf = (u16*)(p.ws + WS_HBUF);
    f32x4 accSt[4];
#pragma unroll
    for (int m = 0; m < 4; ++m) accSt[m] = (f32x4){0.f, 0.f, 0.f, 0.f};
    const int ubase = (b * 8 + h) * 32;
    GdnLd L;
    gdn_load(L, p, ubase, eb, w0, w0 & 3, w0 >> 2, lane0 & 15, lane0 >> 4);
    __syncthreads();
    for (int c = 0; c < 32; ++c) {
        int lane = lane0, w = w0; asm volatile("" : "+v"(lane), "+v"(w));
        const int fr = lane & 15, fq = lane >> 4, mt = w & 3, g = w >> 2;
        const long row0 = (long)b * 2048 + c * 64;
        f32x4 aWS[2], accO[2];
        aWS[0] = aWS[1] = accO[0] = accO[1] = (f32x4){0.f, 0.f, 0.f, 0.f};
#pragma unroll
        for (int kk = 0; kk < 4; ++kk)
#pragma unroll
            for (int n = 0; n < 2; ++n) { const bf16x8 bS = *(const bf16x8*)(Sts + ((g * 2 + n) * 16 + fr) * 136 + kk * 32 + fq * 8);
                aWS[n] = mfma16(L.fW[kk], bS, aWS[n]); accO[n] = mfma16(L.fQ[kk], bS, accO[n]); }
#pragma unroll
        for (int n = 0; n < 2; ++n) {
            const float u0 = __uint_as_float(L.u0[n].x << 16), u1 = __uint_as_float(L.u0[n].x & 0xFFFF0000u);
            const float u2 = __uint_as_float(L.u0[n].y << 16), u3 = __uint_as_float(L.u0[n].y & 0xFFFF0000u);
            uint2 pu; pu.x = pack2(u0 - aWS[n][0], u1 - aWS[n][1]); pu.y = pack2(u2 - aWS[n][2], u3 - aWS[n][3]);
            *(uint2*)(Uts + ((g * 2 + n) * 16 + fr) * 72 + mt * 16 + fq * 4) = pu;
#pragma unroll
            for (int j = 0; j < 4; ++j) accO[n][j] *= L.ebl[j]; }
        const bf16x8 fP0 = L.fP[0], fP1 = L.fP[1], fK0 = L.fKw[0], fK1 = L.fKw[1]; const float ebL = L.ebL;
        __syncthreads();
        if (c + 1 < 32) gdn_load(L, p, ubase + c + 1, eb, w, mt, g, fr, fq);
#pragma unroll
        for (int n = 0; n < 2; ++n) {
            accO[n] = mfma16(fP0, *(const bf16x8*)(Uts + ((g * 2 + n) * 16 + fr) * 72 + fq * 8), accO[n]);
            accO[n] = mfma16(fP1, *(const bf16x8*)(Uts + ((g * 2 + n) * 16 + fr) * 72 + 32 + fq * 8), accO[n]); }
#pragma unroll
        for (int n = 0; n < 2; ++n)
#pragma unroll
            for (int j = 0; j < 4; ++j) hbuf[(row0 + mt * 16 + fq * 4 + j) * DM + 1024 + h * 128 + eb * 64 + (g * 2 + n) * 16 + fr] = f2bf(accO[n][j]);
#pragma unroll
        for (int m = 0; m < 4; ++m) { accSt[m] *= ebL;
            accSt[m] = mfma16(fK0, *(const bf16x8*)(Uts + (m * 16 + fr) * 72 + fq * 8), accSt[m]);
            accSt[m] = mfma16(fK1, *(const bf16x8*)(Uts + (m * 16 + fr) * 72 + 32 + fq * 8), accSt[m]);
            uint2 ps; ps.x = pack2(accSt[m][0], accSt[m][1]); ps.y = pack2(accSt[m][2], accSt[m][3]);
            *(uint2*)(Sts + (m * 16 + fr) * 136 + w * 16 + fq * 4) = ps; }
        __syncthreads();
    }
    const int lane = lane0, w = w0, fr = lane & 15, fq = lane >> 4;
    float* pS = p.out + O_PS + (size_t)(b * 8 + h) * 16384;
#pragma unroll
    for (int m = 0; m < 4; ++m)
#pragma unroll
        for (int j = 0; j < 4; ++j) pS[(size_t)(w * 16 + fq * 4 + j) * 128 + eb * 64 + m * 16 + fr] = accSt[m][j];
    __syncthreads();
}

DEVI void mlstm_sample(const Params& p, int item, char* smem) {
    int tid = threadIdx.x; asm volatile("" : "+v"(tid));
    const int lane = tid & 63, w = tid >> 6;
    const int bs = item >> 2, h = item & 3;
    float* qs = (float*)smem; float* ks = qs + 1024; float* vs = ks + 1024; float* red = vs + 1024; float* num = red + 8192; float* sc = num + 1024; float* sc2 = sc + 32;
    const float* proj = (const float*)(p.ws + WS_PROJ); const float* gates = (const float*)(p.ws + WS_GATES); u16* mix = (u16*)(p.ws + WS_MIX);
    const size_t row0 = NPT + (size_t)bs * 4;
    for (int i = tid; i < 3072; i += NTHR) { const int which = i >> 10, t = (i >> 8) & 3, d = i & 255;
        float v = proj[(row0 + t) * PLD + which * 1024 + h * 256 + d]; if (which == 1) v *= 0.0625f; qs[i] = v; }
    float m = p.st_m[bs * 4 + h]; float fw[4], iw[4], flo[4];
    const float ib = p.m_i_bias[h], fb = p.m_f_bias[h];
#pragma unroll
    for (int t = 0; t < 4; ++t) { const float iv = gates[(row0 + t) * 24 + h] + ib; const float lf = logsigf_(gates[(row0 + t) * 24 + 4 + h] + fb);
        const float mn = fmaxf(lf + m, iv); fw[t] = __expf(lf + m - mn); iw[t] = __expf(iv - mn); flo[t] = __expf(-mn); m = mn; }
    __syncthreads();
    float qn[4] = {0.f, 0.f, 0.f, 0.f};
    if (tid < 256) { float n = p.st_n[(bs * 4 + h) * 256 + tid];
#pragma unroll
        for (int t = 0; t < 4; ++t) { n = fw[t] * n + iw[t] * ks[t * 256 + tid]; qn[t] = qs[t * 256 + tid] * n; }
        p.out[O_SN + (bs * 4 + h) * 256 + tid] = n; }
#pragma unroll
    for (int t = 0; t < 4; ++t) { const float r = wsum(qn[t]); if (lane == 0) sc[w * 4 + t] = r; }
    const float* Cin = p.st_C + (size_t)(bs * 4 + h) * 65536; float* Cout = p.out + O_SC + (size_t)(bs * 4 + h) * 65536;
    f32x4 pn[4];
#pragma unroll
    for (int t = 0; t < 4; ++t) pn[t] = (f32x4){0.f, 0.f, 0.f, 0.f};
#pragma unroll 1
    for (int hf = 0; hf < 2; ++hf) {
        const int d0 = w * 32 + hf * 16;
        f32x4 Cr[16];
#pragma unroll
        for (int i = 0; i < 16; ++i) Cr[i] = __builtin_nontemporal_load((const f32x4*)(Cin + (size_t)(d0 + i) * 256 + lane * 4));
#pragma unroll
        for (int t = 0; t < 4; ++t) { const f32x4 vt = *(const f32x4*)(vs + t * 256 + lane * 4) * iw[t]; f32x4 a = pn[t];
#pragma unroll
            for (int i = 0; i < 16; ++i) { Cr[i] = fw[t] * Cr[i] + ks[t * 256 + d0 + i] * vt; a += qs[t * 256 + d0 + i] * Cr[i]; }
            pn[t] = a; }
#pragma unroll
        for (int i = 0; i < 16; ++i) __builtin_nontemporal_store(Cr[i], (f32x4*)(Cout + (size_t)(d0 + i) * 256 + lane * 4));
    }
#pragma unroll
    for (int t = 0; t < 4; ++t) *(f32x4*)(red + (t * 8 + w) * 256 + lane * 4) = pn[t];
    __syncthreads();
    for (int o = tid; o < 1024; o += NTHR) { const int t = o >> 8, e = o & 255; float sacc = 0.f;
#pragma unroll
        for (int g = 0; g < 8; ++g) sacc += red[(t * 8 + g) * 256 + e];
        num[t * 256 + e] = sacc; }
    __syncthreads();
    float hv[4];
    if (tid < 256) {
#pragma unroll
        for (int t = 0; t < 4; ++t) { float den = 0.f;
#pragma unroll
            for (int g = 0; g < 8; ++g) den += sc[g * 4 + t];
            hv[t] = num[t * 256 + tid] / fmaxf(fabsf(den), flo[t]);
            const float r = wsum(hv[t] * hv[t]); if (lane == 0) sc2[w * 4 + t] = r; }
    }
    __syncthreads();
    if (tid < 256) {
#pragma unroll
        for (int t = 0; t < 4; ++t) { const float ss = sc2[t] + sc2[4 + t] + sc2[8 + t] + sc2[12 + t]; const float rs = rsqrtf(ss * (1.f / 256.f) + 1e-6f);
            const float mo = proj[(row0 + t) * PLD + 3072 + h * 256 + tid];
            mix[(row0 + t) * DM + h * 256 + tid] = f2bf(hv[t] * rs * p.m_norm_g[h * 256 + tid] * sigmoidf_(mo)); }
    }
    if (tid == 0) p.out[O_SM + bs * 4 + h] = m;
    __syncthreads();
}

DEVI void gdn_sample(const Params& p, int item, char* smem) {
    int tid = threadIdx.x; asm volatile("" : "+v"(tid));
    const int lane = tid & 63, w = tid >> 6;
    const int bs = item >> 3, h = item & 7;
    float* qkv = (float*)smem;
    float* red = qkv + 1536;
    float* ored = red + 1024;
    float* sc = ored + 2048;
    const float* proj = (const float*)(p.ws + WS_PROJ); const float* gates = (const float*)(p.ws + WS_GATES); u16* mix = (u16*)(p.ws + WS_MIX);
    const size_t row0 = NPT + (size_t)bs * 4;
    if (tid < 384) { const int which = tid >> 7, dch = tid & 127, ch = which * 1024 + h * 128 + dch;
        float xp[7];
#pragma unroll
        for (int j = 0; j < 3; ++j) xp[j] = p.st_conv[(size_t)(bs * 3 + j) * 3072 + ch];
#pragma unroll
        for (int t = 0; t < 4; ++t) xp[3 + t] = proj[(row0 + t) * PLD + 4096 + ch];
        float cw[4];
#pragma unroll
        for (int j = 0; j < 4; ++j) cw[j] = p.conv_w[j * 3072 + ch];
#pragma unroll
        for (int t = 0; t < 4; ++t) qkv[(which * 4 + t) * 128 + dch] = siluf_(cw[0] * xp[t] + cw[1] * xp[t + 1] + cw[2] * xp[t + 2] + cw[3] * xp[t + 3]); }
    float at[4], be[4];
    { const float dtb = p.g_dt_bias[h], Aexp = __expf(p.g_A_log[h]);
#pragma unroll
        for (int t = 0; t < 4; ++t) { at[t] = __expf(-Aexp * softplusf_(gates[(row0 + t) * 24 + 16 + h] + dtb)); be[t] = sigmoidf_(gates[(row0 + t) * 24 + 8 + h]); } }
    __syncthreads();
    { const int which = w >> 2, t = w & 3; float* a = qkv + (which * 4 + t) * 128; const float v0 = a[lane * 2], v1 = a[lane * 2 + 1];
        const float sc_ = rsqrtf(wsum(v0 * v0 + v1 * v1) + 1e-6f) * (which == 0 ? 0.08838834764831845f : 1.f);
        a[lane * 2] = v0 * sc_; a[lane * 2 + 1] = v1 * sc_; }
    __syncthreads();
    const float* qf = qkv; const float* kf = qkv + 512; const float* vf = qkv + 1024;
    const int e = tid & 127, dg = tid >> 7;
    const float* Sin = p.st_S + (size_t)(bs * 8 + h) * 16384; float* Sout = p.out + O_SS + (size_t)(bs * 8 + h) * 16384;
    float Sr[32];
#pragma unroll
    for (int i = 0; i < 32; ++i) Sr[i] = __builtin_nontemporal_load(Sin + (dg * 32 + i) * 128 + e);
#pragma unroll
    for (int t = 0; t < 4; ++t) {
        float r = 0.f;
#pragma unroll
        for (int i = 0; i < 32; ++i) r += kf[t * 128 + dg * 32 + i] * Sr[i];
        red[((t & 1) * 4 + dg) * 128 + e] = r;
        __syncthreads();
        const float rr = red[((t & 1) * 4 + 0) * 128 + e] + red[((t & 1) * 4 + 1) * 128 + e] + red[((t & 1) * 4 + 2) * 128 + e] + red[((t & 1) * 4 + 3) * 128 + e];
        const float u = be[t] * (vf[t * 128 + e] - at[t] * rr);
        float po = 0.f;
#pragma unroll
        for (int i = 0; i < 32; ++i) { Sr[i] = at[t] * Sr[i] + kf[t * 128 + dg * 32 + i] * u; po += qf[t * 128 + dg * 32 + i] * Sr[i]; }
        ored[(t * 4 + dg) * 128 + e] = po;
    }
#pragma unroll
    for (int i = 0; i < 32; ++i) __builtin_nontemporal_store(Sr[i], Sout + (dg * 32 + i) * 128 + e);
    __syncthreads();
    float ov[4];
    if (tid < 128) {
#pragma unroll
        for (int t = 0; t < 4; ++t) { ov[t] = ored[(t * 4 + 0) * 128 + tid] + ored[(t * 4 + 1) * 128 + tid] + ored[(t * 4 + 2) * 128 + tid] + ored[(t * 4 + 3) * 128 + tid];
            const float r = wsum(ov[t] * ov[t]); if (lane == 0) sc[w * 4 + t] = r; }
    }
    __syncthreads();
    if (tid < 128) {
#pragma unroll
        for (int t = 0; t < 4; ++t) { const float rs = rsqrtf((sc[t] + sc[4 + t]) * (1.f / 128.f) + 1e-6f);
            const float gz = proj[(row0 + t) * PLD + 7168 + h * 128 + tid];
            mix[(row0 + t) * DM + 1024 + h * 128 + tid] = f2bf(ov[t] * rs * p.g_norm_g[h * 128 + tid] * siluf_(gz)); }
    }
    __syncthreads();
}

#ifndef SCM
#define SCM 15
#endif
DEVI void phase_scan(const Params& p, char* smem) {
    const int G = gridDim.x, bid = blockIdx.x;
    if (G >= 192) {
        if (bid < 64) { if (SCM & 1) mlstm_seq(p, bid, smem); }
        else if (bid < 128) { if (SCM & 2) gdn_seq(p, bid - 64, smem); }
        unsigned* q = (unsigned*)(p.ws + WS_BAR) + 64;
        volatile unsigned* lq = (volatile unsigned*)(smem + LDS_BYTES - 32);
        for (;;) {
            __syncthreads();
            if (threadIdx.x == 0) *lq = __hip_atomic_fetch_add(q, 1u, __ATOMIC_RELAXED, __HIP_MEMORY_SCOPE_AGENT);
            __syncthreads();
            const unsigned u = *lq;
            if (u >= 1536u) break;
            if (u < 512u) mlstm_sample(p, (int)u, smem); else gdn_sample(p, (int)u - 512, smem);
        }
        pop_late(p, smem, 1 << 30);
        if (p.ph_hi - p.ph_lo == 1) pop_late(p, smem, 1 << 30, 1);
    } else {
        for (int u = bid; u < 128 + 512 + 1024; u += G) {
            if (u < 64) { if (SCM & 1) mlstm_seq(p, u, smem); } else if (u < 128) { if (SCM & 2) gdn_seq(p, u - 64, smem); }
            else if (u < 640) { if (SCM & 4) mlstm_sample(p, u - 128, smem); } else { if (SCM & 8) gdn_sample(p, u - 640, smem); } }
        pop_late(p, smem, 1 << 30);
    }
}

#define XB_TMO      128
#define XB_XCNT(j)  (256  + 64 * (j))
#define XB_XSUB(j)  (1280 + 64 * (j))
#define XB_XGEN(j)  (2304 + 64 * (j))
#define XB_TOP      3328
#define XB_TOPGEN   3392
#define XCD_BAR_WORDS 3456
#define XB_SPIN_CAP (1u << 18)
#define LAS __attribute__((address_space(3)))

__device__ __forceinline__ unsigned xb_ld(unsigned* p)              { return __hip_atomic_load(p, __ATOMIC_RELAXED, __HIP_MEMORY_SCOPE_AGENT); }
__device__ __forceinline__ unsigned xb_add(unsigned* p, unsigned v) { return __hip_atomic_fetch_add(p, v, __ATOMIC_RELAXED, __HIP_MEMORY_SCOPE_AGENT); }
__device__ __forceinline__ unsigned xb_xcc_id() { return (unsigned)__builtin_amdgcn_s_getreg((3 << 11) | 20) & 0xFu; }
#define XB_SPIN(cond, bar) do { unsigned _sp = 0; while (cond) { __builtin_amdgcn_s_sleep(1); \
    if ((++_sp & 255u) == 0u) { if (xb_ld(&(bar)[XB_TMO])) break; if (_sp > XB_SPIN_CAP) { atomicAdd(&(bar)[XB_TMO], 1u); break; } } } } while (0)

struct XcdBarrier {
    unsigned* bar; unsigned x;
    volatile LAS unsigned* st;
};

__device__ __forceinline__ XcdBarrier xcd_barrier_post(unsigned* bar, volatile LAS unsigned* st) {
    XcdBarrier b; b.bar = bar; b.x = xb_xcc_id(); b.st = st;
    if (threadIdx.x == 0) (void)xb_add(&bar[XB_XCNT(b.x)], 1u);
    return b;
}
__device__ __forceinline__ void xcd_barrier_complete(unsigned* bar, unsigned x, unsigned& nloc, unsigned& nx) {
    const unsigned G = gridDim.x * gridDim.y * gridDim.z;
    unsigned sum, cnt, mine, sp = 0u;
    for (;;) {
        sum = 0u; cnt = 0u; mine = 0u;
#pragma unroll
        for (unsigned j = 0; j < 16; ++j) { const unsigned c = xb_ld(&bar[XB_XCNT(j)]); sum += c; cnt += (c > 0u) ? 1u : 0u; mine = (j == x) ? c : mine; }
        if (sum == G) break;
        __builtin_amdgcn_s_sleep(1);
        if ((++sp & 255u) == 0u) { if (xb_ld(&bar[XB_TMO])) break; if (sp > XB_SPIN_CAP) { atomicAdd(&bar[XB_TMO], 1u); break; } }
    }
    nloc = mine > 0u ? mine : 1u; nx = cnt > 0u ? cnt : 1u;
}

__device__ __forceinline__ void xcd_barrier(const XcdBarrier& b) {
    asm volatile("s_waitcnt vmcnt(0)" ::: "memory");
    __syncthreads();
    if (threadIdx.x == 0) {
        unsigned* bar = b.bar;
        __builtin_amdgcn_s_waitcnt(0);
        unsigned nloc = b.st[0], nx = b.st[1];
        if (nloc == 0u) { xcd_barrier_complete(bar, b.x, nloc, nx); b.st[0] = nloc; b.st[1] = nx; }
        const unsigned old = xb_add(&bar[XB_XSUB(b.x)], 1u);
        const unsigned gen = old / nloc;
        if (old + 1u == (gen + 1u) * nloc) {
            __builtin_amdgcn_fence(__ATOMIC_RELEASE, "agent");
            asm volatile("s_waitcnt vmcnt(0)" ::: "memory");
            const unsigned og = xb_add(&bar[XB_TOP], 1u);
            const unsigned tg = og / nx;
            if (og + 1u == (tg + 1u) * nx) xb_add(&bar[XB_TOPGEN], 1u);
            else XB_SPIN(xb_ld(&bar[XB_TOPGEN]) == tg, bar);
            __builtin_amdgcn_fence(__ATOMIC_ACQUIRE, "agent");
            xb_add(&bar[XB_XGEN(b.x)], 1u);
            asm volatile("s_waitcnt vmcnt(0)" ::: "memory");
        } else {
            XB_SPIN(xb_ld(&bar[XB_XGEN(b.x)]) == gen, bar);
            __builtin_amdgcn_fence(__ATOMIC_ACQUIRE, "agent");
            asm volatile("s_waitcnt vmcnt(0)" ::: "memory");
        }
    }
    __syncthreads();
}

__global__ void __launch_bounds__(NTHR) fwd_kernel(Params p) {
    extern __shared__ __attribute__((aligned(16))) char smem[];
    cg::grid_group grid = cg::this_grid();
    const int lo = p.ph_lo, hi = p.ph_hi;
    if (lo == 777) grid.sync();
    volatile LAS unsigned* xst = (volatile LAS unsigned*)(smem + LDS_BYTES - 16);
    if (threadIdx.x < 2) xst[threadIdx.x] = 0u;
    __syncthreads();
    XcdBarrier xbar; xbar.bar = (unsigned*)(p.ws + WS_BAR); xbar.x = 0; xbar.st = xst;
    if (hi - lo > 1) xbar = xcd_barrier_post((unsigned*)(p.ws + WS_BAR), xst);
#ifndef PHMASK
#define PHMASK 0xFFFF
#endif
#define PHASE(k) if (((PHMASK >> (k)) & 1) && lo <= (k) && (k) < hi)
#define SEAM(k) if (lo <= (k) && (k) + 1 < hi) xcd_barrier(xbar)
    PHASE(0) phase_prep(p, smem);
    SEAM(0);
    PHASE(2) phase_modulate(p);
    SEAM(2);
    PHASE(3) { PEpiProj e{(float*)(p.ws + WS_PROJ), (float*)(p.ws + WS_GATES)}; pg8_run((const u16*)(p.ws + WS_AH), (const u16*)(p.ws + WS_WIN), NTOK, 8448, DM, smem, e);
        if (hi - lo > 1 && 4 * (int)gridDim.x + (int)blockIdx.x >= 34 * 33) pop_late(p, smem, 9); }
    SEAM(3);
    PHASE(4) { for (int u = blockIdx.x; u < 1536; u += gridDim.x) { if (u < 512) mlstm_pre(p, u, smem); else gdn_pre(p, u - 512, smem); } }
    SEAM(4);
    PHASE(5) phase_scan(p, smem);
    SEAM(5);
    PHASE(6) phase_post(p);
    SEAM(6);
    PHASE(7) { PEpiRes e{p.x_prompt, p.x_sample, nullptr, (const float*)(p.ws + WS_ADA), 2 * DM, (float*)(p.ws + WS_X1), (float*)(p.ws + WS_PART), DM / 8};
        pg8_run_split((const u16*)(p.ws + WS_MIX), (const u16*)(p.ws + WS_WOUT), DM, DM, 8, smem, e);
        if (hi - lo > 1 && blockIdx.x >= 128) pop_late(p, smem, 2, 1); }
    SEAM(7);
    PHASE(8) phase_ln1(p);
    SEAM(8);
    PHASE(9) { PEpiGU e{(u16*)(p.ws + WS_ACT)}; pg8_run((const u16*)(p.ws + WS_AH), (const u16*)(p.ws + WS_WGU), NTOK, 2 * DFF, DM, smem, e);
        if (hi - lo > 1) { if (5 * (int)gridDim.x + (int)blockIdx.x >= 34 * 44) pop_late(p, smem, 9, 1); pop_late(p, smem, 1 << 30, 1); } }
    SEAM(9);
    PHASE(10) { PEpiRes e{p.x_prompt, p.x_sample, (const float*)(p.ws + WS_X1), (const float*)(p.ws + WS_ADA), 5 * DM, p.out + O_YP, (float*)(p.ws + WS_PART), DFF / 11};
        pg8_run_split((const u16*)(p.ws + WS_ACT), (const u16*)(p.ws + WS_WDOWN), DM, DFF, 11, smem, e); }
    SEAM(10);
    PHASE(11) phase_ln2(p);
}

extern "C" void kernel_launch(void* const* d_in, const int* in_sizes, int n_in, void* d_out, int out_size, void* d_ws, size_t ws_size,
                              hipStream_t stream) {
    static int grid = 0;
    if (grid == 0) {
        if (n_in != 26 || ws_size < WS_END) { fprintf(stderr, "kernel_launch: unexpected n_in %d / ws_size %zu\n", n_in, ws_size); grid = -1; return; }
        int dev = 0, cus = 0, per_cu = 0;
        hipGetDevice(&dev);
        hipDeviceGetAttribute(&cus, hipDeviceAttributeMultiprocessorCount, dev);
        hipFuncSetAttribute((const void*)fwd_kernel, hipFuncAttributeMaxDynamicSharedMemorySize, LDS_BYTES);
        hipOccupancyMaxActiveBlocksPerMultiprocessor(&per_cu, (const void*)fwd_kernel, NTHR, LDS_BYTES);
        if (per_cu < 1) { fprintf(stderr, "kernel_launch: occupancy query says %d blocks/CU\n", per_cu); grid = -1; return; }
        grid = cus * per_cu;
    }
    if (grid < 0) return;
    Params p{};
    const float** f = (const float**)&p;
    for (int i = 0; i < 26; ++i) f[i] = (const float*)d_in[i];
    p.out = (float*)d_out; p.ws = (unsigned char*)d_ws;
    hipMemsetAsync((char*)d_ws + WS_BAR, 0, XCD_BAR_WORDS * 4, stream);
#if FUSED
    p.ph_lo = 0; p.ph_hi = 12;
    void* args[] = {&p};
    hipError_t e = hipLaunchCooperativeKernel((const void*)fwd_kernel, dim3(grid), dim3(NTHR), args, LDS_BYTES, stream);
    if (e != hipSuccess) fprintf(stderr, "cooperative launch failed: %s (grid %d)\n", hipGetErrorString(e), grid);
#else
    for (int ph = 0; ph < 12; ++ph) { p.ph_lo = ph; p.ph_hi = ph + 1; hipLaunchKernelGGL(fwd_kernel, dim3(grid), dim3(NTHR), LDS_BYTES, stream, p); }
#endif
}
```

```cpp
#include <hip/hip_runtime.h>
#include <hip/hip_cooperative_groups.h>
#include <cstdio>
namespace cg = cooperative_groups;

#ifndef FUSED
#define FUSED 1
#endif

#define DEVI __device__ __forceinline__
typedef unsigned short u16;
typedef short bf16x8 __attribute__((ext_vector_type(8)));
typedef float f32x4 __attribute__((ext_vector_type(4)));

constexpr int NTHR = 512;
constexpr int DM = 2048, NTOK = 8704, NPT = 8192, INC = 8216, PLD = 8192, DFF = 5632, ADAW = 12288;
constexpr int LDS_BYTES = 158 * 1024;
constexpr float ALPHA = 1.189207115002721f;

constexpr size_t O_YP = 0, O_PC = 17825792, O_PN = 18874368, O_PM = 18878464, O_PS = 18878480, O_PCONV = 19402768,
                 O_SC = 19439632, O_SN = 52994064, O_SM = 53125136, O_SS = 53125648, O_SCONV = 69902864;
constexpr size_t WS_WOUT = 0, WS_WGU = 8388608, WS_WDOWN = 54525952, WS_ADA = 77594624, WS_AC = 84082688,
                 WS_WIN = 85131264, WS_WADA = 119734272, WS_HBUF = WS_WIN, WS_AH = 170065920, WS_MIX = 205717504,
                 WS_PROJ = 241369088, WS_X1 = 85131264  , WS_ACT = WS_PROJ + 71303168, WS_GATES = 527417344, WS_GQ = 152240128, WS_GW = 169017344, WS_GP = 185794560, WS_GSC = 194183168,
                 WS_GU0 = 528252928, WS_GKW = 545030144, WS_MKT = 561807360, WS_MVT = 578584576,
                 WS_PART = 528252928  , WS_MP = 194510848, WS_MSC = 198705152, WS_MQ = 118685696, WS_BAR = 595361792, WS_END = 595378176;

struct Params {
    const float* x_prompt; const float* x_sample; const float* st_C; const float* st_n; const float* st_m; const float* st_S;
    const float* st_conv; const float* c_prompt; const float* c_sample; const float* w_ada; const float* b_ada; const float* w_in;
    const float* m_i_bias; const float* m_f_bias; const float* m_norm_g; const float* conv_w; const float* g_dt_bias;
    const float* g_A_log; const float* g_norm_g; const float* w_out; const float* ln1_g; const float* ln1_b; const float* w_gu;
    const float* w_down; const float* ln2_g; const float* ln2_b;
    float* out; unsigned char* ws;
    int ph_lo, ph_hi;
};

typedef float f32x2_t __attribute__((ext_vector_type(2)));
typedef __bf16 bf16x2_t __attribute__((ext_vector_type(2)));
DEVI unsigned pack2(float a, float b) { const f32x2_t v = {a, b}; const bf16x2_t r = __builtin_convertvector(v, bf16x2_t); return __builtin_bit_cast(unsigned, r); }
DEVI u16 f2bf(float f) { const __bf16 r = (__bf16)f; return __builtin_bit_cast(u16, r); }
DEVI float bf2f(u16 b) { return __uint_as_float(((unsigned)b) << 16); }
DEVI float wsum(float v) { for (int o = 32; o; o >>= 1) v += __shfl_xor(v, o); return v; }
DEVI float sigmoidf_(float x) { return 1.f / (1.f + __expf(-x)); }
DEVI float siluf_(float x) { return x / (1.f + __expf(-x)); }
DEVI float softplusf_(float x) { return fmaxf(x, 0.f) + log1pf(__expf(-fabsf(x))); }
DEVI float logsigf_(float x) { return fminf(x, 0.f) - log1pf(__expf(-fabsf(x))); }
DEVI f32x4 mfma16(bf16x8 a, bf16x8 b, f32x4 c) { return __builtin_amdgcn_mfma_f32_16x16x32_bf16(a, b, c, 0, 0, 0); }
DEVI int tok_batch(int row) { return row < NPT ? (row >> 11) : 4 + ((row - NPT) >> 2); }
DEVI const float* x_row(const Params& p, int row) { return row < NPT ? p.x_prompt + (size_t)row * DM : p.x_sample + (size_t)(row - NPT) * DM; }

template <int MT, int NT>
DEVI void mma_lds(f32x4 (&acc)[MT][NT], const u16* A, int lda, const u16* B, int ldb, int K, int fr, int fq) {
    for (int k = 0; k < K; k += 32) {
        bf16x8 a[MT], b[NT];
#pragma unroll
        for (int m = 0; m < MT; ++m) a[m] = *(const bf16x8*)(A + (m * 16 + fr) * lda + k + fq * 8);
#pragma unroll
        for (int n = 0; n < NT; ++n) b[n] = *(const bf16x8*)(B + (n * 16 + fr) * ldb + k + fq * 8);
#pragma unroll
        for (int m = 0; m < MT; ++m)
#pragma unroll
            for (int n = 0; n < NT; ++n) acc[m][n] = mfma16(a[m], b[n], acc[m][n]);
    }
}

namespace pg8 {
#define PG8_LAS __attribute__((address_space(3)))
typedef unsigned short bf16_t;
typedef short bf16x8 __attribute__((ext_vector_type(8)));
typedef float f32x4 __attribute__((ext_vector_type(4)));
typedef unsigned u32x4 __attribute__((ext_vector_type(4)));
constexpr int BM = 256, BK = 64, HALF = 128, HTB = HALF * BK * 2  , STAGE_BYTES = 8 * HTB, NXCD = 8, WGM = 8;

__host__ __device__ __forceinline__ int lds_byte(int r, int c) { const int st = (r >> 4) * 2 + (c >> 5), rr = r & 15, cc = c & 31, ob = rr * 64 + cc * 2; return st * 1024 + (ob ^ (((ob >> 9) & 1) << 5)); }
__host__ __device__ __forceinline__ void stage_rc(int b, int& R, int& C) { const int st = b / 1024, sb = b % 1024, swz = sb ^ (((sb >> 9) & 1) << 5); R = (st >> 1) * 16 + swz / 64; C = (st & 1) * 32 + (swz % 64) / 2; }
__host__ __device__ __forceinline__ int perm32(int rho) { const int n = rho >> 4, i = rho & 15; return 8 * (i >> 2) + 4 * n + (i & 3); }

struct Unit { int pm, pn, k0, nt; };
struct Gemm { const bf16_t* A; const bf16_t* Bt; int M, N, K; };

struct StaticOrder {
    int nM, nN, nwg, G, c, Kt;
    __host__ __device__ void init(int M, int N, int G_, int c_, int K_ = 0) { nM = M / BM; nN = N / BM; nwg = nM * nN; G = G_; c = c_; Kt = K_ / BK; }
    __host__ __device__ bool next(int i, Unit& u) const {
        const long L = (long)i * G + c; if (L >= nwg) return false;
        int wgid = (int)L; { const int q = nwg / NXCD, r = nwg % NXCD, xcd = wgid % NXCD, off = wgid / NXCD; wgid = (xcd < r ? xcd * (q + 1) : r * (q + 1) + (xcd - r) * q) + off; }
        const int nig = WGM * nN, gid = wgid / nig, fm = gid * WGM, gsz = (nM - fm) < WGM ? (nM - fm) : WGM;
        u.pm = fm + ((wgid % nig) % gsz); u.pn = (wgid % nig) / gsz; u.k0 = 0; u.nt = Kt; return true;
    }
    __device__ __forceinline__ void a_ready(const Unit&) const {}
    __device__ __forceinline__ void done(const Unit&) const {}
};
__device__ __forceinline__ unsigned cvt_pk_bf16(float lo, float hi) { unsigned r; asm volatile("v_cvt_pk_bf16_f32 %0, %1, %2" : "=v"(r) : "v"(lo), "v"(hi)); return r; }
template <class Epi, class Sched, bool STAMP = false>
__device__ __forceinline__ void gemm_phase(PG8_LAS unsigned char* lds, const Gemm g, const Sched& S, const Epi& E, unsigned long long* stamps) {
    const int tid = threadIdx.x, wid = __builtin_amdgcn_readfirstlane(tid >> 6), lane = tid & 63, wr = wid >> 2, wc = wid & 3, fr = lane & 15, fq = lane >> 4;
    const int K = g.K;
    int ts_lo = 0, ts_hi = 0, nts = 0; const unsigned long long rt_entry = STAMP ? (unsigned long long)wall_clock64() : 0ull;
#define PG8_STAMP() do { if (STAMP && wid == 0 && nts < 64) { const unsigned long long _c = (unsigned long long)clock64(); \
        ts_lo = (lane == nts) ? (int)(unsigned)_c : ts_lo; ts_hi = (lane == nts) ? (int)(unsigned)(_c >> 32) : ts_hi; ++nts; } } while (0)
    PG8_STAMP();
    unsigned voffA[2], voffB[2];
#pragma unroll
    for (int i = 0; i < 2; ++i) { int R, C; stage_rc(tid * 16 + i * 8192, R, C); const int Rb = Epi::PERM ? ((R & ~31) + perm32(R & 31)) : R;
        voffA[i] = (unsigned)(R * K + C) * 2u; voffB[i] = (unsigned)(Rb * K + C) * 2u; }
    const size_t kstep = (size_t)(BK * 2);
    const size_t hstep = (size_t)HALF * K * 2;
    const size_t tstep = 2 * hstep;
    const unsigned ldsw = (unsigned)wid * 1024u;
    const int aoff = lds_byte(wr * 64 + fr, fq * 8), boff = lds_byte(wc * 32 + fr, fq * 8);
#define PG8_SA(b, h) (((b) * 2 + (h)) * HTB)
#define PG8_SB(b, h) ((4 + (b) * 2 + (h)) * HTB)
#define PG8_STAGE(bufoff, gbase, voff) do { _Pragma("unroll") for (int _i = 0; _i < 2; ++_i) \
        __builtin_amdgcn_global_load_lds((const unsigned*)((const char*)(gbase) + (voff)[_i]), (PG8_LAS unsigned*)(lds + (bufoff) + ldsw + _i * 8192), 16, 0, 0); } while (0)
#define PG8_LDA(dst, b, h) do { _Pragma("unroll") for (int m = 0; m < 4; ++m) _Pragma("unroll") for (int k = 0; k < 2; ++k) dst[m][k] = *(const PG8_LAS bf16x8*)(lds + PG8_SA(b, h) + aoff + m * 2048 + k * 1024); } while (0)
#define PG8_LDB(dst, b, h) do { _Pragma("unroll") for (int n = 0; n < 2; ++n) _Pragma("unroll") for (int k = 0; k < 2; ++k) dst[n][k] = *(const PG8_LAS bf16x8*)(lds + PG8_SB(b, h) + boff + n * 2048 + k * 1024); } while (0)
#define PG8_MMA(ai, bj, At, Bt) do { __builtin_amdgcn_s_setprio(1); _Pragma("unroll") for (int m = 0; m < 4; ++m) _Pragma("unroll") for (int n = 0; n < 2; ++n) _Pragma("unroll") for (int k = 0; k < 2; ++k) \
        acc[ai][bj][m][n] = __builtin_amdgcn_mfma_f32_16x16x32_bf16(Bt[n][k], At[m][k], acc[ai][bj][m][n], 0, 0, 0); __builtin_amdgcn_s_setprio(0); } while (0)
#define PG8_WAIT_V(n) asm volatile("s_waitcnt vmcnt(" #n ")" ::: "memory")
#define PG8_WAIT_L(n) asm volatile("s_waitcnt lgkmcnt(" #n ")" ::: "memory")
#define PG8_BAR __builtin_amdgcn_s_barrier()
#define PG8_SCHED __builtin_amdgcn_sched_barrier(0)
    Unit cur, nxt; int ui = 0;
    if (!S.next(0, cur)) return;
    f32x4 acc[2][2][4][2];
#pragma unroll
    for (int a = 0; a < 2; ++a)
#pragma unroll
        for (int b = 0; b < 2; ++b)
#pragma unroll
            for (int m = 0; m < 4; ++m)
#pragma unroll
                for (int n = 0; n < 2; ++n) acc[a][b][m][n] = (f32x4){0.f, 0.f, 0.f, 0.f};
    bf16x8 At[4][2], B0[2][2], B1[2][2];
    const char* cA = (const char*)g.A + (size_t)cur.pm * tstep + (size_t)cur.k0 * 2; const char* cB = (const char*)g.Bt + (size_t)cur.pn * tstep + (size_t)cur.k0 * 2;
    S.a_ready(cur);
    PG8_STAGE(PG8_SB(0, 0), cB, voffB); PG8_STAGE(PG8_SA(0, 0), cA, voffA); PG8_STAGE(PG8_SB(0, 1), cB + hstep, voffB); PG8_STAGE(PG8_SA(0, 1), cA + hstep, voffA);
    if (wr == 1) PG8_BAR;
    PG8_WAIT_V(4); PG8_BAR;
    PG8_STAGE(PG8_SB(1, 0), cB + kstep, voffB); PG8_STAGE(PG8_SA(1, 0), cA + kstep, voffA); PG8_STAGE(PG8_SB(1, 1), cB + hstep + kstep, voffB);
    PG8_WAIT_V(6); PG8_BAR;
    PG8_STAMP();
    for (;;) {
        const bool has_next = S.next(ui + 1, nxt);
        const char* nA = has_next ? (const char*)g.A + (size_t)nxt.pm * tstep + (size_t)nxt.k0 * 2 : cA; const char* nB = has_next ? (const char*)g.Bt + (size_t)nxt.pn * tstep + (size_t)nxt.k0 * 2 : cB;
        const int nt = cur.nt;
        for (int t = 0; t < nt; t += 2) {
            const bool last = (t == nt - 2);
            const char* a1 = cA + (size_t)(t + 1) * kstep;
            const char* a2 = last ? nA : cA + (size_t)(t + 2) * kstep; const char* b2 = last ? nB : cB + (size_t)(t + 2) * kstep;
            const char* a3 = a2 + kstep; const char* b3 = b2 + kstep;
            if (last && has_next) S.a_ready(nxt);
            PG8_LDB(B0, 0, 0); PG8_SCHED; PG8_LDA(At, 0, 0); PG8_STAGE(PG8_SA(1, 1), a1 + hstep, voffA);
            PG8_WAIT_L(8); PG8_BAR; PG8_WAIT_L(0); PG8_MMA(0, 0, At, B0); PG8_BAR; PG8_SCHED;
            PG8_LDB(B1, 0, 1); PG8_STAGE(PG8_SB(0, 0), b2, voffB);
            PG8_BAR; PG8_WAIT_L(0); PG8_MMA(0, 1, At, B1); PG8_BAR;
            PG8_LDA(At, 0, 1); PG8_STAGE(PG8_SA(0, 0), a2, voffA);
            PG8_BAR; PG8_WAIT_L(0); PG8_MMA(1, 0, At, B0); PG8_BAR; PG8_SCHED;
            PG8_STAGE(PG8_SB(0, 1), b2 + hstep, voffB);
            PG8_WAIT_V(6); PG8_BAR; PG8_MMA(1, 1, At, B1); PG8_BAR;
            PG8_LDB(B0, 1, 0); PG8_SCHED; PG8_LDA(At, 1, 0); PG8_STAGE(PG8_SA(0, 1), a2 + hstep, voffA);
            PG8_WAIT_L(8); PG8_BAR; PG8_WAIT_L(0); PG8_MMA(0, 0, At, B0); PG8_BAR; PG8_SCHED;
            PG8_LDB(B1, 1, 1); PG8_STAGE(PG8_SB(1, 0), b3, voffB);
            PG8_BAR; PG8_WAIT_L(0); PG8_MMA(0, 1, At, B1); PG8_BAR;
            PG8_LDA(At, 1, 1); PG8_STAGE(PG8_SA(1, 0), a3, voffA);
            PG8_BAR; PG8_WAIT_L(0); PG8_MMA(1, 0, At, B0); PG8_BAR; PG8_SCHED;
            PG8_STAGE(PG8_SB(1, 1), b3 + hstep, voffB);
            PG8_WAIT_V(6); PG8_BAR; PG8_MMA(1, 1, At, B1); PG8_BAR;
        }
        PG8_STAMP();
        if constexpr (!Epi::AFTER_DRAIN) { E(acc, cur, wr, wc, fr, fq); S.done(cur); }
        PG8_STAMP();
        if (!has_next) break;
#pragma unroll
        for (int a = 0; a < 2; ++a)
#pragma unroll
            for (int b = 0; b < 2; ++b)
#pragma unroll
                for (int m = 0; m < 4; ++m)
#pragma unroll
                    for (int n = 0; n < 2; ++n) acc[a][b][m][n] = (f32x4){0.f, 0.f, 0.f, 0.f};
        cur = nxt; cA = nA; cB = nB; ++ui;
    }
    PG8_WAIT_V(0);
    if (wr == 0) PG8_BAR;
    PG8_BAR;
    if constexpr (Epi::AFTER_DRAIN) { E.fused(acc, cur, wr, wc, fr, fq, lds, wid, lane); S.done(cur); }
    PG8_STAMP();
    if (STAMP && wid == 0) { stamps[lane] = lane < nts ? (((unsigned long long)(unsigned)ts_hi << 32) | (unsigned)ts_lo) : 0ull;
        if (lane == 62) stamps[62] = rt_entry; if (lane == 63) stamps[63] = (unsigned long long)wall_clock64(); }
#undef PG8_STAMP
#undef PG8_SA
#undef PG8_SB
#undef PG8_STAGE
#undef PG8_LDA
#undef PG8_LDB
#undef PG8_MMA
#undef PG8_WAIT_V
#undef PG8_WAIT_L
#undef PG8_BAR
#undef PG8_SCHED
}
}

DEVI void transpose_tile4(const float* src, int ldsrc, int nvalid, int k0, int c00, int c01, int c02, int c03, u16* dst, int ldd, u16* t) {
    int tid = threadIdx.x; asm volatile("" : "+v"(tid));
    const int kr = tid >> 4, n4 = (tid & 15) * 4;
    float4 v[4][2];
#pragma unroll
    for (int q = 0; q < 4; ++q) { const int c0 = q == 0 ? c00 : q == 1 ? c01 : q == 2 ? c02 : c03;
#pragma unroll
        for (int i = 0; i < 2; ++i) { v[q][i] = make_float4(0.f, 0.f, 0.f, 0.f);
            if (c0 + n4 < nvalid) { const f32x4 t4 = __builtin_nontemporal_load((const f32x4*)(src + (size_t)(k0 + kr + 32 * i) * ldsrc + c0 + n4)); v[q][i] = make_float4(t4[0], t4[1], t4[2], t4[3]); } } }
#pragma unroll
    for (int q = 0; q < 4; ++q)
#pragma unroll
        for (int i = 0; i < 2; ++i) { const int k = kr + 32 * i; u16* tq = t + q * 64 * 72;
            tq[(n4 + 0) * 72 + k] = f2bf(v[q][i].x); tq[(n4 + 1) * 72 + k] = f2bf(v[q][i].y); tq[(n4 + 2) * 72 + k] = f2bf(v[q][i].z); tq[(n4 + 3) * 72 + k] = f2bf(v[q][i].w); }
    __syncthreads();
#pragma unroll
    for (int q = 0; q < 4; ++q) { const int n = tid >> 3, kc = tid & 7;
        *(uint4*)(dst + (size_t)(q * 64 + n) * ldd + k0 + kc * 8) = *(const uint4*)(t + q * 64 * 72 + n * 72 + kc * 8); }
    __syncthreads();
}

DEVI void ada_job(const Params& p, int job, char* smem) {
    int tid = threadIdx.x; asm volatile("" : "+v"(tid));
    const int lane = tid & 63, w = tid >> 6, fr = lane & 15, fq = lane >> 4;
    u16* T = (u16*)smem;
    const int n0 = job * 64;
    float* ada = (float*)(p.ws + WS_ADA);
    f32x4 acc0[4], acc1[4];
#pragma unroll
    for (int n = 0; n < 4; ++n) acc0[n] = acc1[n] = (f32x4){0.f, 0.f, 0.f, 0.f};
    const int kr = tid >> 4, n4 = (tid & 15) * 4;
    const int r0 = 16 * w + fr;
    const float* c0 = (r0 < 4 ? p.c_prompt + (size_t)r0 * DM : p.c_sample + (size_t)(r0 - 4) * DM) + fq * 8;
    const bool v1 = (fr < 4);
    const float* c1 = p.c_sample + (size_t)(124 + (v1 ? fr : 0)) * DM + fq * 8;
    const float* wsrc = p.w_ada + (size_t)kr * ADAW + n0 + n4;
    float4 wv[4][2];
#pragma unroll
    for (int q = 0; q < 4; ++q)
#pragma unroll
        for (int i = 0; i < 2; ++i) { const f32x4 t4 = __builtin_nontemporal_load((const f32x4*)(wsrc + (size_t)(q * 64 + 32 * i) * ADAW)); wv[q][i] = make_float4(t4[0], t4[1], t4[2], t4[3]); }
    for (int gk = 0; gk < 8; ++gk) {
#pragma unroll
        for (int q = 0; q < 4; ++q)
#pragma unroll
            for (int i = 0; i < 2; ++i) { const int k = kr + 32 * i; u16* tq = T + q * 64 * 72;
                tq[(n4 + 0) * 72 + k] = f2bf(wv[q][i].x); tq[(n4 + 1) * 72 + k] = f2bf(wv[q][i].y); tq[(n4 + 2) * 72 + k] = f2bf(wv[q][i].z); tq[(n4 + 3) * 72 + k] = f2bf(wv[q][i].w); }
        __syncthreads();
        if (gk + 1 < 8) {
#pragma unroll
            for (int q = 0; q < 4; ++q)
#pragma unroll
                for (int i = 0; i < 2; ++i) { const f32x4 t4 = __builtin_nontemporal_load((const f32x4*)(wsrc + (size_t)((gk + 1) * 256 + q * 64 + 32 * i) * ADAW)); wv[q][i] = make_float4(t4[0], t4[1], t4[2], t4[3]); }
        }
#pragma unroll
        for (int q = 0; q < 4; ++q) { const int kt = gk * 4 + q; const u16* Tc = T + q * 64 * 72;
            bf16x8 a0[2], a1[2];
#pragma unroll
            for (int k2 = 0; k2 < 2; ++k2) { const f32x4 x0 = *(const f32x4*)(c0 + kt * 64 + k2 * 32), x1 = *(const f32x4*)(c0 + kt * 64 + k2 * 32 + 4);
                bf16x8 qq; qq[0] = (short)f2bf(siluf_(x0[0])); qq[1] = (short)f2bf(siluf_(x0[1])); qq[2] = (short)f2bf(siluf_(x0[2])); qq[3] = (short)f2bf(siluf_(x0[3]));
                qq[4] = (short)f2bf(siluf_(x1[0])); qq[5] = (short)f2bf(siluf_(x1[1])); qq[6] = (short)f2bf(siluf_(x1[2])); qq[7] = (short)f2bf(siluf_(x1[3])); a0[k2] = qq; }
            if (w == 0) {
#pragma unroll
                for (int k2 = 0; k2 < 2; ++k2) { const f32x4 x0 = *(const f32x4*)(c1 + kt * 64 + k2 * 32), x1 = *(const f32x4*)(c1 + kt * 64 + k2 * 32 + 4);
                    bf16x8 qq; qq[0] = (short)f2bf(siluf_(x0[0])); qq[1] = (short)f2bf(siluf_(x0[1])); qq[2] = (short)f2bf(siluf_(x0[2])); qq[3] = (short)f2bf(siluf_(x0[3]));
                    qq[4] = (short)f2bf(siluf_(x1[0])); qq[5] = (short)f2bf(siluf_(x1[1])); qq[6] = (short)f2bf(siluf_(x1[2])); qq[7] = (short)f2bf(siluf_(x1[3]));
#pragma unroll
                    for (int e = 0; e < 8; ++e) qq[e] = v1 ? qq[e] : (short)0;
                    a1[k2] = qq; }
            }
#pragma unroll
            for (int k2 = 0; k2 < 2; ++k2)
#pragma unroll
                for (int n = 0; n < 4; ++n) { const bf16x8 bb = *(const bf16x8*)(Tc + (n * 16 + fr) * 72 + k2 * 32 + fq * 8);
                    acc0[n] = mfma16(a0[k2], bb, acc0[n]); if (w == 0) acc1[n] = mfma16(a1[k2], bb, acc1[n]); }
        }
        __syncthreads();
    }
#pragma unroll
    for (int n = 0; n < 4; ++n) { const int col = n0 + n * 16 + fr; const float bias = p.b_ada[col];
#pragma unroll
        for (int j = 0; j < 4; ++j) { ada[(size_t)(16 * w + fq * 4 + j) * ADAW + col] = acc0[n][j] + bias;
            if (w == 0 && fq == 0) ada[(size_t)(128 + j) * ADAW + col] = acc1[n][j] + bias; } }
    __syncthreads();
}

DEVI void phase_prep(const Params& p, char* smem) {
    u16* t = (u16*)smem;
    u16* WinT = (u16*)(p.ws + WS_WIN);
    constexpr int JA = 192, JB = 32 * 33;
    constexpr int TOT = JA + JB;
    for (int job = blockIdx.x; job < TOT; job += gridDim.x) {
        int j = job;
        if (j < JA) { ada_job(p, j, smem); continue; }
        j -= JA;
        { const int kt = j & 31, rg = j >> 5, c = rg * 256; transpose_tile4(p.w_in, INC, INC, kt * 64, c, c + 64, c + 128, c + 192, WinT + (size_t)rg * 256 * DM, DM, t); }
    }
}
constexpr int N_LATE_TR = 32 * 8 + 32 * 44 + 88 * 8;
DEVI void late_transpose(const Params& p, int j, char* smem) {
    u16* t = (u16*)smem; u16* WoutT = (u16*)(p.ws + WS_WOUT); u16* WguT = (u16*)(p.ws + WS_WGU); u16* WdownT = (u16*)(p.ws + WS_WDOWN);
    if (j < 32 * 8) { const int kt = j & 31, rg = j >> 5, c = rg * 256; transpose_tile4(p.w_out, DM, DM, kt * 64, c, c + 64, c + 128, c + 192, WoutT + (size_t)rg * 256 * DM, DM, t); return; }
    j -= 32 * 8;
    if (j < 32 * 44) { const int kt = j & 31, jj = j >> 5;
        transpose_tile4(p.w_gu, 2 * DFF, 2 * DFF, kt * 64, 128 * jj, 128 * jj + 64, DFF + 128 * jj, DFF + 128 * jj + 64, WguT + (size_t)jj * 256 * DM, DM, t); return; }
    j -= 32 * 44;
    { const int kt = j % 88, rg = j / 88, c = rg * 256; transpose_tile4(p.w_down, DM, DM, kt * 64, c, c + 64, c + 128, c + 192, WdownT + (size_t)rg * 256 * DFF, DFF, t); }
}
DEVI void pop_late(const Params& p, char* smem, int maxjobs, int list = 0) {
    unsigned* q2 = (unsigned*)(p.ws + WS_BAR) + 96 + 4 * list;
    const unsigned base = list ? 32 * 8 + 32 * 44 : 0, cnt = list ? 88 * 8 : 32 * 8 + 32 * 44;
    volatile unsigned* lq = (volatile unsigned*)(smem + LDS_BYTES - 32);
    for (int n = 0; n < maxjobs; ++n) {
        __syncthreads();
        if (threadIdx.x == 0) *lq = __hip_atomic_fetch_add(q2, 1u, __ATOMIC_RELAXED, __HIP_MEMORY_SCOPE_AGENT);
        __syncthreads();
        const unsigned u = *lq;
        if (u >= cnt) break;
        late_transpose(p, (int)(base + u), smem);
    }
    __syncthreads();
}

struct PEpiProj { static constexpr bool PERM = false, AFTER_DRAIN = false; float* C; float* gates;
    DEVI void operator()(const pg8::f32x4 (&acc)[2][2][4][2], const pg8::Unit& u, int wr, int wc, int fr, int fq) const {
        const int row0 = u.pm * 256 + wr * 64 + fr, col0 = u.pn * 256 + wc * 32 + 4 * fq;
        if (u.pn == 32) {
            if (wc == 0) {
#pragma unroll
                for (int ai = 0; ai < 2; ++ai)
#pragma unroll
                    for (int m = 0; m < 4; ++m) { float* gp = gates + (size_t)(row0 + ai * 128 + m * 16) * 24 + 4 * fq;
                        *(f32x4*)gp = acc[ai][0][m][0]; if (fq < 2) *(f32x4*)(gp + 16) = acc[ai][0][m][1]; }
            }
            return;
        }
#pragma unroll
        for (int ai = 0; ai < 2; ++ai)
#pragma unroll
            for (int m = 0; m < 4; ++m) { float* rowp = C + (size_t)(row0 + ai * 128 + m * 16) * PLD + col0;
#pragma unroll
                for (int bj = 0; bj < 2; ++bj)
#pragma unroll
                    for (int n = 0; n < 2; ++n) *(f32x4*)(rowp + bj * 128 + n * 16) = acc[ai][bj][m][n]; }
    } };
struct PEpiRes { static constexpr bool PERM = false, AFTER_DRAIN = false;
    const float* xp; const float* xs; const float* res; const float* ada; int gofs; float* out; float* part; int klen;
    DEVI void operator()(const pg8::f32x4 (&acc)[2][2][4][2], const pg8::Unit& u, int wr, int wc, int fr, int fq) const {
        const int row0 = u.pm * 256 + wr * 64 + fr, col0 = u.pn * 256 + wc * 32 + 4 * fq;
        const bool sliced = (u.pm >= 32);
#pragma unroll
        for (int ai = 0; ai < 2; ++ai)
#pragma unroll
            for (int m = 0; m < 4; ++m) { const int row = row0 + ai * 128 + m * 16; const int b = tok_batch(row);
                const float* rp = res ? res + (size_t)row * DM : (row < NPT ? xp + (size_t)row * DM : xs + (size_t)(row - NPT) * DM);
                const float* gp = ada + (size_t)b * ADAW + gofs; float* op = out + (size_t)row * DM;
#pragma unroll
                for (int bj = 0; bj < 2; ++bj)
#pragma unroll
                    for (int n = 0; n < 2; ++n) { const int col = col0 + bj * 128 + n * 16;
                        const f32x4 g = *(const f32x4*)(gp + col);
                        if (sliced) {
                            *(f32x4*)(part + ((size_t)(u.k0 / klen) * 512 + (row - NPT)) * DM + col) = acc[ai][bj][m][n];
                        } else { const f32x4 r = *(const f32x4*)(rp + col);
                            *(f32x4*)(op + col) = ALPHA * r + (1.f + g) * acc[ai][bj][m][n]; } } }
    } };
struct PEpiGU { static constexpr bool PERM = true, AFTER_DRAIN = false; u16* act;
    DEVI void operator()(const pg8::f32x4 (&acc)[2][2][4][2], const pg8::Unit& u, int wr, int wc, int fr, int fq) const {
        const int row0 = u.pm * 256 + wr * 64 + fr, col0 = u.pn * 128 + wc * 32 + 8 * fq;
#pragma unroll
        for (int ai = 0; ai < 2; ++ai)
#pragma unroll
            for (int m = 0; m < 4; ++m) { const int row = row0 + ai * 128 + m * 16;
                const f32x4 g0 = acc[ai][0][m][0], g1 = acc[ai][0][m][1], u0 = acc[ai][1][m][0], u1 = acc[ai][1][m][1];
                uint4 w; w.x = pack2(siluf_(g0[0]) * u0[0], siluf_(g0[1]) * u0[1]); w.y = pack2(siluf_(g0[2]) * u0[2], siluf_(g0[3]) * u0[3]);
                w.z = pack2(siluf_(g1[0]) * u1[0], siluf_(g1[1]) * u1[1]); w.w = pack2(siluf_(g1[2]) * u1[2], siluf_(g1[3]) * u1[3]);
                *(uint4*)(act + (size_t)row * DFF + col0) = w; }
    } };
struct SplitOrder : pg8::StaticOrder {
    int KS, Kfull;
    __device__ void init2(int N, int K, int G_, int c_, int KS_) { init(NPT, N, G_, c_, K); KS = KS_; Kfull = K; }
    __device__ bool next(int i, pg8::Unit& u) const {
        if (i == 0) return pg8::StaticOrder::next(0, u);
        if (i > 1 || c >= 16 * KS) return false;
        const int slice = c % KS, tile = c / KS;
        u.pm = 32 + (tile >> 3); u.pn = tile & 7; u.k0 = slice * (Kfull / KS); u.nt = Kfull / KS / 64; return true;
    }
};
template <class Epi>
DEVI void pg8_run_split(const u16* A, const u16* Bt, int N, int K, int KS, char* smem, const Epi& e) {
    pg8::Gemm g{(const pg8::bf16_t*)A, (const pg8::bf16_t*)Bt, NTOK, N, K}; SplitOrder S; S.init2(N, K, (int)gridDim.x, (int)blockIdx.x, KS);
    pg8::gemm_phase<Epi, SplitOrder, false>((PG8_LAS unsigned char*)smem, g, S, e, nullptr);
}
template <class Epi>
DEVI void pg8_run(const u16* A, const u16* Bt, int M, int N, int K, char* smem, const Epi& e) {
    pg8::Gemm g{(const pg8::bf16_t*)A, (const pg8::bf16_t*)Bt, M, N, K}; pg8::StaticOrder S; S.init(M, N, (int)gridDim.x, (int)blockIdx.x, K);
    pg8::gemm_phase<Epi, pg8::StaticOrder, false>((PG8_LAS unsigned char*)smem, g, S, e, nullptr);
}

DEVI void modulate_row(const Params& p, int row, int lane) {
    const float* ada = (const float*)(p.ws + WS_ADA); u16* Ah = (u16*)(p.ws + WS_AH);
    const float* xr = x_row(p, row); const float* ar = ada + (size_t)tok_batch(row) * ADAW;
#pragma unroll
    for (int i = 0; i < 8; ++i) { const int col = i * 256 + lane * 4;
        const f32x4 x = __builtin_nontemporal_load((const f32x4*)(xr + col)), sh = *(const f32x4*)(ar + col), sc = *(const f32x4*)(ar + DM + col);
        const f32x4 h = x * (1.f + sc) + sh; uint2 w; w.x = pack2(h[0], h[1]); w.y = pack2(h[2], h[3]);
        *(uint2*)(Ah + (size_t)row * DM + col) = w; }
}
DEVI void phase_modulate(const Params& p) {
    const int lane = threadIdx.x & 63, gw = blockIdx.x * 8 + (threadIdx.x >> 6), nw = gridDim.x * 8;
    for (int sr = gw; sr < 4 * (NTOK - NPT); sr += nw) if ((sr & 3) == 0) modulate_row(p, NPT + (sr >> 2), lane);
    for (int row = gw; row < NPT; row += nw) modulate_row(p, row, lane);
}
DEVI void ln_row(f32x4 (&v)[8], const float* g, const float* bta, int lane) {
    float s = 0.f;
#pragma unroll
    for (int i = 0; i < 8; ++i) s += v[i][0] + v[i][1] + v[i][2] + v[i][3];
    const float mu = wsum(s) * (1.f / DM);
    float q = 0.f;
#pragma unroll
    for (int i = 0; i < 8; ++i) { v[i] = v[i] - mu; q += v[i][0] * v[i][0] + v[i][1] * v[i][1] + v[i][2] * v[i][2] + v[i][3] * v[i][3]; }
    const float rs = rsqrtf(wsum(q) * (1.f / DM) + 1e-5f);
#pragma unroll
    for (int i = 0; i < 8; ++i) { const int col = i * 256 + lane * 4; v[i] = v[i] * rs * *(const f32x4*)(g + col) + *(const f32x4*)(bta + col); }
}
DEVI void ln1_row(const Params& p, int row, int lane) {
    const float* ada = (const float*)(p.ws + WS_ADA); u16* Ah = (u16*)(p.ws + WS_AH); float* x1 = (float*)(p.ws + WS_X1);
    float* xr = x1 + (size_t)row * DM; const float* ar = ada + (size_t)tok_batch(row) * ADAW;
    f32x4 v[8];
    if (row < NPT) {
#pragma unroll
        for (int i = 0; i < 8; ++i) v[i] = *(const f32x4*)(xr + i * 256 + lane * 4);
    } else { const float* part = (const float*)(p.ws + WS_PART) + (size_t)(row - NPT) * DM; const float* xs = p.x_sample + (size_t)(row - NPT) * DM;
#pragma unroll
        for (int i = 0; i < 8; ++i) { const int col = i * 256 + lane * 4; f32x4 a = {0.f, 0.f, 0.f, 0.f};
#pragma unroll
            for (int k = 0; k < 8; ++k) a += *(const f32x4*)(part + (size_t)k * 512 * DM + col);
            v[i] = ALPHA * *(const f32x4*)(xs + col) + (1.f + *(const f32x4*)(ar + 2 * DM + col)) * a; } }
    ln_row(v, p.ln1_g, p.ln1_b, lane);
#pragma unroll
    for (int i = 0; i < 8; ++i) { const int col = i * 256 + lane * 4; *(f32x4*)(xr + col) = v[i];
        const f32x4 sh = *(const f32x4*)(ar + 3 * DM + col), sc = *(const f32x4*)(ar + 4 * DM + col);
        const f32x4 h = v[i] * (1.f + sc) + sh; uint2 w; w.x = pack2(h[0], h[1]); w.y = pack2(h[2], h[3]);
        *(uint2*)(Ah + (size_t)row * DM + col) = w; }
}
DEVI void phase_ln1(const Params& p) {
    const int lane = threadIdx.x & 63, gw = blockIdx.x * 8 + (threadIdx.x >> 6), nw = gridDim.x * 8;
    for (int sr = gw; sr < 4 * (NTOK - NPT); sr += nw) if ((sr & 3) == 0) ln1_row(p, NPT + (sr >> 2), lane);
    for (int row = gw; row < NPT; row += nw) ln1_row(p, row, lane);
}
DEVI void ln2_row(const Params& p, int row, int lane) {
    float* xr = p.out + O_YP + (size_t)row * DM;
    f32x4 v[8];
    if (row < NPT) {
#pragma unroll
        for (int i = 0; i < 8; ++i) v[i] = *(const f32x4*)(xr + i * 256 + lane * 4);
    } else { const float* part = (const float*)(p.ws + WS_PART) + (size_t)(row - NPT) * DM; const float* x1r = (const float*)(p.ws + WS_X1) + (size_t)row * DM;
        const float* ar = (const float*)(p.ws + WS_ADA) + (size_t)tok_batch(row) * ADAW;
#pragma unroll
        for (int i = 0; i < 8; ++i) { const int col = i * 256 + lane * 4; f32x4 a = {0.f, 0.f, 0.f, 0.f};
#pragma unroll
            for (int k = 0; k < 11; ++k) a += *(const f32x4*)(part + (size_t)k * 512 * DM + col);
            v[i] = ALPHA * *(const f32x4*)(x1r + col) + (1.f + *(const f32x4*)(ar + 5 * DM + col)) * a; } }
    ln_row(v, p.ln2_g, p.ln2_b, lane);
#pragma unroll
    for (int i = 0; i < 8; ++i) __builtin_nontemporal_store(v[i], (f32x4*)(xr + i * 256 + lane * 4));
}
DEVI void phase_ln2(const Params& p) {
    const int lane = threadIdx.x & 63, gw = blockIdx.x * 8 + (threadIdx.x >> 6), nw = gridDim.x * 8;
    for (int sr = gw; sr < 4 * (NTOK - NPT); sr += nw) if ((sr & 3) == 0) ln2_row(p, NPT + (sr >> 2), lane);
    for (int row = gw; row < NPT; row += nw) ln2_row(p, row, lane);
}
DEVI void phase_post(const Params& p) {
    const float* proj = (const float*)(p.ws + WS_PROJ); const float* gates = (const float*)(p.ws + WS_GATES); const u16* hbuf = (const u16*)(p.ws + WS_HBUF); u16* mix = (u16*)(p.ws + WS_MIX);
    const int lane = threadIdx.x & 63, gw = blockIdx.x * 8 + (threadIdx.x >> 6), nw = gridDim.x * 8;
    for (int row = gw; row < NPT; row += nw) {
        const u16* hr = hbuf + (size_t)row * DM; const float* pr = proj + (size_t)row * PLD; u16* mr = mix + (size_t)row * DM;
#pragma unroll
        for (int h = 0; h < 4; ++h) { const int col = h * 256 + lane * 4;
            const uint2 hv2 = *(const uint2*)(hr + col); const f32x4 v = {__uint_as_float(hv2.x << 16), __uint_as_float(hv2.x & 0xFFFF0000u), __uint_as_float(hv2.y << 16), __uint_as_float(hv2.y & 0xFFFF0000u)}; const float ss = wsum(v[0] * v[0] + v[1] * v[1] + v[2] * v[2] + v[3] * v[3]);
            const float rs = rsqrtf(ss * (1.f / 256.f) + 1e-6f);
            const f32x4 g = *(const f32x4*)(p.m_norm_g + col), o = *(const f32x4*)(pr + 3072 + col);
            uint2 w; w.x = pack2(v[0] * rs * g[0] * sigmoidf_(o[0]), v[1] * rs * g[1] * sigmoidf_(o[1]));
            w.y = pack2(v[2] * rs * g[2] * sigmoidf_(o[2]), v[3] * rs * g[3] * sigmoidf_(o[3]));
            *(uint2*)(mr + col) = w; }
#pragma unroll
        for (int h = 0; h < 8; ++h) { const int c = h * 128 + lane * 2;
            const unsigned hv1 = *(const unsigned*)(hr + 1024 + c); const float v0 = __uint_as_float(hv1 << 16), v1 = __uint_as_float(hv1 & 0xFFFF0000u); const float ss = wsum(v0 * v0 + v1 * v1);
            const float rs = rsqrtf(ss * (1.f / 128.f) + 1e-6f);
            const float z0 = pr[7168 + c], z1 = pr[7168 + c + 1];
            *(unsigned*)(mr + 1024 + c) = pack2(v0 * rs * p.g_norm_g[c] * siluf_(z0), v1 * rs * p.g_norm_g[c + 1] * siluf_(z1)); }
    }
    const int total = (4 + 128) * 3 * 3072;
    for (int i = blockIdx.x * NTHR + threadIdx.x; i < total; i += gridDim.x * NTHR) {
        const int ch = i % 3072, rj = i / 3072, j = rj % 3, b = rj / 3;
        if (b < 4) p.out[O_PCONV + (size_t)(b * 3 + j) * 3072 + ch] = proj[(size_t)(b * 2048 + 2045 + j) * PLD + 4096 + ch];
        else p.out[O_SCONV + (size_t)((b - 4) * 3 + j) * 3072 + ch] = proj[(size_t)(NPT + (b - 4) * 4 + 1 + j) * PLD + 4096 + ch];
    }
}

DEVI float scan_add(float x, int lane) { for (int o = 1; o < 64; o <<= 1) { const float y = __shfl_up(x, o); if (lane >= o) x += y; } return x; }
DEVI float scan_max(float x, int lane) { for (int o = 1; o < 64; o <<= 1) { const float y = __shfl_up(x, o); if (lane >= o) x = fmaxf(x, y); } return x; }

DEVI void mlstm_pre(const Params& p, int unit, char* smem) {
    int tid = threadIdx.x; asm volatile("" : "+v"(tid));
    const int lane = tid & 63, w = tid >> 6, fr = lane & 15, fq = lane >> 4;
    const int b = unit >> 7, h = (unit >> 5) & 3, c = unit & 31;
    u16* Qs = (u16*)smem;
    u16* Ks = Qs + 64 * 264;
    const float* proj = (const float*)(p.ws + WS_PROJ); const float* gates = (const float*)(p.ws + WS_GATES);
    u16* MP = (u16*)(p.ws + WS_MP) + (size_t)unit * 4096; u16* MKT = (u16*)(p.ws + WS_MKT) + (size_t)unit * 16384; u16* MQ = (u16*)(p.ws + WS_MQ) + (size_t)unit * 16384;
    u16* MVT = (u16*)(p.ws + WS_MVT) + (size_t)unit * 16384; float* MSC = (float*)(p.ws + WS_MSC) + (size_t)unit * 128;
    const size_t row0 = (size_t)b * 2048 + c * 64;
    const float iv = gates[(row0 + lane) * 24 + h] + p.m_i_bias[h];
    const float fv = gates[(row0 + lane) * 24 + 4 + h] + p.m_f_bias[h];
    const float bt = scan_add(logsigf_(fv), lane);
    const float av = iv - bt;
    const float ml = scan_max(av, lane);
    const float wt = __expf(av - __shfl(ml, 63));
    if (w == 0) { MSC[lane] = bt; MSC[64 + lane] = ml; }
    {
        unsigned kt[4][4], vt[4][4];
#pragma unroll
        for (int i = 0; i < 8; ++i) { const int s = w * 8 + i; const float* pr = proj + (row0 + s) * PLD + h * 256 + lane * 4;
            const f32x4 qv = __builtin_nontemporal_load((const f32x4*)(pr)), kv = __builtin_nontemporal_load((const f32x4*)(pr + 1024)) * 0.0625f, vv = __builtin_nontemporal_load((const f32x4*)(pr + 2048));
            uint2 pq; pq.x = pack2(qv[0], qv[1]); pq.y = pack2(qv[2], qv[3]); *(uint2*)(Qs + s * 264 + lane * 4) = pq; *(uint2*)(MQ + s * 256 + lane * 4) = pq;
            uint2 pk; pk.x = pack2(kv[0], kv[1]); pk.y = pack2(kv[2], kv[3]); *(uint2*)(Ks + s * 264 + lane * 4) = pk;
            const float ws_ = __shfl(wt, s);
#pragma unroll
            for (int dd = 0; dd < 4; ++dd) { const unsigned kb = f2bf(kv[dd] * ws_), vb = f2bf(vv[dd]);
                if (i & 1) { kt[dd][i >> 1] |= kb << 16; vt[dd][i >> 1] |= vb << 16; } else { kt[dd][i >> 1] = kb; vt[dd][i >> 1] = vb; } } }
#pragma unroll
        for (int dd = 0; dd < 4; ++dd) {
            *(uint4*)(MKT + (lane * 4 + dd) * 64 + w * 8) = make_uint4(kt[dd][0], kt[dd][1], kt[dd][2], kt[dd][3]);
            *(uint4*)(MVT + (lane * 4 + dd) * 64 + w * 8) = make_uint4(vt[dd][0], vt[dd][1], vt[dd][2], vt[dd][3]); }
    }
    __syncthreads();
    {
        const int mt = w & 3, g = w >> 2;
        f32x4 acc[2]; acc[0] = acc[1] = (f32x4){0.f, 0.f, 0.f, 0.f};
#pragma unroll
        for (int kk = 0; kk < 8; ++kk) { const bf16x8 aQ = *(const bf16x8*)(Qs + (mt * 16 + fr) * 264 + kk * 32 + fq * 8);
#pragma unroll
            for (int n = 0; n < 2; ++n) acc[n] = mfma16(*(const bf16x8*)(Ks + ((g * 2 + n) * 16 + fr) * 264 + kk * 32 + fq * 8), aQ, acc[n]); }
        const int t = mt * 16 + fr; const float mlt = __shfl(ml, t);
#pragma unroll
        for (int n = 0; n < 2; ++n) { float pv[4];
#pragma unroll
            for (int j = 0; j < 4; ++j) { const int s = (g * 2 + n) * 16 + fq * 4 + j; const float as_ = __shfl(av, s);
                pv[j] = (s <= t) ? acc[n][j] * __expf(as_ - mlt) : 0.f; }
            uint2 pp; pp.x = pack2(pv[0], pv[1]); pp.y = pack2(pv[2], pv[3]);
            *(uint2*)(MP + t * 64 + (g * 2 + n) * 16 + fq * 4) = pp; }
    }
    __syncthreads();
}

struct MlLd { bf16x8 fP[2]; bf16x8 fV[4][2]; bf16x8 fK[2][2]; bf16x8 fQ[8]; float bt, ml; };
DEVI void ml_loadQ(MlLd& L, const Params& p, int unit, int mt, int fr, int fq) {
    const u16* MQ = (const u16*)(p.ws + WS_MQ) + (size_t)unit * 16384;
#pragma unroll
    for (int kk = 0; kk < 8; ++kk) L.fQ[kk] = *(const bf16x8*)(MQ + (mt * 16 + fr) * 256 + kk * 32 + fq * 8);
}
DEVI void ml_loadP(MlLd& L, const Params& p, int unit, int mt, int fr, int fq) {
    const u16* MP = (const u16*)(p.ws + WS_MP) + (size_t)unit * 4096;
#pragma unroll
    for (int k2 = 0; k2 < 2; ++k2) L.fP[k2] = *(const bf16x8*)(MP + (mt * 16 + fr) * 64 + k2 * 32 + fq * 8);
}
DEVI void ml_loadVK(MlLd& L, const Params& p, int unit, int eb, int w, int fr, int fq) {
    const u16* MKT = (const u16*)(p.ws + WS_MKT) + (size_t)unit * 16384; const u16* MVT = (const u16*)(p.ws + WS_MVT) + (size_t)unit * 16384;
#pragma unroll
    for (int k2 = 0; k2 < 2; ++k2) {
#pragma unroll
        for (int m = 0; m < 4; ++m) L.fV[m][k2] = *(const bf16x8*)(MVT + (eb * 64 + m * 16 + fr) * 64 + k2 * 32 + fq * 8);
#pragma unroll
        for (int n = 0; n < 2; ++n) L.fK[n][k2] = *(const bf16x8*)(MKT + (w * 32 + n * 16 + fr) * 64 + k2 * 32 + fq * 8); }
}
DEVI void ml_loadS(MlLd& L, const Params& p, int unit, int lane) {
    const float* MSC = (const float*)(p.ws + WS_MSC) + (size_t)unit * 128; L.bt = MSC[lane]; L.ml = MSC[64 + lane];
}
DEVI void mlstm_load(MlLd& L, const Params& p, int unit, int eb, int lane, int w, int mt, int fr, int fq) {
    ml_loadQ(L, p, unit, mt, fr, fq); ml_loadP(L, p, unit, mt, fr, fq); ml_loadVK(L, p, unit, eb, w, fr, fq); ml_loadS(L, p, unit, lane);
}
DEVI void mlstm_seq(const Params& p, int role, char* smem) {
    const int tid = threadIdx.x, lane0 = tid & 63, w0 = tid >> 6;
    const int b = role >> 4, h = (role >> 2) & 3, eb = role & 3;
    u16* Cts = (u16*)smem;
    for (int i = tid; i < 2 * 80 * 264 / 2; i += NTHR) ((unsigned*)Cts)[i] = 0u;
    u16* hbuf = (u16*)(p.ws + WS_HBUF);
    f32x4 accC[5][2];
#pragma unroll
    for (int m = 0; m < 5; ++m) { accC[m][0] = (f32x4){0.f, 0.f, 0.f, 0.f}; accC[m][1] = (f32x4){0.f, 0.f, 0.f, 0.f}; }
    float mcar = 0.f;
    const int ubase = (b * 4 + h) * 32;
    MlLd L;
    mlstm_load(L, p, ubase, eb, lane0, w0, w0 & 3, lane0 & 15, lane0 >> 4);
    __syncthreads();
    for (int c = 0; c < 32; ++c) {
        int lane = lane0, w = w0; asm volatile("" : "+v"(lane), "+v"(w));
        const int fr = lane & 15, fq = lane >> 4, mt = w & 3, g = w >> 2;
        const size_t row0 = (size_t)b * 2048 + c * 64;
        const u16* Cc = Cts + (c & 1) * 80 * 264; u16* Cn = Cts + ((c & 1) ^ 1) * 80 * 264;
        const float bt = L.bt, ml = L.ml;
        const float mr = fmaxf(ml, mcar);
        const float bL = __shfl(bt, 63), mrL = __shfl(mr, 63), mlL = __shfl(ml, 63);
        const float mnew = bL + mrL, decay = __expf(bL + mcar - mnew), rho = __expf(mlL - mrL);
        const float iw = __expf(mcar - mr), rt = __expf(ml - mr), flo = __expf(-(bt + mr));
        bf16x8 one8;
#pragma unroll
        for (int i = 0; i < 8; ++i) one8[i] = (fr == 0) ? (short)0x3F80 : (short)0;
        const bool more = (c + 1 < 32); const int nu = ubase + c + 1;
        if (more) ml_loadS(L, p, nu, lane);
        f32x4 accH1[3]; accH1[0] = accH1[1] = accH1[2] = (f32x4){0.f, 0.f, 0.f, 0.f};
#pragma unroll
        for (int kk = 0; kk < 8; ++kk) { const bf16x8 q = L.fQ[kk];
#pragma unroll
            for (int n = 0; n < 3; ++n) { const int et = n < 2 ? g * 2 + n : 4;
                accH1[n] = mfma16(q, *(const bf16x8*)(Cc + (et * 16 + fr) * 264 + kk * 32 + fq * 8), accH1[n]); } }
        __builtin_amdgcn_sched_barrier(0);
        if (more) ml_loadQ(L, p, nu, mt, fr, fq);
        __builtin_amdgcn_sched_barrier(0);
        f32x4 accH2[3]; accH2[0] = accH2[1] = accH2[2] = (f32x4){0.f, 0.f, 0.f, 0.f};
#pragma unroll
        for (int k2 = 0; k2 < 2; ++k2) {
#pragma unroll
            for (int n = 0; n < 2; ++n) { bf16x8 bv;
#pragma unroll
                for (int i = 0; i < 8; ++i) bv[i] = g ? L.fV[2 + n][k2][i] : L.fV[n][k2][i];
                accH2[n] = mfma16(L.fP[k2], bv, accH2[n]); }
            accH2[2] = mfma16(L.fP[k2], one8, accH2[2]); }
        __builtin_amdgcn_sched_barrier(0);
        if (more) ml_loadP(L, p, nu, mt, fr, fq);
        __builtin_amdgcn_sched_barrier(0);
#pragma unroll
        for (int j = 0; j < 4; ++j) { const int t = mt * 16 + fq * 4 + j;
            const float iwt = __shfl(iw, t), rtt = __shfl(rt, t), fl = __shfl(flo, t);
            const float h0 = iwt * accH1[0][j] + rtt * accH2[0][j], h1 = iwt * accH1[1][j] + rtt * accH2[1][j], hd = iwt * accH1[2][j] + rtt * accH2[2][j];
            const float den = __shfl(hd, fq * 16); const float dn = fmaxf(fabsf(den), fl);
            hbuf[(row0 + t) * DM + h * 256 + eb * 64 + (g * 2) * 16 + fr] = f2bf(h0 / dn);
            hbuf[(row0 + t) * DM + h * 256 + eb * 64 + (g * 2 + 1) * 16 + fr] = f2bf(h1 / dn); }
        __builtin_amdgcn_sched_barrier(0);
        {
            f32x4 tmp[5][2];
#pragma unroll
            for (int m = 0; m < 5; ++m) { tmp[m][0] = (f32x4){0.f, 0.f, 0.f, 0.f}; tmp[m][1] = (f32x4){0.f, 0.f, 0.f, 0.f}; }
#pragma unroll
            for (int k2 = 0; k2 < 2; ++k2)
#pragma unroll
                for (int m = 0; m < 5; ++m)
#pragma unroll
                    for (int n = 0; n < 2; ++n) tmp[m][n] = mfma16(m < 4 ? L.fV[m < 4 ? m : 0][k2] : one8, L.fK[n][k2], tmp[m][n]);
            __builtin_amdgcn_sched_barrier(0);
            if (more) ml_loadVK(L, p, nu, eb, w, fr, fq);
            __builtin_amdgcn_sched_barrier(0);
#pragma unroll
            for (int m = 0; m < 5; ++m)
#pragma unroll
                for (int n = 0; n < 2; ++n) { accC[m][n] = decay * accC[m][n] + rho * tmp[m][n];
#pragma unroll
                    for (int j = 0; j < 4; ++j) Cn[(m * 16 + fq * 4 + j) * 264 + w * 32 + n * 16 + fr] = f2bf(accC[m][n][j]); }
        }
        __builtin_amdgcn_sched_barrier(0);
        mcar = mnew;
        __syncthreads();
    }
    const int lane = lane0, w = w0, fr = lane & 15, fq = lane >> 4;
    float* pC = p.out + O_PC + (size_t)(b * 4 + h) * 65536;
#pragma unroll
    for (int m = 0; m < 4; ++m)
#pragma unroll
        for (int n = 0; n < 2; ++n) *(f32x4*)(pC + (size_t)(w * 32 + n * 16 + fr) * 256 + eb * 64 + m * 16 + fq * 4) = accC[m][n];
    if (eb == 0 && fq == 0) { p.out[O_PN + (b * 4 + h) * 256 + w * 32 + fr] = accC[4][0][0]; p.out[O_PN + (b * 4 + h) * 256 + w * 32 + 16 + fr] = accC[4][1][0]; }
    if (eb == 0 && tid == 0) p.out[O_PM + b * 4 + h] = mcar;
    __syncthreads();
}

DEVI void gdn_pre(const Params& p, int unit, char* smem) {
    int tid = threadIdx.x; asm volatile("" : "+v"(tid));
    const int lane = tid & 63, w = tid >> 6, fr = lane & 15, fq = lane >> 4;
    const int b = unit >> 8, h = (unit >> 5) & 7, c = unit & 31;
    u16* Ks = (u16*)smem;
    u16* Qs = Ks + 64 * 136;
    u16* KbT = Qs + 64 * 136;
    u16* VbT = KbT + 128 * 72;
    u16* KwT = VbT + 128 * 72;
    u16* Mb = KwT + 128 * 72;
    u16* Mtb = Mb + 2 * 64 * 72;
    u16* Ts = Mtb + 2 * 64 * 72;
    u16* Ps = Ts + 64 * 72;
    const float* proj = (const float*)(p.ws + WS_PROJ); const float* gates = (const float*)(p.ws + WS_GATES);
    u16* GQ = (u16*)(p.ws + WS_GQ) + (size_t)unit * 8192; u16* GW = (u16*)(p.ws + WS_GW) + (size_t)unit * 8192;
    u16* GP = (u16*)(p.ws + WS_GP) + (size_t)unit * 4096; u16* GU0 = (u16*)(p.ws + WS_GU0) + (size_t)unit * 8192;
    u16* GKW = (u16*)(p.ws + WS_GKW) + (size_t)unit * 8192; float* GSC = (float*)(p.ws + WS_GSC) + (size_t)unit * 80;
    const float dtb = p.g_dt_bias[h], Aexp = __expf(p.g_A_log[h]);
    const int mt = w & 3, g = w >> 2;
    const int chq = h * 128 + 2 * lane, chk = 1024 + chq, chv = 2048 + chq;
    const long row0 = (long)b * 2048 + c * 64;
    const float ga = gates[(row0 + lane) * 24 + 16 + h] + dtb;
    const float la = -Aexp * softplusf_(ga);
    const float beta = sigmoidf_(gates[(row0 + lane) * 24 + 8 + h]);
    const float bc = scan_add(la, lane);
    const float bL = __shfl(bc, 63);
    const float eb_ = __expf(bc);
    if (w == 0) { GSC[lane] = eb_; if (lane == 0) GSC[64] = __expf(bL); }
    {
        float2 cq[4], ck[4], cv[4];
#pragma unroll
        for (int j = 0; j < 4; ++j) { cq[j] = *(const float2*)(p.conv_w + j * 3072 + chq); ck[j] = *(const float2*)(p.conv_w + j * 3072 + chk); cv[j] = *(const float2*)(p.conv_w + j * 3072 + chv); }
        float2 rq[11], rk[11], rv[11];
#pragma unroll
        for (int j = 0; j < 11; ++j) { const long tg = (long)c * 64 + w * 8 - 3 + j;
            if (tg >= 0) { const float* pr = proj + ((long)b * 2048 + tg) * PLD + 4096;
                { const f32x2_t a_ = __builtin_nontemporal_load((const f32x2_t*)(pr + chq)), b_ = __builtin_nontemporal_load((const f32x2_t*)(pr + chk)), c_ = __builtin_nontemporal_load((const f32x2_t*)(pr + chv)); rq[j] = make_float2(a_[0], a_[1]); rk[j] = make_float2(b_[0], b_[1]); rv[j] = make_float2(c_[0], c_[1]); } }
            else { rq[j] = make_float2(0.f, 0.f); rk[j] = make_float2(0.f, 0.f); rv[j] = make_float2(0.f, 0.f); } }
        unsigned kb0[4], kb1[4], kw0[4], kw1[4], vb0[4], vb1[4];
#pragma unroll
        for (int i = 0; i < 8; ++i) { const int s = w * 8 + i;
            float yq0 = cq[0].x * rq[i].x + cq[1].x * rq[i + 1].x + cq[2].x * rq[i + 2].x + cq[3].x * rq[i + 3].x;
            float yq1 = cq[0].y * rq[i].y + cq[1].y * rq[i + 1].y + cq[2].y * rq[i + 2].y + cq[3].y * rq[i + 3].y;
            float yk0 = ck[0].x * rk[i].x + ck[1].x * rk[i + 1].x + ck[2].x * rk[i + 2].x + ck[3].x * rk[i + 3].x;
            float yk1 = ck[0].y * rk[i].y + ck[1].y * rk[i + 1].y + ck[2].y * rk[i + 2].y + ck[3].y * rk[i + 3].y;
            float yv0 = cv[0].x * rv[i].x + cv[1].x * rv[i + 1].x + cv[2].x * rv[i + 2].x + cv[3].x * rv[i + 3].x;
            float yv1 = cv[0].y * rv[i].y + cv[1].y * rv[i + 1].y + cv[2].y * rv[i + 2].y + cv[3].y * rv[i + 3].y;
            yq0 = siluf_(yq0); yq1 = siluf_(yq1); yk0 = siluf_(yk0); yk1 = siluf_(yk1); yv0 = siluf_(yv0); yv1 = siluf_(yv1);
            const float rqn = rsqrtf(wsum(yq0 * yq0 + yq1 * yq1) + 1e-6f) * 0.08838834764831845f;
            const float rkn = rsqrtf(wsum(yk0 * yk0 + yk1 * yk1) + 1e-6f);
            yq0 *= rqn; yq1 *= rqn; yk0 *= rkn; yk1 *= rkn;
            *(unsigned*)(Qs + s * 136 + 2 * lane) = pack2(yq0, yq1);
            *(unsigned*)(Ks + s * 136 + 2 * lane) = pack2(yk0, yk1);
            const float bs_ = __shfl(bc, s), bets = __shfl(beta, s);
            const float f1 = bets * __expf(bs_), f2 = __expf(bL - bs_);
            const unsigned a0 = f2bf(yk0 * f1), a1 = f2bf(yk1 * f1), w0_ = f2bf(yk0 * f2), w1_ = f2bf(yk1 * f2), v0_ = f2bf(yv0 * bets), v1_ = f2bf(yv1 * bets);
            if (i & 1) { kb0[i >> 1] |= a0 << 16; kb1[i >> 1] |= a1 << 16; kw0[i >> 1] |= w0_ << 16; kw1[i >> 1] |= w1_ << 16; vb0[i >> 1] |= v0_ << 16; vb1[i >> 1] |= v1_ << 16; }
            else { kb0[i >> 1] = a0; kb1[i >> 1] = a1; kw0[i >> 1] = w0_; kw1[i >> 1] = w1_; vb0[i >> 1] = v0_; vb1[i >> 1] = v1_; } }
        *(uint4*)(KbT + (2 * lane) * 72 + w * 8) = make_uint4(kb0[0], kb0[1], kb0[2], kb0[3]);
        *(uint4*)(KbT + (2 * lane + 1) * 72 + w * 8) = make_uint4(kb1[0], kb1[1], kb1[2], kb1[3]);
        *(uint4*)(KwT + (2 * lane) * 72 + w * 8) = make_uint4(kw0[0], kw0[1], kw0[2], kw0[3]);
        *(uint4*)(KwT + (2 * lane + 1) * 72 + w * 8) = make_uint4(kw1[0], kw1[1], kw1[2], kw1[3]);
        *(uint4*)(VbT + (2 * lane) * 72 + w * 8) = make_uint4(vb0[0], vb0[1], vb0[2], vb0[3]);
        *(uint4*)(VbT + (2 * lane + 1) * 72 + w * 8) = make_uint4(vb1[0], vb1[1], vb1[2], vb1[3]);
    }
    __syncthreads();
    {
        f32x4 aKK[2], aQK[2];
#pragma unroll
        for (int n = 0; n < 2; ++n) aKK[n] = aQK[n] = (f32x4){0.f, 0.f, 0.f, 0.f};
#pragma unroll
        for (int k = 0; k < 128; k += 32) {
            const bf16x8 fK = *(const bf16x8*)(Ks + (mt * 16 + fr) * 136 + k + fq * 8), fQ = *(const bf16x8*)(Qs + (mt * 16 + fr) * 136 + k + fq * 8);
#pragma unroll
            for (int n = 0; n < 2; ++n) { const bf16x8 bK = *(const bf16x8*)(Ks + ((g * 2 + n) * 16 + fr) * 136 + k + fq * 8);
                aKK[n] = mfma16(fK, bK, aKK[n]); aQK[n] = mfma16(fQ, bK, aQK[n]); }
        }
#pragma unroll
        for (int n = 0; n < 2; ++n) { const int s = (g * 2 + n) * 16 + fr; const float bs_ = __shfl(bc, s);
#pragma unroll
            for (int j = 0; j < 4; ++j) { const int l = mt * 16 + fq * 4 + j; const float bl = __shfl(bc, l), betl = __shfl(beta, l);
                const float dec = __expf(fminf(bl - bs_, 0.f));
                const float nm = (s < l) ? -betl * aKK[n][j] * dec : 0.f; const u16 nmb = f2bf(nm);
                Mb[l * 72 + s] = nmb; Mtb[s * 72 + l] = nmb; Ts[l * 72 + s] = (l == s) ? (u16)0x3F80 : nmb;
                Ps[l * 72 + s] = f2bf((s <= l) ? aQK[n][j] * dec : 0.f); } }
    }
    __syncthreads();
    {
        f32x4 accT[4];
        if (w >= 4) {
#pragma unroll
            for (int n = 0; n < 4; ++n)
#pragma unroll
                for (int j = 0; j < 4; ++j) accT[n][j] = bf2f(Ts[((w - 4) * 16 + fq * 4 + j) * 72 + n * 16 + fr]);
        }
        for (int k = 1; k <= 6; ++k) {
            const int cur = (k - 1) & 1;
            const u16* Mc = Mb + cur * 64 * 72; const u16* Mtc = Mtb + cur * 64 * 72;
            if (w < 4) {
                if (k <= 5) {
                    f32x4 am[1][4];
#pragma unroll
                    for (int n = 0; n < 4; ++n) am[0][n] = (f32x4){0.f, 0.f, 0.f, 0.f};
                    mma_lds<1, 4>(am, Mc + (w * 16) * 72, 72, Mtc, 72, 64, fr, fq);
                    u16* Mn = Mb + (cur ^ 1) * 64 * 72; u16* Mtn = Mtb + (cur ^ 1) * 64 * 72;
#pragma unroll
                    for (int n = 0; n < 4; ++n)
#pragma unroll
                        for (int j = 0; j < 4; ++j) { const int l = w * 16 + fq * 4 + j, s = n * 16 + fr; const u16 v = f2bf(am[0][n][j]); Mn[l * 72 + s] = v; Mtn[s * 72 + l] = v; }
                }
            } else if (k >= 2) {
                f32x4 at[1][4];
#pragma unroll
                for (int n = 0; n < 4; ++n) at[0][n] = accT[n];
                mma_lds<1, 4>(at, Ts + ((w - 4) * 16) * 72, 72, Mtc, 72, 64, fr, fq);
#pragma unroll
                for (int n = 0; n < 4; ++n) { accT[n] = at[0][n];
#pragma unroll
                    for (int j = 0; j < 4; ++j) Ts[((w - 4) * 16 + fq * 4 + j) * 72 + n * 16 + fr] = f2bf(accT[n][j]); }
            }
            __syncthreads();
        }
    }
    {
        f32x4 aW[4], aU[4];
#pragma unroll
        for (int n = 0; n < 4; ++n) aW[n] = aU[n] = (f32x4){0.f, 0.f, 0.f, 0.f};
#pragma unroll
        for (int k2 = 0; k2 < 2; ++k2) { const bf16x8 aT = *(const bf16x8*)(Ts + (mt * 16 + fr) * 72 + k2 * 32 + fq * 8);
#pragma unroll
            for (int n = 0; n < 4; ++n) { const bf16x8 bK = *(const bf16x8*)(KbT + ((g * 4 + n) * 16 + fr) * 72 + k2 * 32 + fq * 8);
                const bf16x8 bV = *(const bf16x8*)(VbT + ((g * 4 + n) * 16 + fr) * 72 + k2 * 32 + fq * 8);
                aW[n] = mfma16(bK, aT, aW[n]);
                aU[n] = mfma16(aT, bV, aU[n]); } }
#pragma unroll
        for (int n = 0; n < 4; ++n) {
            uint2 pw; pw.x = pack2(aW[n][0], aW[n][1]); pw.y = pack2(aW[n][2], aW[n][3]);
            *(uint2*)(GW + (mt * 16 + fr) * 128 + (g * 4 + n) * 16 + fq * 4) = pw;
            uint2 pu; pu.x = pack2(aU[n][0], aU[n][1]); pu.y = pack2(aU[n][2], aU[n][3]);
            *(uint2*)(GU0 + ((g * 4 + n) * 16 + fr) * 64 + mt * 16 + fq * 4) = pu; }
#pragma unroll
        for (int i = 0; i < 2; ++i) { const int id = tid + i * NTHR;
            *(uint4*)(GQ + (id >> 4) * 128 + (id & 15) * 8) = *(const uint4*)(Qs + (id >> 4) * 136 + (id & 15) * 8);
            *(uint4*)(GKW + (id >> 3) * 64 + (id & 7) * 8) = *(const uint4*)(KwT + (id >> 3) * 72 + (id & 7) * 8); }
        *(uint4*)(GP + (tid >> 3) * 64 + (tid & 7) * 8) = *(const uint4*)(Ps + (tid >> 3) * 72 + (tid & 7) * 8);
    }
    __syncthreads();
}

struct GdnLd { bf16x8 fW[4], fQ[4], fP[2], fKw[2]; uint2 u0[2]; float ebl[4]; float ebL; };
DEVI void gdn_load(GdnLd& L, const Params& p, int unit, int eb, int w, int mt, int g, int fr, int fq) {
    const u16* GQ = (const u16*)(p.ws + WS_GQ) + (size_t)unit * 8192; const u16* GW = (const u16*)(p.ws + WS_GW) + (size_t)unit * 8192;
    const u16* GP = (const u16*)(p.ws + WS_GP) + (size_t)unit * 4096; const u16* GU0 = (const u16*)(p.ws + WS_GU0) + (size_t)unit * 8192;
    const u16* GKW = (const u16*)(p.ws + WS_GKW) + (size_t)unit * 8192; const float* GSC = (const float*)(p.ws + WS_GSC) + (size_t)unit * 80;
#pragma unroll
    for (int kk = 0; kk < 4; ++kk) { L.fW[kk] = *(const bf16x8*)(GW + (mt * 16 + fr) * 128 + kk * 32 + fq * 8); L.fQ[kk] = *(const bf16x8*)(GQ + (mt * 16 + fr) * 128 + kk * 32 + fq * 8); }
#pragma unroll
    for (int k2 = 0; k2 < 2; ++k2) { L.fP[k2] = *(const bf16x8*)(GP + (mt * 16 + fr) * 64 + k2 * 32 + fq * 8); L.fKw[k2] = *(const bf16x8*)(GKW + (w * 16 + fr) * 64 + k2 * 32 + fq * 8); }
#pragma unroll
    for (int n = 0; n < 2; ++n) L.u0[n] = *(const uint2*)(GU0 + (eb * 64 + (g * 2 + n) * 16 + fr) * 64 + mt * 16 + fq * 4);
    const f32x4 e4 = *(const f32x4*)(GSC + mt * 16 + fq * 4);
    L.ebl[0] = e4[0]; L.ebl[1] = e4[1]; L.ebl[2] = e4[2]; L.ebl[3] = e4[3]; L.ebL = GSC[64];
}
DEVI void gdn_seq(const Params& p, int role, char* smem) {
    const int tid = threadIdx.x, lane0 = tid & 63, w0 = tid >> 6;
    const int b = role >> 4, h = (role >> 1) & 7, eb = role & 1;
    u16* Sts = (u16*)smem;
    u16* Uts = Sts + 64 * 136;
    for (int i = tid; i < 64 * 136 / 2; i += NTHR) ((unsigned*)Sts)[i] = 0u;
    u16* hbuf = (u16*)(p.ws + WS_HBUF);
    f32x4 accSt[4];
#pragma unroll
    for (int m = 0; m < 4; ++m) accSt[m] = (f32x4){0.f, 0.f, 0.f, 0.f};
    const int ubase = (b * 8 + h) * 32;
    GdnLd L;
    gdn_load(L, p, ubase, eb, w0, w0 & 3, w0 >> 2, lane0 & 15, lane0 >> 4);
    __syncthreads();
    for (int c = 0; c < 32; ++c) {
        int lane = lane0, w = w0; asm volatile("" : "+v"(lane), "+v"(w));
        const int fr = lane & 15, fq = lane >> 4, mt = w & 3, g = w >> 2;
        const long row0 = (long)b * 2048 + c * 64;
        f32x4 aWS[2], accO[2];
        aWS[0] = aWS[1] = accO[0] = accO[1] = (f32x4){0.f, 0.f, 0.f, 0.f};
#pragma unroll
        for (int kk = 0; kk < 4; ++kk)
#pragma unroll
            for (int n = 0; n < 2; ++n) { const bf16x8 bS = *(const bf16x8*)(Sts + ((g * 2 + n) * 16 + fr) * 136 + kk * 32 + fq * 8);
                aWS[n] = mfma16(L.fW[kk], bS, aWS[n]); accO[n] = mfma16(L.fQ[kk], bS, accO[n]); }
#pragma unroll
        for (int n = 0; n < 2; ++n) {
            const float u0 = __uint_as_float(L.u0[n].x << 16), u1 = __uint_as_float(L.u0[n].x & 0xFFFF0000u);
            const float u2 = __uint_as_float(L.u0[n].y << 16), u3 = __uint_as_float(L.u0[n].y & 0xFFFF0000u);
            uint2 pu; pu.x = pack2(u0 - aWS[n][0], u1 - aWS[n][1]); pu.y = pack2(u2 - aWS[n][2], u3 - aWS[n][3]);
            *(uint2*)(Uts + ((g * 2 + n) * 16 + fr) * 72 + mt * 16 + fq * 4) = pu;
#pragma unroll
            for (int j = 0; j < 4; ++j) accO[n][j] *= L.ebl[j]; }
        const bf16x8 fP0 = L.fP[0], fP1 = L.fP[1], fK0 = L.fKw[0], fK1 = L.fKw[1]; const float ebL = L.ebL;
        __syncthreads();
        if (c + 1 < 32) gdn_load(L, p, ubase + c + 1, eb, w, mt, g, fr, fq);
#pragma unroll
        for (int n = 0; n < 2; ++n) {
            accO[n] = mfma16(fP0, *(const bf16x8*)(Uts + ((g * 2 + n) * 16 + fr) * 72 + fq * 8), accO[n]);
            accO[n] = mfma16(fP1, *(const bf16x8*)(Uts + ((g * 2 + n) * 16 + fr) * 72 + 32 + fq * 8), accO[n]); }
#pragma unroll
        for (int n = 0; n < 2; ++n)
#pragma unroll
            for (int j = 0; j < 4; ++j) hbuf[(row0 + mt * 16 + fq * 4 + j) * DM + 1024 + h * 128 + eb * 64 + (g * 2 + n) * 16 + fr] = f2bf(accO[n][j]);
#pragma unroll
        for (int m = 0; m < 4; ++m) { accSt[m] *= ebL;
            accSt[m] = mfma16(fK0, *(const bf16x8*)(Uts + (m * 16 + fr) * 72 + fq * 8), accSt[m]);
            accSt[m] = mfma16(fK1, *(const bf16x8*)(Uts + (m * 16 + fr) * 72 + 32 + fq * 8), accSt[m]);
            uint2 ps; ps.x = pack2(accSt[m][0], accSt[m][1]); ps.y = pack2(accSt[m][2], accSt[m][3]);
            *(uint2*)(Sts + (m * 16 + fr) * 136 + w * 16 + fq * 4) = ps; }
        __syncthreads();
    }
    const int lane = lane0, w = w0, fr = lane & 15, fq = lane >> 4;
    float* pS = p.out + O_PS + (size_t)(b * 8 + h) * 16384;
#pragma unroll
    for (int m = 0; m < 4; ++m)
#pragma unroll
        for (int j = 0; j < 4; ++j) pS[(size_t)(w * 16 + fq * 4 + j) * 128 + eb * 64 + m * 16 + fr] = accSt[m][j];
    __syncthreads();
}

DEVI void mlstm_sample(const Params& p, int item, char* smem) {
    int tid = threadIdx.x; asm volatile("" : "+v"(tid));
    const int lane = tid & 63, w = tid >> 6;
    const int bs = item >> 2, h = item & 3;
    float* qs = (float*)smem; float* ks = qs + 1024; float* vs = ks + 1024; float* red = vs + 1024; float* num = red + 8192; float* sc = num + 1024; float* sc2 = sc + 32;
    const float* proj = (const float*)(p.ws + WS_PROJ); const float* gates = (const float*)(p.ws + WS_GATES); u16* mix = (u16*)(p.ws + WS_MIX);
    const size_t row0 = NPT + (size_t)bs * 4;
    for (int i = tid; i < 3072; i += NTHR) { const int which = i >> 10, t = (i >> 8) & 3, d = i & 255;
        float v = proj[(row0 + t) * PLD + which * 1024 + h * 256 + d]; if (which == 1) v *= 0.0625f; qs[i] = v; }
    float m = p.st_m[bs * 4 + h]; float fw[4], iw[4], flo[4];
    const float ib = p.m_i_bias[h], fb = p.m_f_bias[h];
#pragma unroll
    for (int t = 0; t < 4; ++t) { const float iv = gates[(row0 + t) * 24 + h] + ib; const float lf = logsigf_(gates[(row0 + t) * 24 + 4 + h] + fb);
        const float mn = fmaxf(lf + m, iv); fw[t] = __expf(lf + m - mn); iw[t] = __expf(iv - mn); flo[t] = __expf(-mn); m = mn; }
    __syncthreads();
    float qn[4] = {0.f, 0.f, 0.f, 0.f};
    if (tid < 256) { float n = p.st_n[(bs * 4 + h) * 256 + tid];
#pragma unroll
        for (int t = 0; t < 4; ++t) { n = fw[t] * n + iw[t] * ks[t * 256 + tid]; qn[t] = qs[t * 256 + tid] * n; }
        p.out[O_SN + (bs * 4 + h) * 256 + tid] = n; }
#pragma unroll
    for (int t = 0; t < 4; ++t) { const float r = wsum(qn[t]); if (lane == 0) sc[w * 4 + t] = r; }
    const float* Cin = p.st_C + (size_t)(bs * 4 + h) * 65536; float* Cout = p.out + O_SC + (size_t)(bs * 4 + h) * 65536;
    f32x4 pn[4];
#pragma unroll
    for (int t = 0; t < 4; ++t) pn[t] = (f32x4){0.f, 0.f, 0.f, 0.f};
#pragma unroll 1
    for (int hf = 0; hf < 2; ++hf) {
        const int d0 = w * 32 + hf * 16;
        f32x4 Cr[16];
#pragma unroll
        for (int i = 0; i < 16; ++i) Cr[i] = __builtin_nontemporal_load((const f32x4*)(Cin + (size_t)(d0 + i) * 256 + lane * 4));
#pragma unroll
        for (int t = 0; t < 4; ++t) { const f32x4 vt = *(const f32x4*)(vs + t * 256 + lane * 4) * iw[t]; f32x4 a = pn[t];
#pragma unroll
            for (int i = 0; i < 16; ++i) { Cr[i] = fw[t] * Cr[i] + ks[t * 256 + d0 + i] * vt; a += qs[t * 256 + d0 + i] * Cr[i]; }
            pn[t] = a; }
#pragma unroll
        for (int i = 0; i < 16; ++i) __builtin_nontemporal_store(Cr[i], (f32x4*)(Cout + (size_t)(d0 + i) * 256 + lane * 4));
    }
#pragma unroll
    for (int t = 0; t < 4; ++t) *(f32x4*)(red + (t * 8 + w) * 256 + lane * 4) = pn[t];
    __syncthreads();
    for (int o = tid; o < 1024; o += NTHR) { const int t = o >> 8, e = o & 255; float sacc = 0.f;
#pragma unroll
        for (int g = 0; g < 8; ++g) sacc += red[(t * 8 + g) * 256 + e];
        num[t * 256 + e] = sacc; }
    __syncthreads();
    float hv[4];
    if (tid < 256) {
#pragma unroll
        for (int t = 0; t < 4; ++t) { float den = 0.f;
#pragma unroll
            for (int g = 0; g < 8; ++g) den += sc[g * 4 + t];
            hv[t] = num[t * 256 + tid] / fmaxf(fabsf(den), flo[t]);
            const float r = wsum(hv[t] * hv[t]); if (lane == 0) sc2[w * 4 + t] = r; }
    }
    __syncthreads();
    if (tid < 256) {
#pragma unroll
        for (int t = 0; t < 4; ++t) { const float ss = sc2[t] + sc2[4 + t] + sc2[8 + t] + sc2[12 + t]; const float rs = rsqrtf(ss * (1.f / 256.f) + 1e-6f);
            const float mo = proj[(row0 + t) * PLD + 3072 + h * 256 + tid];
            mix[(row0 + t) * DM + h * 256 + tid] = f2bf(hv[t] * rs * p.m_norm_g[h * 256 + tid] * sigmoidf_(mo)); }
    }
    if (tid == 0) p.out[O_SM + bs * 4 + h] = m;
    __syncthreads();
}

DEVI void gdn_sample(const Params& p, int item, char* smem) {
    int tid = threadIdx.x; asm volatile("" : "+v"(tid));
    const int lane = tid & 63, w = tid >> 6;
    const int bs = item >> 3, h = item & 7;
    float* qkv = (float*)smem;
    float* red = qkv + 1536;
    float* ored = red + 1024;
    float* sc = ored + 2048;
    const float* proj = (const float*)(p.ws + WS_PROJ); const float* gates = (const float*)(p.ws + WS_GATES); u16* mix = (u16*)(p.ws + WS_MIX);
    const size_t row0 = NPT + (size_t)bs * 4;
    if (tid < 384) { const int which = tid >> 7, dch = tid & 127, ch = which * 1024 + h * 128 + dch;
        float xp[7];
#pragma unroll
        for (int j = 0; j < 3; ++j) xp[j] = p.st_conv[(size_t)(bs * 3 + j) * 3072 + ch];
#pragma unroll
        for (int t = 0; t < 4; ++t) xp[3 + t] = proj[(row0 + t) * PLD + 4096 + ch];
        float cw[4];
#pragma unroll
        for (int j = 0; j < 4; ++j) cw[j] = p.conv_w[j * 3072 + ch];
#pragma unroll
        for (int t = 0; t < 4; ++t) qkv[(which * 4 + t) * 128 + dch] = siluf_(cw[0] * xp[t] + cw[1] * xp[t + 1] + cw[2] * xp[t + 2] + cw[3] * xp[t + 3]); }
    float at[4], be[4];
    { const float dtb = p.g_dt_bias[h], Aexp = __expf(p.g_A_log[h]);
#pragma unroll
        for (int t = 0; t < 4; ++t) { at[t] = __expf(-Aexp * softplusf_(gates[(row0 + t) * 24 + 16 + h] + dtb)); be[t] = sigmoidf_(gates[(row0 + t) * 24 + 8 + h]); } }
    __syncthreads();
    { const int which = w >> 2, t = w & 3; float* a = qkv + (which * 4 + t) * 128; const float v0 = a[lane * 2], v1 = a[lane * 2 + 1];
        const float sc_ = rsqrtf(wsum(v0 * v0 + v1 * v1) + 1e-6f) * (which == 0 ? 0.08838834764831845f : 1.f);
        a[lane * 2] = v0 * sc_; a[lane * 2 + 1] = v1 * sc_; }
    __syncthreads();
    const float* qf = qkv; const float* kf = qkv + 512; const float* vf = qkv + 1024;
    const int e = tid & 127, dg = tid >> 7;
    const float* Sin = p.st_S + (size_t)(bs * 8 + h) * 16384; float* Sout = p.out + O_SS + (size_t)(bs * 8 + h) * 16384;
    float Sr[32];
#pragma unroll
    for (int i = 0; i < 32; ++i) Sr[i] = __builtin_nontemporal_load(Sin + (dg * 32 + i) * 128 + e);
#pragma unroll
    for (int t = 0; t < 4; ++t) {
        float r = 0.f;
#pragma unroll
        for (int i = 0; i < 32; ++i) r += kf[t * 128 + dg * 32 + i] * Sr[i];
        red[((t & 1) * 4 + dg) * 128 + e] = r;
        __syncthreads();
        const float rr = red[((t & 1) * 4 + 0) * 128 + e] + red[((t & 1) * 4 + 1) * 128 + e] + red[((t & 1) * 4 + 2) * 128 + e] + red[((t & 1) * 4 + 3) * 128 + e];
        const float u = be[t] * (vf[t * 128 + e] - at[t] * rr);
        float po = 0.f;
#pragma unroll
        for (int i = 0; i < 32; ++i) { Sr[i] = at[t] * Sr[i] + kf[t * 128 + dg * 32 + i] * u; po += qf[t * 128 + dg * 32 + i] * Sr[i]; }
        ored[(t * 4 + dg) * 128 + e] = po;
    }
#pragma unroll
    for (int i = 0; i < 32; ++i) __builtin_nontemporal_store(Sr[i], Sout + (dg * 32 + i) * 128 + e);
    __syncthreads();
    float ov[4];
    if (tid < 128) {
#pragma unroll
        for (int t = 0; t < 4; ++t) { ov[t] = ored[(t * 4 + 0) * 128 + tid] + ored[(t * 4 + 1) * 128 + tid] + ored[(t * 4 + 2) * 128 + tid] + ored[(t * 4 + 3) * 128 + tid];
            const float r = wsum(ov[t] * ov[t]); if (lane == 0) sc[w * 4 + t] = r; }
    }
    __syncthreads();
    if (tid < 128) {
#pragma unroll
        for (int t = 0; t < 4; ++t) { const float rs = rsqrtf((sc[t] + sc[4 + t]) * (1.f / 128.f) + 1e-6f);
            const float gz = proj[(row0 + t) * PLD + 7168 + h * 128 + tid];
            mix[(row0 + t) * DM + 1024 + h * 128 + tid] = f2bf(ov[t] * rs * p.g_norm_g[h * 128 + tid] * siluf_(gz)); }
    }
    __syncthreads();
}

#ifndef SCM
#define SCM 15
#endif
DEVI void phase_scan(const Params& p, char* smem) {
    const int G = gridDim.x, bid = blockIdx.x;
    if (G >= 192) {
        if (bid < 64) { if (SCM & 1) mlstm_seq(p, bid, smem); }
        else if (bid < 128) { if (SCM & 2) gdn_seq(p, bid - 64, smem); }
        unsigned* q = (unsigned*)(p.ws + WS_BAR) + 64;
        volatile unsigned* lq = (volatile unsigned*)(smem + LDS_BYTES - 32);
        for (;;) {
            __syncthreads();
            if (threadIdx.x == 0) *lq = __hip_atomic_fetch_add(q, 1u, __ATOMIC_RELAXED, __HIP_MEMORY_SCOPE_AGENT);
            __syncthreads();
            const unsigned u = *lq;
            if (u >= 1536u) break;
            if (u < 512u) mlstm_sample(p, (int)u, smem); else gdn_sample(p, (int)u - 512, smem);
        }
        pop_late(p, smem, 1 << 30);
        if (p.ph_hi - p.ph_lo == 1) pop_late(p, smem, 1 << 30, 1);
    } else {
        for (int u = bid; u < 128 + 512 + 1024; u += G) {
            if (u < 64) { if (SCM & 1) mlstm_seq(p, u, smem); } else if (u < 128) { if (SCM & 2) gdn_seq(p, u - 64, smem); }
            else if (u < 640) { if (SCM & 4) mlstm_sample(p, u - 128, smem); } else { if (SCM & 8) gdn_sample(p, u - 640, smem); } }
        pop_late(p, smem, 1 << 30);
    }
}

#define XB_TMO      128
#define XB_XCNT(j)  (256  + 64 * (j))
#define XB_XSUB(j)  (1280 + 64 * (j))
#define XB_XGEN(j)  (2304 + 64 * (j))
#define XB_TOP      3328
#define XB_TOPGEN   3392
#define XCD_BAR_WORDS 3456
#define XB_SPIN_CAP (1u << 18)
#define LAS __attribute__((address_space(3)))

__device__ __forceinline__ unsigned xb_ld(unsigned* p)              { return __hip_atomic_load(p, __ATOMIC_RELAXED, __HIP_MEMORY_SCOPE_AGENT); }
__device__ __forceinline__ unsigned xb_add(unsigned* p, unsigned v) { return __hip_atomic_fetch_add(p, v, __ATOMIC_RELAXED, __HIP_MEMORY_SCOPE_AGENT); }
__device__ __forceinline__ unsigned xb_xcc_id() { return (unsigned)__builtin_amdgcn_s_getreg((3 << 11) | 20) & 0xFu; }
#define XB_SPIN(cond, bar) do { unsigned _sp = 0; while (cond) { __builtin_amdgcn_s_sleep(1); \
    if ((++_sp & 255u) == 0u) { if (xb_ld(&(bar)[XB_TMO])) break; if (_sp > XB_SPIN_CAP) { atomicAdd(&(bar)[XB_TMO], 1u); break; } } } } while (0)

struct XcdBarrier {
    unsigned* bar; unsigned x;
    volatile LAS unsigned* st;
};

__device__ __forceinline__ XcdBarrier xcd_barrier_post(unsigned* bar, volatile LAS unsigned* st) {
    XcdBarrier b; b.bar = bar; b.x = xb_xcc_id(); b.st = st;
    if (threadIdx.x == 0) (void)xb_add(&bar[XB_XCNT(b.x)], 1u);
    return b;
}
__device__ __forceinline__ void xcd_barrier_complete(unsigned* bar, unsigned x, unsigned& nloc, unsigned& nx) {
    const unsigned G = gridDim.x * gridDim.y * gridDim.z;
    unsigned sum, cnt, mine, sp = 0u;
    for (;;) {
        sum = 0u; cnt = 0u; mine = 0u;
#pragma unroll
        for (unsigned j = 0; j < 16; ++j) { const unsigned c = xb_ld(&bar[XB_XCNT(j)]); sum += c; cnt += (c > 0u) ? 1u : 0u; mine = (j == x) ? c : mine; }
        if (sum == G) break;
        __builtin_amdgcn_s_sleep(1);
        if ((++sp & 255u) == 0u) { if (xb_ld(&bar[XB_TMO])) break; if (sp > XB_SPIN_CAP) { atomicAdd(&bar[XB_TMO], 1u); break; } }
    }
    nloc = mine > 0u ? mine : 1u; nx = cnt > 0u ? cnt : 1u;
}

__device__ __forceinline__ void xcd_barrier(const XcdBarrier& b) {
    asm volatile("s_waitcnt vmcnt(0)" ::: "memory");
    __syncthreads();
    if (threadIdx.x == 0) {
        unsigned* bar = b.bar;
        __builtin_amdgcn_s_waitcnt(0);
        unsigned nloc = b.st[0], nx = b.st[1];
        if (nloc == 0u) { xcd_barrier_complete(bar, b.x, nloc, nx); b.st[0] = nloc; b.st[1] = nx; }
        const unsigned old = xb_add(&bar[XB_XSUB(b.x)], 1u);
        const unsigned gen = old / nloc;
        if (old + 1u == (gen + 1u) * nloc) {
            __builtin_amdgcn_fence(__ATOMIC_RELEASE, "agent");
            asm volatile("s_waitcnt vmcnt(0)" ::: "memory");
            const unsigned og = xb_add(&bar[XB_TOP], 1u);
            const unsigned tg = og / nx;
            if (og + 1u == (tg + 1u) * nx) xb_add(&bar[XB_TOPGEN], 1u);
            else XB_SPIN(xb_ld(&bar[XB_TOPGEN]) == tg, bar);
            __builtin_amdgcn_fence(__ATOMIC_ACQUIRE, "agent");
            xb_add(&bar[XB_XGEN(b.x)], 1u);
            asm volatile("s_waitcnt vmcnt(0)" ::: "memory");
        } else {
            XB_SPIN(xb_ld(&bar[XB_XGEN(b.x)]) == gen, bar);
            __builtin_amdgcn_fence(__ATOMIC_ACQUIRE, "agent");
            asm volatile("s_waitcnt vmcnt(0)" ::: "memory");
        }
    }
    __syncthreads();
}

__global__ void __launch_bounds__(NTHR) fwd_kernel(Params p) {
    extern __shared__ __attribute__((aligned(16))) char smem[];
    cg::grid_group grid = cg::this_grid();
    const int lo = p.ph_lo, hi = p.ph_hi;
    if (lo == 777) grid.sync();
    volatile LAS unsigned* xst = (volatile LAS unsigned*)(smem + LDS_BYTES - 16);
    if (threadIdx.x < 2) xst[threadIdx.x] = 0u;
    __syncthreads();
    XcdBarrier xbar; xbar.bar = (unsigned*)(p.ws + WS_BAR); xbar.x = 0; xbar.st = xst;
    if (hi - lo > 1) xbar = xcd_barrier_post((unsigned*)(p.ws + WS_BAR), xst);
#ifndef PHMASK
#define PHMASK 0xFFFF
#endif
#define PHASE(k) if (((PHMASK >> (k)) & 1) && lo <= (k) && (k) < hi)
#define SEAM(k) if (lo <= (k) && (k) + 1 < hi) xcd_barrier(xbar)
    PHASE(0) phase_prep(p, smem);
    SEAM(0);
    PHASE(2) phase_modulate(p);
    SEAM(2);
    PHASE(3) { PEpiProj e{(float*)(p.ws + WS_PROJ), (float*)(p.ws + WS_GATES)}; pg8_run((const u16*)(p.ws + WS_AH), (const u16*)(p.ws + WS_WIN), NTOK, 8448, DM, smem, e);
        if (hi - lo > 1 && 4 * (int)gridDim.x + (int)blockIdx.x >= 34 * 33) pop_late(p, smem, 9); }
    SEAM(3);
    PHASE(4) { for (int u = blockIdx.x; u < 1536; u += gridDim.x) { if (u < 512) mlstm_pre(p, u, smem); else gdn_pre(p, u - 512, smem); } }
    SEAM(4);
    PHASE(5) phase_scan(p, smem);
    SEAM(5);
    PHASE(6) phase_post(p);
    SEAM(6);
    PHASE(7) { PEpiRes e{p.x_prompt, p.x_sample, nullptr, (const float*)(p.ws + WS_ADA), 2 * DM, (float*)(p.ws + WS_X1), (float*)(p.ws + WS_PART), DM / 8};
        pg8_run_split((const u16*)(p.ws + WS_MIX), (const u16*)(p.ws + WS_WOUT), DM, DM, 8, smem, e);
        if (hi - lo > 1 && blockIdx.x >= 128) pop_late(p, smem, 2, 1); }
    SEAM(7);
    PHASE(8) phase_ln1(p);
    SEAM(8);
    PHASE(9) { PEpiGU e{(u16*)(p.ws + WS_ACT)}; pg8_run((const u16*)(p.ws + WS_AH), (const u16*)(p.ws + WS_WGU), NTOK, 2 * DFF, DM, smem, e);
        if (hi - lo > 1) { if (5 * (int)gridDim.x + (int)blockIdx.x >= 34 * 44) pop_late(p, smem, 9, 1); pop_late(p, smem, 1 << 30, 1); } }
    SEAM(9);
    PHASE(10) { PEpiRes e{p.x_prompt, p.x_sample, (const float*)(p.ws + WS_X1), (const float*)(p.ws + WS_ADA), 5 * DM, p.out + O_YP, (float*)(p.ws + WS_PART), DFF / 11};
        pg8_run_split((const u16*)(p.ws + WS_ACT), (const u16*)(p.ws + WS_WDOWN), DM, DFF, 11, smem, e); }
    SEAM(10);
    PHASE(11) phase_ln2(p);
}

extern "C" void kernel_launch(void* const* d_in, const int* in_sizes, int n_in, void* d_out, int out_size, void* d_ws, size_t ws_size,
                              hipStream_t stream) {
    static int grid = 0;
    if (grid == 0) {
        if (n_in != 26 || ws_size < WS_END) { fprintf(stderr, "kernel_launch: unexpected n_in %d / ws_size %zu\n", n_in, ws_size); grid = -1; return; }
        int dev = 0, cus = 0, per_cu = 0;
        hipGetDevice(&dev);
        hipDeviceGetAttribute(&cus, hipDeviceAttributeMultiprocessorCount, dev);
        hipFuncSetAttribute((const void*)fwd_kernel, hipFuncAttributeMaxDynamicSharedMemorySize, LDS_BYTES);
        hipOccupancyMaxActiveBlocksPerMultiprocessor(&per_cu, (const void*)fwd_kernel, NTHR, LDS_BYTES);
        if (per_cu < 1) { fprintf(stderr, "kernel_launch: occupancy query says %d blocks/CU\n", per_cu); grid = -1; return; }
        grid = cus * per_cu;
    }
    if (grid < 0) return;
    Params p{};
    const float** f = (const float**)&p;
    for (int i = 0; i < 26; ++i) f[i] = (const float*)d_in[i];
    p.out = (float*)d_out; p.ws = (unsigned char*)d_ws;
    hipMemsetAsync((char*)d_ws + WS_BAR, 0, XCD_BAR_WORDS * 4, stream);
#if FUSED
    p.ph_lo = 0; p.ph_hi = 12;
    void* args[] = {&p};
    hipError_t e = hipLaunchCooperativeKernel((const void*)fwd_kernel, dim3(grid), dim3(NTHR), args, LDS_BYTES, stream);
    if (e != hipSuccess) fprintf(stderr, "cooperative launch failed: %s (grid %d)\n", hipGetErrorString(e), grid);
#else
    for (int ph = 0; ph < 12; ++ph) { p.ph_lo = ph; p.ph_hi = ph + 1; hipLaunchKernelGGL(fwd_kernel, dim3(grid), dim3(NTHR), LDS_BYTES, stream, p); }
#endif
}
```
